# Optimizing an MI355X kernel written in HIP

```python
import numpy as np
import jax
import jax.numpy as jnp
from jax import lax

D_MODEL = 1024
BATCH = 8
SEQ = 4096
DEPTH = 2

ROPE_THETA = 10000.0
NORM_EPS = 1e-6
NEG_INF = -1e30
TINY = 1e-30
D_FF = 2816
Q_BLOCK = 128

MLA_HEADS = 8
MLA_NOPE = 64
MLA_ROPE = 32
MLA_V = 64
MLA_Q_LORA = 256
MLA_KV_LORA = 128

GLA_HEADS = 4
GLA_DK = 64
GLA_DV = 128
GLA_GATE_RANK = 16
GLA_GATE_TAU = 16.0
GLA_CHUNK = 64

NSA_HEADS = 16
NSA_KV_GROUPS = 4
NSA_HEAD_DIM = 64
NSA_CMP_LEN = 32
NSA_CMP_STRIDE = 16
NSA_CMP_HIDDEN = 128
NSA_SEL_LEN = 64
NSA_TOP_N = 16
NSA_WINDOW = 512
NSA_Q_BLOCK = 64
NSA_FORCE_SCORE = 1e4

HY_SPLITS = (MLA_Q_LORA, MLA_KV_LORA, MLA_ROPE, GLA_HEADS * GLA_DK, GLA_HEADS * GLA_DK,
             GLA_HEADS * GLA_DV, GLA_GATE_RANK, GLA_HEADS * GLA_DV)
HY_IN = sum(HY_SPLITS)
HY_OUT = MLA_HEADS * MLA_V + GLA_HEADS * GLA_DV
NSA_KV_WIDTH = NSA_KV_GROUPS * NSA_HEAD_DIM
NSA_SPLITS = (NSA_HEADS * NSA_HEAD_DIM,) + (NSA_KV_WIDTH,) * 6 + (NSA_HEADS * 3,)
NSA_IN = sum(NSA_SPLITS)
NSA_OUT = NSA_HEADS * NSA_HEAD_DIM
N_EVEN = (DEPTH + 1) // 2
N_ODD = DEPTH // 2

kernel_name = 'hybrid_mla_gla_nsa_macaron'


def split_cols(h, sizes):
    return jnp.split(h, np.cumsum(sizes)[:-1].tolist(), axis=-1)


def rms_norm(x, g):
    xf = x.astype(jnp.float32)
    y = xf * lax.rsqrt(jnp.mean(xf * xf, axis=-1, keepdims=True) + NORM_EPS)
    return (y * g.astype(jnp.float32)).astype(x.dtype)


def rope(x, pos):
    d = x.shape[-1]
    inv_freq = jnp.power(ROPE_THETA, -jnp.arange(d // 2, dtype=jnp.float32) * (2.0 / d))
    ang = pos.astype(jnp.float32)[..., None] * inv_freq
    cos = jnp.cos(ang)[:, :, None, :]
    sin = jnp.sin(ang)[:, :, None, :]
    xf = x.astype(jnp.float32)
    x1, x2 = xf[..., : d // 2], xf[..., d // 2:]
    return jnp.concatenate([x1 * cos - x2 * sin, x2 * cos + x1 * sin], axis=-1).astype(x.dtype)


def masked_softmax(s, mask):
    s = jnp.where(mask, s.astype(jnp.float32), NEG_INF)
    m = jnp.max(s, axis=-1, keepdims=True)
    p = jnp.where(mask, jnp.exp(s - m), 0.0)
    return p / jnp.maximum(jnp.sum(p, axis=-1, keepdims=True), TINY)


def swiglu(x, w_gate, w_up, w_down):
    return (jax.nn.silu(x @ w_gate) * (x @ w_up)) @ w_down


def causal_block_attention(q, k, v, scale):
    B, S, H, Dk = q.shape
    nb = S // Q_BLOCK
    q_blocks = q.reshape(B, nb, Q_BLOCK, H, Dk).transpose(1, 0, 2, 3, 4)
    key_pos = jnp.arange(S)

    def one_block(args):
        i, qb = args
        s = jnp.einsum('bqhd,bkhd->bhqk', qb, k, preferred_element_type=jnp.float32) * scale
        q_pos = i * Q_BLOCK + jnp.arange(Q_BLOCK)
        p = masked_softmax(s, key_pos[None, :] <= q_pos[:, None])
        return jnp.einsum('bhqk,bkhd->bqhd', p.astype(v.dtype), v)

    out = lax.map(one_block, (jnp.arange(nb), q_blocks))
    return out.transpose(1, 0, 2, 3, 4).reshape(B, S, H, v.shape[-1])


def mla_heads(c_q, c_kv, k_r, positions, q_norm, w_uq, kv_norm, w_ukv):
    B, S, _ = c_q.shape
    q = (rms_norm(c_q, q_norm) @ w_uq).reshape(B, S, MLA_HEADS, MLA_NOPE + MLA_ROPE)
    q_nope, q_rot = q[..., :MLA_NOPE], rope(q[..., MLA_NOPE:], positions)
    kv = (rms_norm(c_kv, kv_norm) @ w_ukv).reshape(B, S, MLA_HEADS, MLA_NOPE + MLA_V)
    k_nope, v = kv[..., :MLA_NOPE], kv[..., MLA_NOPE:]
    k_rot = rope(k_r.reshape(B, S, 1, MLA_ROPE), positions)
    q_full = jnp.concatenate([q_nope, q_rot], axis=-1)
    k_full = jnp.concatenate([k_nope, jnp.broadcast_to(k_rot, (B, S, MLA_HEADS, MLA_ROPE))], axis=-1)
    o = causal_block_attention(q_full, k_full, v, (MLA_NOPE + MLA_ROPE) ** -0.5)
    return o.reshape(B, S, MLA_HEADS * MLA_V)


def gla_heads(h_q, h_k, h_v, h_a, h_r, w_a2, b_a, out_norm):
    B, S, _ = h_q.shape
    H, DK, DV, C = GLA_HEADS, GLA_DK, GLA_DV, GLA_CHUNK
    nc = S // C
    f32 = jnp.float32
    q = h_q.reshape(B, nc, C, H, DK).astype(f32) * DK ** -0.5
    k = h_k.reshape(B, nc, C, H, DK).astype(f32)
    v = h_v.reshape(B, nc, C, H, DV).astype(f32)
    log_a = jax.nn.log_sigmoid((h_a @ w_a2 + b_a).astype(f32)) / GLA_GATE_TAU
    b = jnp.cumsum(log_a.reshape(B, nc, C, H, DK), axis=2)
    b_last = b[:, :, -1:]
    k_dec = k * jnp.exp(b_last - b)
    q_inter = q * jnp.exp(b)
    q_intra = q * jnp.exp(b - b_last)
    causal = jnp.tril(jnp.ones((C, C), dtype=bool))
    A = jnp.where(causal, jnp.einsum('bnihd,bnjhd->bnhij', q_intra, k_dec), 0.0)
    o_intra = jnp.einsum('bnhij,bnjhv->bnihv', A, v)
    kv_chunk = jnp.einsum('bnjhd,bnjhv->nbhdv', k_dec, v)
    decay_chunk = jnp.exp(b[:, :, -1]).transpose(1, 0, 2, 3)

    def step(state, inp):
        dec, kv = inp
        return state * dec[..., None] + kv, state

    _, s_prev = lax.scan(step, jnp.zeros((B, H, DK, DV), f32), (decay_chunk, kv_chunk))
    o_inter = jnp.einsum('bnihd,nbhdv->bnihv', q_inter, s_prev)
    o = rms_norm((o_intra + o_inter).reshape(B, S, H, DV), out_norm)
    o = o * jax.nn.silu(h_r.reshape(B, S, H, DV).astype(f32))
    return o.reshape(B, S, H * DV).astype(h_q.dtype)


def mla_gla_mixer(u, positions, w_in, q_norm, w_uq, kv_norm, w_ukv, w_a2, b_a, out_norm, w_out):
    c_q, c_kv, k_r, g_q, g_k, g_v, g_a, g_r = split_cols(u @ w_in, HY_SPLITS)
    o_mla = mla_heads(c_q, c_kv, k_r, positions, q_norm, w_uq, kv_norm, w_ukv)
    o_gla = gla_heads(g_q, g_k, g_v, g_a, g_r, w_a2, b_a, out_norm)
    return jnp.concatenate([o_mla, o_gla.astype(o_mla.dtype)], axis=-1) @ w_out


def nsa_mixer(u, positions, w_in, pos_k, pos_v, ck_w1, ck_w2, cv_w1, cv_w2, w_out):
    B, S, _ = u.shape
    H, G, Dh = NSA_HEADS, NSA_KV_GROUPS, NSA_HEAD_DIM
    Hg = H // G
    dt = u.dtype
    q, k_c, v_c, k_s, v_s, k_w, v_w, g = split_cols(u @ w_in, NSA_SPLITS)
    q = rope(q.reshape(B, S, H, Dh), positions)
    gates = jax.nn.sigmoid(g.reshape(B, S, H, 3))

    n_cmp = (S - NSA_CMP_LEN) // NSA_CMP_STRIDE + 1
    cmp_start = np.arange(n_cmp) * NSA_CMP_STRIDE
    cmp_end = cmp_start + NSA_CMP_LEN - 1
    cmp_idx = cmp_start[:, None] + np.arange(NSA_CMP_LEN)[None, :]

    def compress(t, pos_emb, w1, w2):
        blocks = t.reshape(B, S, G, Dh)[:, cmp_idx] + pos_emb[None, None, :, None, :]
        flat = blocks.transpose(0, 1, 3, 2, 4).reshape(B, n_cmp, G, NSA_CMP_LEN * Dh)
        return jax.nn.silu(flat @ w1) @ w2

    k_cmp = rope(compress(k_c, pos_k, ck_w1, ck_w2), positions[:, cmp_end])
    v_cmp = compress(v_c, pos_v, cv_w1, cv_w2)
    cmp_end_j = jnp.asarray(cmp_end)

    n_blk = S // NSA_SEL_LEN
    n_pad = max(n_blk, NSA_TOP_N)

    def to_blocks(t):
        tb = t.reshape(B, n_blk, NSA_SEL_LEN, G, Dh).transpose(0, 3, 1, 2, 4)
        return jnp.pad(tb, ((0, 0), (0, 0), (0, n_pad - n_blk), (0, 0), (0, 0)))

    k_sel_all = to_blocks(rope(k_s.reshape(B, S, G, Dh), positions))
    v_sel_all = to_blocks(v_s.reshape(B, S, G, Dh))
    blk_start = np.arange(n_pad) * NSA_SEL_LEN
    ov = np.minimum(cmp_start[:, None] + NSA_CMP_LEN, blk_start[None, :] + NSA_SEL_LEN) - np.maximum(cmp_start[:, None], blk_start[None, :])
    overlap = jnp.asarray(np.clip(ov, 0, None) / NSA_CMP_LEN, dtype=jnp.float32)

    pad_w = ((0, 0), (NSA_WINDOW, 0), (0, 0), (0, 0))
    k_win = jnp.pad(rope(k_w.reshape(B, S, G, Dh), positions), pad_w)
    v_win = jnp.pad(v_w.reshape(B, S, G, Dh), pad_w)

    nq = S // NSA_Q_BLOCK
    q_blocks = q.reshape(B, nq, NSA_Q_BLOCK, G, Hg, Dh).transpose(1, 0, 2, 3, 4, 5)
    g_blocks = gates.reshape(B, nq, NSA_Q_BLOCK, G, Hg, 3).transpose(1, 0, 2, 3, 4, 5)
    bi = jnp.arange(B)[:, None, None, None]
    gi = jnp.arange(G)[None, :, None, None]
    scale = Dh ** -0.5
    span = NSA_Q_BLOCK + NSA_WINDOW

    def one_block(args):
        i, qb, gb = args
        t = i * NSA_Q_BLOCK + jnp.arange(NSA_Q_BLOCK)
        s_c = jnp.einsum('bqghd,bngd->bghqn', qb, k_cmp, preferred_element_type=jnp.float32) * scale
        p_c = masked_softmax(s_c, cmp_end_j[None, :] <= t[:, None])
        o_c = jnp.einsum('bghqn,bngd->bqghd', p_c.astype(dt), v_cmp)
        imp = jnp.einsum('bghqn,nm->bgqm', p_c, overlap)
        blk = jnp.arange(n_pad)[None, :]
        cur = (t // NSA_SEL_LEN)[:, None]
        forced = (blk == 0) | (blk == cur) | (blk == cur - 1)
        score = jnp.where(blk <= cur, jnp.where(forced, NSA_FORCE_SCORE, imp), NEG_INF)
        _, sel = lax.top_k(score, NSA_TOP_N)
        k_sel = k_sel_all[bi, gi, sel].reshape(B, G, NSA_Q_BLOCK, NSA_TOP_N * NSA_SEL_LEN, Dh)
        v_sel = v_sel_all[bi, gi, sel].reshape(B, G, NSA_Q_BLOCK, NSA_TOP_N * NSA_SEL_LEN, Dh)
        kpos = (sel[..., None] * NSA_SEL_LEN + jnp.arange(NSA_SEL_LEN)).reshape(B, G, NSA_Q_BLOCK, -1)
        s_s = jnp.einsum('bqghd,bgqmd->bghqm', qb, k_sel, preferred_element_type=jnp.float32) * scale
        p_s = masked_softmax(s_s, (kpos <= t[None, None, :, None])[:, :, None])
        o_s = jnp.einsum('bghqm,bgqmd->bqghd', p_s.astype(dt), v_sel)
        start = i * NSA_Q_BLOCK
        k_wb = lax.dynamic_slice_in_dim(k_win, start, span, axis=1)
        v_wb = lax.dynamic_slice_in_dim(v_win, start, span, axis=1)
        wpos = (start - NSA_WINDOW + jnp.arange(span))[None, :]
        m_w = (wpos <= t[:, None]) & (wpos > t[:, None] - NSA_WINDOW) & (wpos >= 0)
        s_w = jnp.einsum('bqghd,bkgd->bghqk', qb, k_wb, preferred_element_type=jnp.float32) * scale
        p_w = masked_softmax(s_w, m_w)
        o_w = jnp.einsum('bghqk,bkgd->bqghd', p_w.astype(dt), v_wb)
        return gb[..., 0:1] * o_c + gb[..., 1:2] * o_s + gb[..., 2:3] * o_w

    out = lax.map(one_block, (jnp.arange(nq), q_blocks, g_blocks))
    return out.transpose(1, 0, 2, 3, 4, 5).reshape(B, S, NSA_OUT) @ w_out


def setup_inputs(seed: int = 0) -> dict:
    key = jax.random.key(seed)
    ks = iter(jax.random.split(key, 40))
    f32 = jnp.float32

    def w(shape, fan_in):
        return jax.random.normal(next(ks), shape, f32) * fan_in ** -0.5

    def gain(shape):
        return 1.0 + 0.02 * jax.random.normal(next(ks), shape, f32)

    def small(shape, s):
        return s * jax.random.normal(next(ks), shape, f32)

    x = jax.random.normal(next(ks), (BATCH, SEQ, D_MODEL), f32)
    offsets = jax.random.randint(next(ks), (BATCH, 1), 0, 1024)
    positions = (offsets + jnp.arange(SEQ)[None, :]).astype(jnp.int32)
    return {
        'x': x,
        'positions': positions,
        'ffn_norm': gain((DEPTH, 2, D_MODEL)),
        'ffn_w_gate': w((DEPTH, 2, D_MODEL, D_FF), D_MODEL),
        'ffn_w_up': w((DEPTH, 2, D_MODEL, D_FF), D_MODEL),
        'ffn_w_down': w((DEPTH, 2, D_FF, D_MODEL), D_FF),
        'mix_norm': gain((DEPTH, D_MODEL)),
        'hy_w_in': w((N_EVEN, D_MODEL, HY_IN), D_MODEL),
        'mla_q_norm': gain((N_EVEN, MLA_Q_LORA)),
        'mla_w_uq': w((N_EVEN, MLA_Q_LORA, MLA_HEADS * (MLA_NOPE + MLA_ROPE)), MLA_Q_LORA),
        'mla_kv_norm': gain((N_EVEN, MLA_KV_LORA)),
        'mla_w_ukv': w((N_EVEN, MLA_KV_LORA, MLA_HEADS * (MLA_NOPE + MLA_V)), MLA_KV_LORA),
        'gla_w_a2': w((N_EVEN, GLA_GATE_RANK, GLA_HEADS * GLA_DK), GLA_GATE_RANK),
        'gla_b_a': small((N_EVEN, GLA_HEADS * GLA_DK), 0.1),
        'gla_out_norm': gain((N_EVEN, GLA_DV)),
        'hy_w_out': w((N_EVEN, HY_OUT, D_MODEL), HY_OUT),
        'nsa_w_in': w((N_ODD, D_MODEL, NSA_IN), D_MODEL),
        'nsa_pos_k': small((N_ODD, NSA_CMP_LEN, NSA_HEAD_DIM), 0.1),
        'nsa_pos_v': small((N_ODD, NSA_CMP_LEN, NSA_HEAD_DIM), 0.1),
        'nsa_ck_w1': w((N_ODD, NSA_CMP_LEN * NSA_HEAD_DIM, NSA_CMP_HIDDEN), NSA_CMP_LEN * NSA_HEAD_DIM),
        'nsa_ck_w2': w((N_ODD, NSA_CMP_HIDDEN, NSA_HEAD_DIM), NSA_CMP_HIDDEN),
        'nsa_cv_w1': w((N_ODD, NSA_CMP_LEN * NSA_HEAD_DIM, NSA_CMP_HIDDEN), NSA_CMP_LEN * NSA_HEAD_DIM),
        'nsa_cv_w2': w((N_ODD, NSA_CMP_HIDDEN, NSA_HEAD_DIM), NSA_CMP_HIDDEN),
        'nsa_w_out': w((N_ODD, NSA_OUT, D_MODEL), NSA_OUT),
        'final_norm': gain((D_MODEL,)),
    }


def reference(x, positions, ffn_norm, ffn_w_gate, ffn_w_up, ffn_w_down, mix_norm,
              hy_w_in, mla_q_norm, mla_w_uq, mla_kv_norm, mla_w_ukv, gla_w_a2, gla_b_a,
              gla_out_norm, hy_w_out, nsa_w_in, nsa_pos_k, nsa_pos_v, nsa_ck_w1, nsa_ck_w2,
              nsa_cv_w1, nsa_cv_w2, nsa_w_out, final_norm):
    h = x
    for layer in range(DEPTH):
        j = layer // 2
        h = h + 0.5 * swiglu(rms_norm(h, ffn_norm[layer, 0]), ffn_w_gate[layer, 0], ffn_w_up[layer, 0], ffn_w_down[layer, 0])
        u = rms_norm(h, mix_norm[layer])
        if layer % 2 == 0:
            mixed = mla_gla_mixer(u, positions, hy_w_in[j], mla_q_norm[j], mla_w_uq[j], mla_kv_norm[j],
                                  mla_w_ukv[j], gla_w_a2[j], gla_b_a[j], gla_out_norm[j], hy_w_out[j])
        else:
            mixed = nsa_mixer(u, positions, nsa_w_in[j], nsa_pos_k[j], nsa_pos_v[j], nsa_ck_w1[j],
                              nsa_ck_w2[j], nsa_cv_w1[j], nsa_cv_w2[j], nsa_w_out[j])
        h = h + mixed.astype(h.dtype)
        h = h + 0.5 * swiglu(rms_norm(h, ffn_norm[layer, 1]), ffn_w_gate[layer, 1], ffn_w_up[layer, 1], ffn_w_down[layer, 1])
    return rms_norm(h, final_norm)
```

```cpp
#include <hip/hip_runtime.h>
#include <cstdio>
#include <cstdint>
#include <cmath>
namespace pg8 {
#define PG8_LAS __attribute__((address_space(3)))
typedef unsigned short bf16_t;
typedef short bf16x8 __attribute__((ext_vector_type(8)));
typedef float f32x4 __attribute__((ext_vector_type(4)));
typedef unsigned u32x4 __attribute__((ext_vector_type(4)));
constexpr int BM = 256, BK = 64, HALF = 128, HTB = HALF * BK * 2  , STAGE_BYTES = 8 * HTB, NXCD = 8, WGM = 4;

__host__ __device__ __forceinline__ int lds_byte(int r, int c) { const int st = (r >> 4) * 2 + (c >> 5), rr = r & 15, cc = c & 31, ob = rr * 64 + cc * 2; return st * 1024 + (ob ^ (((ob >> 9) & 1) << 5)); }
__host__ __device__ __forceinline__ void stage_rc(int b, int& R, int& C) { const int st = b / 1024, sb = b % 1024, swz = sb ^ (((sb >> 9) & 1) << 5); R = (st >> 1) * 16 + swz / 64; C = (st & 1) * 32 + (swz % 64) / 2; }
__host__ __device__ __forceinline__ int perm32(int rho) { const int n = rho >> 4, i = rho & 15; return 8 * (i >> 2) + 4 * n + (i & 3); }

struct Unit { int pm, pn; };
struct Gemm { const bf16_t* A; const bf16_t* Bt; int M, N, K, lda; };

struct StaticOrder {
    int nM, nN, nwg, G, c, wgm;
    __host__ __device__ void init(int M, int N, int G_, int c_, int wgm_ = WGM) { nM = M / BM; nN = N / BM; nwg = nM * nN; G = G_; c = c_; wgm = wgm_; }
    __host__ __device__ bool next(int i, Unit& u) const {
        const long L = (long)i * G + c; if (L >= nwg) return false;
        int wgid = (int)L; { const int q = nwg / NXCD, r = nwg % NXCD, xcd = wgid % NXCD, off = wgid / NXCD; wgid = (xcd < r ? xcd * (q + 1) : r * (q + 1) + (xcd - r) * q) + off; }
        const int nig = wgm * nN, gid = wgid / nig, fm = gid * wgm, gsz = (nM - fm) < wgm ? (nM - fm) : wgm;
        u.pm = fm + ((wgid % nig) % gsz); u.pn = (wgid % nig) / gsz; return true;
    }
    __device__ __forceinline__ void a_ready(const Unit&) const {}
    __device__ __forceinline__ void done(const Unit&) const {}
};

typedef float f32x2_t __attribute__((ext_vector_type(2))); typedef __bf16 bf16x2_t __attribute__((ext_vector_type(2)));
__device__ __forceinline__ unsigned cvtpk(float lo, float hi) { f32x2_t v = {lo, hi}; bf16x2_t b = __builtin_convertvector(v, bf16x2_t); return __builtin_bit_cast(unsigned, b); }
__device__ __forceinline__ u32x4 pack8(const f32x4 a, const f32x4 b) { u32x4 w; w.x = cvtpk(a[0], a[1]); w.y = cvtpk(a[2], a[3]); w.z = cvtpk(b[0], b[1]); w.w = cvtpk(b[2], b[3]); return w; }
__device__ __forceinline__ float silu_f(float x) { return x * __builtin_amdgcn_rcpf(1.0f + __builtin_amdgcn_exp2f(-1.4426950408889634f * x)); }
__device__ __forceinline__ float sigmoid_f(float x) { return __builtin_amdgcn_rcpf(1.0f + __builtin_amdgcn_exp2f(-1.4426950408889634f * x)); }
constexpr float NORM_EPS = 1e-6f;
template <int NP> __device__ __forceinline__ void row_rstd8(float (&rs)[2][4], const float* ssq, int row0, int fq, float inv_n) {
#pragma unroll
    for (int ai = 0; ai < 2; ++ai)
#pragma unroll
        for (int m = 0; m < 4; ++m) { const int row = row0 + ai * HALF + m * 16; float s;
            if (NP == 16) { const f32x4 p = *(const f32x4*)(ssq + (size_t)row * 16 + 4 * fq); s = (p[0] + p[1]) + (p[2] + p[3]); } else { s = ssq[(size_t)row * 4 + fq]; }
            s += __shfl_xor(s, 16); s += __shfl_xor(s, 32); rs[ai][m] = __builtin_amdgcn_rsqf(s * inv_n + NORM_EPS); }
}
__device__ __forceinline__ float sq8(const f32x4 a, const f32x4 b) { return ((a[0] * a[0] + a[1] * a[1]) + (a[2] * a[2] + a[3] * a[3])) + ((b[0] * b[0] + b[1] * b[1]) + (b[2] * b[2] + b[3] * b[3])); }

__device__ __forceinline__ void epi_ids(int& wr, int& wc, int& fr, int& fq) { int t = threadIdx.x; asm volatile("" : "+v"(t)); const int wid = __builtin_amdgcn_readfirstlane(t >> 6); wr = wid >> 2; wc = wid & 3; fr = t & 15; fq = (t >> 4) & 3; }
struct EpiGateUp {
    static constexpr bool PERM = true, AFTER_DRAIN = false;
    bf16_t* H; const float* ssq; int ldh;
    __device__ __forceinline__ void operator()(const f32x4 (&acc)[2][2][4][2], const Unit& u, int wr_, int wc_, int fr_, int fq_) const {
        int wr, wc, fr, fq; epi_ids(wr, wc, fr, fq);
        const int row0 = u.pm * BM + wr * 64 + fr, col = u.pn * HALF + wc * 32 + 8 * fq;
        float rs[2][4]; row_rstd8<16>(rs, ssq, row0, fq, 1.0f / 1024.0f);
#pragma unroll
        for (int ai = 0; ai < 2; ++ai)
#pragma unroll
            for (int m = 0; m < 4; ++m) { const float r = rs[ai][m], rr = r * r, rn = r * -1.4426950408889634f; f32x4 h0, h1;
                const f32x4 g0 = acc[ai][0][m][0], g1 = acc[ai][0][m][1], p0 = (g0 * acc[ai][1][m][0]) * rr, p1 = (g1 * acc[ai][1][m][1]) * rr, e0 = g0 * rn, e1 = g1 * rn;
#pragma unroll
                for (int e = 0; e < 4; ++e) { h0[e] = p0[e] * __builtin_amdgcn_rcpf(1.0f + __builtin_amdgcn_exp2f(e0[e])); h1[e] = p1[e] * __builtin_amdgcn_rcpf(1.0f + __builtin_amdgcn_exp2f(e1[e])); }
                *(u32x4*)(H + (size_t)(row0 + ai * HALF + m * 16) * ldh + col) = pack8(h0, h1); }
    }
};
struct EpiNull {
    static constexpr bool PERM = true, AFTER_DRAIN = false;
    __device__ __forceinline__ void operator()(const f32x4 (&acc)[2][2][4][2], const Unit& u, int, int, int, int) const {
#pragma unroll
        for (int ai = 0; ai < 2; ++ai)
#pragma unroll
            for (int bj = 0; bj < 2; ++bj) asm volatile("" :: "v"(acc[ai][bj][0][0]), "v"(acc[ai][bj][0][1]), "v"(acc[ai][bj][1][0]), "v"(acc[ai][bj][1][1]), "v"(acc[ai][bj][2][0]), "v"(acc[ai][bj][2][1]), "v"(acc[ai][bj][3][0]), "v"(acc[ai][bj][3][1]));
    }
};
template <bool XBASE> struct EpiResidT {
    static constexpr bool PERM = true, AFTER_DRAIN = false;
    const float* xbase; bf16_t* hb; float* ssq; float alpha;
    __device__ __forceinline__ void operator()(const f32x4 (&acc)[2][2][4][2], const Unit& u, int wr_, int wc_, int fr_, int fq_) const {
        int wr, wc, fr, fq; epi_ids(wr, wc, fr, fq);
        const int row0 = u.pm * BM + wr * 64 + fr, col = u.pn * BM + wc * 32 + 8 * fq;
        if (XBASE) {
#pragma unroll
            for (int ai = 0; ai < 2; ++ai) { f32x4 bx[4][2][2];
#pragma unroll
                for (int m = 0; m < 4; ++m)
#pragma unroll
                    for (int bj = 0; bj < 2; ++bj) { const size_t off = (size_t)(row0 + ai * HALF + m * 16) * 1024 + col + bj * HALF; bx[m][bj][0] = *(const f32x4*)(xbase + off); bx[m][bj][1] = *(const f32x4*)(xbase + off + 4); }
#pragma unroll
                for (int m = 0; m < 4; ++m) { const size_t off = (size_t)(row0 + ai * HALF + m * 16) * 1024 + col; float s = 0.f;
#pragma unroll
                    for (int bj = 0; bj < 2; ++bj) { const f32x4 v0 = bx[m][bj][0] + alpha * acc[ai][bj][m][0], v1 = bx[m][bj][1] + alpha * acc[ai][bj][m][1]; *(u32x4*)(hb + off + bj * HALF) = pack8(v0, v1); s += sq8(v0, v1); }
                    s += __shfl_xor(s, 16); s += __shfl_xor(s, 32);
                    if (fq == 0) ssq[(size_t)(row0 + ai * HALF + m * 16) * 16 + u.pn * 4 + wc] = s; }
                asm volatile("" ::: "memory"); }
        } else {
            u32x4 bw[2][4][2];
#pragma unroll
            for (int ai = 0; ai < 2; ++ai)
#pragma unroll
                for (int m = 0; m < 4; ++m)
#pragma unroll
                    for (int bj = 0; bj < 2; ++bj) bw[ai][m][bj] = *(const u32x4*)(hb + (size_t)(row0 + ai * HALF + m * 16) * 1024 + col + bj * HALF);
#pragma unroll
            for (int ai = 0; ai < 2; ++ai)
#pragma unroll
                for (int m = 0; m < 4; ++m) { const size_t off = (size_t)(row0 + ai * HALF + m * 16) * 1024 + col; float s = 0.f;
#pragma unroll
                    for (int bj = 0; bj < 2; ++bj) { const u32x4 w = bw[ai][m][bj];
                        const f32x4 b0 = {__builtin_bit_cast(float, w.x << 16), __builtin_bit_cast(float, w.x & 0xffff0000u), __builtin_bit_cast(float, w.y << 16), __builtin_bit_cast(float, w.y & 0xffff0000u)};
                        const f32x4 b1 = {__builtin_bit_cast(float, w.z << 16), __builtin_bit_cast(float, w.z & 0xffff0000u), __builtin_bit_cast(float, w.w << 16), __builtin_bit_cast(float, w.w & 0xffff0000u)};
                        const f32x4 v0 = b0 + alpha * acc[ai][bj][m][0], v1 = b1 + alpha * acc[ai][bj][m][1]; *(u32x4*)(hb + off + bj * HALF) = pack8(v0, v1); s += sq8(v0, v1); }
                    s += __shfl_xor(s, 16); s += __shfl_xor(s, 32);
                    if (fq == 0) ssq[(size_t)(row0 + ai * HALF + m * 16) * 16 + u.pn * 4 + wc] = s; }
        }
    }
};
template <class E0> struct EpiTwice {
    static constexpr bool PERM = E0::PERM, AFTER_DRAIN = false; E0 e;
    __device__ __forceinline__ void operator()(const f32x4 (&acc)[2][2][4][2], const Unit& u, int a, int b, int c, int d) const { e(acc, u, a, b, c, d); asm volatile("" ::: "memory"); e(acc, u, a, b, c, d); }
};
struct EpiHyIn {
    static constexpr bool PERM = true, AFTER_DRAIN = false;
    bf16_t* U; const float* ssq; float* ssqq; float* ssqkv; float* kr; float* ga;
    __device__ __forceinline__ void operator()(const f32x4 (&acc)[2][2][4][2], const Unit& u, int wr_, int wc_, int fr_, int fq_) const {
        int wr, wc, fr, fq; epi_ids(wr, wc, fr, fq);
        const int row0 = u.pm * BM + wr * 64 + fr, col = u.pn * BM + wc * 32 + 8 * fq;
        float rs[2][4]; row_rstd8<16>(rs, ssq, row0, fq, 1.0f / 1024.0f);
#pragma unroll
        for (int ai = 0; ai < 2; ++ai)
#pragma unroll
            for (int m = 0; m < 4; ++m) { const int row = row0 + ai * HALF + m * 16; const float r = rs[ai][m];
                const f32x4 a0 = acc[ai][0][m][0] * r, a1 = acc[ai][0][m][1] * r, b0 = acc[ai][1][m][0] * r, b1 = acc[ai][1][m][1] * r;
                bf16_t* up = U + (size_t)row * 2048 + col;
                if (u.pn == 0) { *(u32x4*)up = pack8(a0, a1); *(u32x4*)(up + HALF) = pack8(b0, b1);
                    float s = sq8(a0, a1) + sq8(b0, b1); s += __shfl_xor(s, 16); s += __shfl_xor(s, 32); if (fq == 0) ssqq[(size_t)row * 4 + wc] = s; }
                else if (u.pn == 1) { *(u32x4*)up = pack8(a0, a1);
                    float s = sq8(a0, a1); s += __shfl_xor(s, 16); s += __shfl_xor(s, 32); if (fq == 0) ssqkv[(size_t)row * 4 + wc] = s;
                    if (wc == 0) { *(f32x4*)(kr + (size_t)row * 32 + 8 * fq) = b0; *(f32x4*)(kr + (size_t)row * 32 + 8 * fq + 4) = b1; }
                    else if (wc == 1 && fq < 2) { *(f32x4*)(ga + (size_t)row * 16 + 8 * fq) = b0; *(f32x4*)(ga + (size_t)row * 16 + 8 * fq + 4) = b1; } }
                else { *(u32x4*)up = pack8(a0, a1); *(u32x4*)(up + HALF) = pack8(b0, b1); } }
    }
};
struct EpiQup {
    static constexpr bool PERM = true, AFTER_DRAIN = false;
    bf16_t* QM; const float* ssqq; const float* rope; float c2;
    __device__ __forceinline__ void operator()(const f32x4 (&acc)[2][2][4][2], const Unit& u, int wr_, int wc_, int fr_, int fq_) const {
        int wr, wc, fr, fq; epi_ids(wr, wc, fr, fq);
        const int row0 = u.pm * BM + wr * 64 + fr;
        float rs[2][4]; row_rstd8<4>(rs, ssqq, row0, fq, 1.0f / 256.0f);
#pragma unroll
        for (int ai = 0; ai < 2; ++ai)
#pragma unroll
            for (int m = 0; m < 4; ++m) { const int row = row0 + ai * HALF + m * 16; const float r = rs[ai][m] * c2;
                const f32x4 a0 = acc[ai][0][m][0] * r, a1 = acc[ai][0][m][1] * r, b0 = acc[ai][1][m][0] * r, b1 = acc[ai][1][m][1] * r;
                bf16_t* qp = QM + (size_t)row * 768;
                if (u.pn < 2) { const int c0 = u.pn * BM + wc * 32 + 8 * fq, c1 = c0 + HALF;
                    *(u32x4*)(qp + (c0 >> 6) * 96 + (c0 & 63)) = pack8(a0, a1); *(u32x4*)(qp + (c1 >> 6) * 96 + (c1 & 63)) = pack8(b0, b1); }
                else { const int j0 = wc * 32 + 8 * fq, h = j0 >> 4, i0 = j0 & 15; const f32x4* cs = (const f32x4*)(rope + ((size_t)row * 16 + i0) * 2);
                    const f32x4 t0 = cs[0], t1 = cs[1], t2 = cs[2], t3 = cs[3];
                    const f32x4 cA = {t0[0], t0[2], t1[0], t1[2]}, sA = {t0[1], t0[3], t1[1], t1[3]}, cB = {t2[0], t2[2], t3[0], t3[2]}, sB = {t2[1], t2[3], t3[1], t3[3]};
                    const f32x4 y10 = a0 * cA - b0 * sA, y11 = a1 * cB - b1 * sB, y20 = b0 * cA + a0 * sA, y21 = b1 * cB + a1 * sB;
                    *(u32x4*)(qp + h * 96 + 64 + i0) = pack8(y10, y11); *(u32x4*)(qp + h * 96 + 80 + i0) = pack8(y20, y21); } }
    }
};
struct EpiKVup {
    static constexpr bool PERM = true, AFTER_DRAIN = false;
    bf16_t* KF; bf16_t* VM; const float* ssqkv;
    __device__ __forceinline__ void operator()(const f32x4 (&acc)[2][2][4][2], const Unit& u, int wr_, int wc_, int fr_, int fq_) const {
        int wr, wc, fr, fq; epi_ids(wr, wc, fr, fq);
        const int row0 = u.pm * BM + wr * 64 + fr, w = wc * 32 + 8 * fq;
        float rs[2][4]; row_rstd8<4>(rs, ssqkv, row0, fq, 1.0f / 128.0f);
#pragma unroll
        for (int ai = 0; ai < 2; ++ai)
#pragma unroll
            for (int m = 0; m < 4; ++m) { const int row = row0 + ai * HALF + m * 16; const float r = rs[ai][m];
#pragma unroll
                for (int bj = 0; bj < 2; ++bj) { const int h = 2 * u.pn + bj; const u32x4 v = pack8(acc[ai][bj][m][0] * r, acc[ai][bj][m][1] * r);
                    if (wc < 2) *(u32x4*)(KF + (size_t)row * 768 + h * 96 + w) = v; else *(u32x4*)(VM + (size_t)row * 512 + h * 64 + (w - 64)) = v; } }
    }
};
struct EpiNsaIn {
    static constexpr bool PERM = true, AFTER_DRAIN = false;
    bf16_t* QN; bf16_t* KV6;
    const float* ssq; const float* rope; float c2;
    __device__ __forceinline__ void operator()(const f32x4 (&acc)[2][2][4][2], const Unit& u, int wr_, int wc_, int fr_, int fq_) const {
        int wr, wc, fr, fq; epi_ids(wr, wc, fr, fq);
        const int row0 = u.pm * BM + wr * 64 + fr;
        float rs[2][4]; row_rstd8<16>(rs, ssq, row0, fq, 1.0f / 1024.0f);
        const bool is_rope = (u.pn < 4) || u.pn == 6 || u.pn == 8;
#pragma unroll
        for (int ai = 0; ai < 2; ++ai)
#pragma unroll
            for (int m = 0; m < 4; ++m) { const int row = row0 + ai * HALF + m * 16; const float r = rs[ai][m] * (u.pn < 4 ? c2 : 1.0f);
                const f32x4 a0 = acc[ai][0][m][0] * r, a1 = acc[ai][0][m][1] * r, b0 = acc[ai][1][m][0] * r, b1 = acc[ai][1][m][1] * r;
                if (is_rope) { const int i0 = 8 * fq; const f32x4* cs = (const f32x4*)(rope + ((size_t)row * 32 + i0) * 2);
                    const f32x4 t0 = cs[0], t1 = cs[1], t2 = cs[2], t3 = cs[3];
                    const f32x4 cA = {t0[0], t0[2], t1[0], t1[2]}, sA = {t0[1], t0[3], t1[1], t1[3]}, cB = {t2[0], t2[2], t3[0], t3[2]}, sB = {t2[1], t2[3], t3[1], t3[3]};
                    const f32x4 y10 = a0 * cA - b0 * sA, y11 = a1 * cB - b1 * sB, y20 = b0 * cA + a0 * sA, y21 = b1 * cB + a1 * sB;
                    bf16_t* dst = (u.pn < 4) ? QN + (size_t)row * 1024 + (4 * u.pn + wc) * 64 : KV6 + (size_t)(u.pn - 4) * ((size_t)32768 * 256) + (size_t)row * 256 + wc * 64;
                    *(u32x4*)(dst + i0) = pack8(y10, y11); *(u32x4*)(dst + 32 + i0) = pack8(y20, y21); }
                else { bf16_t* dst = KV6 + (size_t)(u.pn - 4) * ((size_t)32768 * 256) + (size_t)row * 256 + wc * 32 + 8 * fq;
                    *(u32x4*)dst = pack8(a0, a1); *(u32x4*)(dst + HALF) = pack8(b0, b1); } }
    }
};

template <class Epi, class Sched, bool ALIGN_EPI = false, bool SP2 = false>
__device__ __forceinline__ void gemm_phase(PG8_LAS unsigned char* lds, const Gemm g, const Sched& S, const Epi& E) {
    int tid_ = threadIdx.x; asm volatile("" : "+v"(tid_));
    const int tid = tid_, wid = __builtin_amdgcn_readfirstlane(tid >> 6), lane = tid & 63, wr = wid >> 2, wc = wid & 3, fr = lane & 15, fq = lane >> 4;
    const int K = g.K, nt = K / BK;
    unsigned voffA[2], voffB[2];
#pragma unroll
    for (int i = 0; i < 2; ++i) { int R, C; stage_rc(tid * 16 + i * 8192, R, C); const int Rb = Epi::PERM ? ((R & ~31) + perm32(R & 31)) : R;
        voffA[i] = (unsigned)(R * g.lda + C) * 2u; voffB[i] = (unsigned)(Rb * K + C) * 2u; }
    const size_t kstep = (size_t)(BK * 2);
    const size_t hstepA = (size_t)HALF * g.lda * 2, hstepB = (size_t)HALF * K * 2;
    const size_t tstepA = 2 * hstepA, tstepB = 2 * hstepB;
    const unsigned ldsw = (unsigned)wid * 1024u;
    const int aoff = lds_byte(wr * 64 + fr, fq * 8), boff = lds_byte(wc * 32 + fr, fq * 8);
#define PG8_SA(b, h) (((b) * 2 + (h)) * HTB)
#define PG8_SB(b, h) ((4 + (b) * 2 + (h)) * HTB)
#define PG8_STAGE(bufoff, gbase, voff) do { _Pragma("unroll") for (int _i = 0; _i < 2; ++_i) \
        __builtin_amdgcn_global_load_lds((const unsigned*)((const char*)(gbase) + (voff)[_i]), (PG8_LAS unsigned*)(lds + (bufoff) + ldsw + _i * 8192), 16, 0, 0); } while (0)
#define PG8_LDA(dst, b, h) do { _Pragma("unroll") for (int m = 0; m < 4; ++m) _Pragma("unroll") for (int k = 0; k < 2; ++k) dst[m][k] = *(const PG8_LAS bf16x8*)(lds + PG8_SA(b, h) + aoff + m * 2048 + k * 1024); } while (0)
#define PG8_LDB(dst, b, h) do { _Pragma("unroll") for (int n = 0; n < 2; ++n) _Pragma("unroll") for (int k = 0; k < 2; ++k) dst[n][k] = *(const PG8_LAS bf16x8*)(lds + PG8_SB(b, h) + boff + n * 2048 + k * 1024); } while (0)
#define PG8_MMA(ai, bj, At, Bt) do { __builtin_amdgcn_s_setprio(1); _Pragma("unroll") for (int m = 0; m < 4; ++m) _Pragma("unroll") for (int n = 0; n < 2; ++n) _Pragma("unroll") for (int k = 0; k < 2; ++k) \
        acc[ai][bj][m][n] = __builtin_amdgcn_mfma_f32_16x16x32_bf16(Bt[n][k], At[m][k], acc[ai][bj][m][n], 0, 0, 0); __builtin_amdgcn_s_setprio(0); } while (0)
#define PG8_WAIT_V(n) asm volatile("s_waitcnt vmcnt(" #n ")" ::: "memory")
#define PG8_WAIT_L(n) asm volatile("s_waitcnt lgkmcnt(" #n ")" ::: "memory")
#define PG8_BAR __builtin_amdgcn_s_barrier()
#define PG8_SCHED __builtin_amdgcn_sched_barrier(0)
    Unit cur, nxt; int ui = 0;
    if (!S.next(0, cur)) return;
    f32x4 acc[2][2][4][2];
#pragma unroll
    for (int a = 0; a < 2; ++a)
#pragma unroll
        for (int b = 0; b < 2; ++b)
#pragma unroll
            for (int m = 0; m < 4; ++m)
#pragma unroll
                for (int n = 0; n < 2; ++n) acc[a][b][m][n] = (f32x4){0.f, 0.f, 0.f, 0.f};
    bf16x8 At[4][2], B0[2][2], B1[2][2];
    const char* cA = (const char*)g.A + (size_t)cur.pm * tstepA; const char* cB = (const char*)g.Bt + (size_t)cur.pn * tstepB;
    S.a_ready(cur);
    if constexpr (SP2) {
        PG8_STAGE(PG8_SB(0, 0), cB, voffB); PG8_STAGE(PG8_SB(0, 1), cB + hstepB, voffB); PG8_STAGE(PG8_SA(0, 0), cA, voffA); PG8_STAGE(PG8_SA(0, 1), cA + hstepA, voffA);
        if (wr == 1) PG8_BAR;
        PG8_WAIT_V(2); PG8_BAR;
        PG8_STAGE(PG8_SB(1, 0), cB + kstep, voffB); PG8_STAGE(PG8_SA(1, 0), cA + kstep, voffA); PG8_STAGE(PG8_SB(1, 1), cB + hstepB + kstep, voffB);
        PG8_WAIT_V(6); PG8_BAR;
    } else {
        PG8_STAGE(PG8_SB(0, 0), cB, voffB); PG8_STAGE(PG8_SA(0, 0), cA, voffA); PG8_STAGE(PG8_SB(0, 1), cB + hstepB, voffB); PG8_STAGE(PG8_SA(0, 1), cA + hstepA, voffA);
        if (wr == 1) PG8_BAR;
        PG8_WAIT_V(4); PG8_BAR;
        PG8_STAGE(PG8_SB(1, 0), cB + kstep, voffB); PG8_STAGE(PG8_SA(1, 0), cA + kstep, voffA); PG8_STAGE(PG8_SB(1, 1), cB + hstepB + kstep, voffB);
        PG8_WAIT_V(6); PG8_BAR;
    }
    for (;;) {
        const bool has_next = S.next(ui + 1, nxt);
        const char* nA = has_next ? (const char*)g.A + (size_t)nxt.pm * tstepA : cA; const char* nB = has_next ? (const char*)g.Bt + (size_t)nxt.pn * tstepB : cB;
        for (int t = 0; t < nt; t += 2) {
            const bool last = (t == nt - 2);
            const char* a1 = cA + (size_t)(t + 1) * kstep;
            const char* a2 = last ? nA : cA + (size_t)(t + 2) * kstep; const char* b2 = last ? nB : cB + (size_t)(t + 2) * kstep;
            const char* a3 = a2 + kstep; const char* b3 = b2 + kstep;
            if (last && has_next) S.a_ready(nxt);
            if constexpr (SP2) {
            PG8_LDB(B0, 0, 0); PG8_LDB(B1, 0, 1); PG8_SCHED; PG8_LDA(At, 0, 0); PG8_STAGE(PG8_SA(1, 1), a1 + hstepA, voffA);
            PG8_WAIT_V(8); PG8_WAIT_L(0); PG8_BAR; PG8_MMA(0, 0, At, B0); PG8_MMA(0, 1, At, B1); PG8_BAR; PG8_SCHED;
            PG8_LDA(At, 0, 1); PG8_STAGE(PG8_SB(0, 0), b2, voffB); PG8_STAGE(PG8_SB(0, 1), b2 + hstepB, voffB); PG8_STAGE(PG8_SA(0, 0), a2, voffA);
            PG8_WAIT_V(8); PG8_WAIT_L(0); PG8_BAR; PG8_MMA(1, 0, At, B0); PG8_MMA(1, 1, At, B1); PG8_BAR; PG8_SCHED;
            PG8_LDB(B0, 1, 0); PG8_LDB(B1, 1, 1); PG8_SCHED; PG8_LDA(At, 1, 0); PG8_STAGE(PG8_SA(0, 1), a2 + hstepA, voffA);
            PG8_WAIT_V(8); PG8_WAIT_L(0); PG8_BAR; PG8_MMA(0, 0, At, B0); PG8_MMA(0, 1, At, B1); PG8_BAR; PG8_SCHED;
            PG8_LDA(At, 1, 1); PG8_STAGE(PG8_SB(1, 0), b3, voffB); PG8_STAGE(PG8_SB(1, 1), b3 + hstepB, voffB); PG8_STAGE(PG8_SA(1, 0), a3, voffA);
            PG8_WAIT_V(8); PG8_WAIT_L(0); PG8_BAR; PG8_MMA(1, 0, At, B0); PG8_MMA(1, 1, At, B1); PG8_BAR; PG8_SCHED;
            } else {
            PG8_LDB(B0, 0, 0); PG8_SCHED; PG8_LDA(At, 0, 0); PG8_STAGE(PG8_SA(1, 1), a1 + hstepA, voffA);
            PG8_WAIT_L(8); PG8_BAR; PG8_WAIT_L(0); PG8_MMA(0, 0, At, B0); PG8_BAR; PG8_SCHED;
            PG8_LDB(B1, 0, 1); PG8_STAGE(PG8_SB(0, 0), b2, voffB);
            PG8_BAR; PG8_WAIT_L(0); PG8_MMA(0, 1, At, B1); PG8_BAR;
            PG8_LDA(At, 0, 1); PG8_STAGE(PG8_SA(0, 0), a2, voffA);
            PG8_BAR; PG8_WAIT_L(0); PG8_MMA(1, 0, At, B0); PG8_BAR; PG8_SCHED;
            PG8_STAGE(PG8_SB(0, 1), b2 + hstepB, voffB);
            PG8_WAIT_V(6); PG8_BAR; PG8_MMA(1, 1, At, B1); PG8_BAR;
            PG8_LDB(B0, 1, 0); PG8_SCHED; PG8_LDA(At, 1, 0); PG8_STAGE(PG8_SA(0, 1), a2 + hstepA, voffA);
            PG8_WAIT_L(8); PG8_BAR; PG8_WAIT_L(0); PG8_MMA(0, 0, At, B0); PG8_BAR; PG8_SCHED;
            PG8_LDB(B1, 1, 1); PG8_STAGE(PG8_SB(1, 0), b3, voffB);
            PG8_BAR; PG8_WAIT_L(0); PG8_MMA(0, 1, At, B1); PG8_BAR;
            PG8_LDA(At, 1, 1); PG8_STAGE(PG8_SA(1, 0), a3, voffA);
            PG8_BAR; PG8_WAIT_L(0); PG8_MMA(1, 0, At, B0); PG8_BAR; PG8_SCHED;
            PG8_STAGE(PG8_SB(1, 1), b3 + hstepB, voffB);
            PG8_WAIT_V(6); PG8_BAR; PG8_MMA(1, 1, At, B1); PG8_BAR;
            }
        }
        if constexpr (ALIGN_EPI) { if (wr == 0) PG8_BAR; }
        if constexpr (!Epi::AFTER_DRAIN) { E(acc, cur, wr, wc, fr, fq); S.done(cur); }
        if (!has_next) break;
#pragma unroll
        for (int a = 0; a < 2; ++a)
#pragma unroll
            for (int b = 0; b < 2; ++b)
#pragma unroll
                for (int m = 0; m < 4; ++m)
#pragma unroll
                    for (int n = 0; n < 2; ++n) acc[a][b][m][n] = (f32x4){0.f, 0.f, 0.f, 0.f};
        cur = nxt; cA = nA; cB = nB; ++ui;
        if constexpr (ALIGN_EPI) { if (wr == 1) PG8_BAR; }
    }
    PG8_WAIT_V(0);
    if constexpr (!ALIGN_EPI) { if (wr == 0) PG8_BAR; }
    PG8_BAR;
    if constexpr (Epi::AFTER_DRAIN) { E.fused(acc, cur, wr, wc, fr, fq, lds, wid, lane); S.done(cur); }
#undef PG8_SA
#undef PG8_SB
#undef PG8_STAGE
#undef PG8_LDA
#undef PG8_LDB
#undef PG8_MMA
#undef PG8_WAIT_V
#undef PG8_WAIT_L
#undef PG8_BAR
#undef PG8_SCHED
}
}
namespace fa {
#define FA_LAS __attribute__((address_space(3)))
typedef unsigned short bf16_t;
typedef short bf16x8 __attribute__((ext_vector_type(8)));
typedef short s16x4 __attribute__((ext_vector_type(4)));
typedef float f32x16 __attribute__((ext_vector_type(16)));
typedef float f32x4 __attribute__((ext_vector_type(4)));
typedef unsigned u32x4 __attribute__((ext_vector_type(4)));
typedef short v4i16_t __attribute__((ext_vector_type(4)));
typedef FA_LAS const char* lds_cptr;
typedef FA_LAS char* lds_ptr;
#define FA_MFMA(a, b, c) __builtin_amdgcn_mfma_f32_32x32x16_bf16(a, b, c, 0, 0, 0)
#define FA_WAIT_BAR(N) asm volatile("s_waitcnt vmcnt(" #N ") lgkmcnt(0)\n\ts_barrier" ::: "memory")
__device__ __forceinline__ int crow(int r, int hi) { return (r & 3) + 8 * (r >> 2) + 4 * hi; }
__device__ __forceinline__ unsigned cvtpk(float lo, float hi) { return pg8::cvtpk(lo, hi); }
__device__ __forceinline__ void glds16(const void* g, unsigned lds_base) {
    unsigned sv; asm volatile("s_mov_b32 %0, m0\n\ts_mov_b32 m0, %2\n\ts_nop 0\n\tglobal_load_lds_dwordx4 %1, off\n\ts_mov_b32 m0, %0" : "=&s"(sv) : "v"(g), "s"(lds_base) : "memory"); }
__device__ __forceinline__ s16x4 vtr(lds_cptr p) { return __builtin_bit_cast(s16x4, __builtin_amdgcn_ds_read_tr16_b64_v4i16((FA_LAS v4i16_t*)p)); }
__device__ __forceinline__ unsigned lds_addr(lds_cptr p) { return (unsigned)(uintptr_t)p; }
#define FA_MX3(a, b, c) __builtin_fmaxf(__builtin_fmaxf((a), (b)), (c))
__device__ __forceinline__ float swap_max(float m) { auto rr = __builtin_amdgcn_permlane32_swap(__float_as_uint(m), __float_as_uint(m), false, false); return __builtin_fmaxf(__uint_as_float(rr[0]), __uint_as_float(rr[1])); }
__device__ __forceinline__ float swap_sum(float m) { auto rr = __builtin_amdgcn_permlane32_swap(__float_as_uint(m), __float_as_uint(m), false, false); return __uint_as_float(rr[0]) + __uint_as_float(rr[1]); }
__device__ __forceinline__ float rowmax(const f32x16& p0, const f32x16& p1) {
    float a = FA_MX3(p0[0], p0[1], p1[0]), b = FA_MX3(p0[2], p0[3], p1[1]); a = FA_MX3(a, p1[2], p1[3]);
#pragma unroll
    for (int r = 4; r < 16; r += 4) { a = FA_MX3(a, p0[r], p0[r + 1]); b = FA_MX3(b, p0[r + 2], p0[r + 3]); a = FA_MX3(a, p1[r], p1[r + 1]); b = FA_MX3(b, p1[r + 2], p1[r + 3]); }
    return swap_max(__builtin_fmaxf(a, b)); }

template <int DK> __device__ __forceinline__ void dma_k(const bf16_t* ksrc, int kpitch, unsigned kslot, int wid, int lane) {
    glds16(ksrc + (size_t)lane * kpitch + wid * 8, (unsigned)__builtin_amdgcn_readfirstlane(kslot + wid * 1024));
    if (DK > 64) { const int c2 = (wid < DK / 8 - 8) ? wid + 8 : wid;
        glds16(ksrc + (size_t)lane * kpitch + c2 * 8, (unsigned)__builtin_amdgcn_readfirstlane(kslot + c2 * 1024)); }
}
__device__ __forceinline__ void dma_v(const bf16_t* vsrc, int vpitch, unsigned vslot, int wid, int lane) {
    glds16(vsrc + (size_t)(16 * (wid & 3) + (lane >> 2)) * vpitch + (wid >> 2) * 32 + (lane & 3) * 8, (unsigned)__builtin_amdgcn_readfirstlane(vslot + wid * 1024));
}
struct Run { float mref, l; f32x16 o0, o1, negm; bool started; };
__device__ __forceinline__ void run_init(Run& R) { R.mref = 0.f; R.l = 0.f; R.o0 = f32x16{}; R.o1 = f32x16{}; R.negm = f32x16{}; R.started = false; }
constexpr float FA_THR = 8.0f;
template <int DK> __device__ __forceinline__ void qkt(f32x16& p0, f32x16& p1, lds_cptr kslot, const bf16x8* qr, const f32x16& negm, int r32, int hi) {
    const lds_cptr kb = kslot + hi * 1024 + r32 * 16;
    bf16x8 kf[DK / 8];
#pragma unroll
    for (int d0 = 0; d0 < DK / 16; ++d0) { kf[2 * d0] = *(const FA_LAS bf16x8*)(kb + d0 * 2048); kf[2 * d0 + 1] = *(const FA_LAS bf16x8*)(kb + d0 * 2048 + 512); }
    __builtin_amdgcn_sched_barrier(0);
#pragma unroll
    for (int d0 = 0; d0 < DK / 16; ++d0) {
        if (d0 == 0) { p0 = FA_MFMA(kf[0], qr[0], negm); p1 = FA_MFMA(kf[1], qr[0], negm); } else { p0 = FA_MFMA(kf[2 * d0], qr[d0], p0); p1 = FA_MFMA(kf[2 * d0 + 1], qr[d0], p1); } }
}
__device__ __forceinline__ void mask_range(f32x16& p0, f32x16& p1, int kidx0, int klo, int khi, int hi) {
#pragma unroll
    for (int r = 0; r < 16; ++r) { const int k0 = kidx0 + (r & 3) + 8 * (r >> 2) + 4 * hi, k1 = k0 + 32;
        if (k0 < klo || k0 > khi) p0[r] = -INFINITY; if (k1 < klo || k1 > khi) p1[r] = -INFINITY; }
}
__device__ __forceinline__ void softmax_step(Run& R, f32x16& p0, f32x16& p1, FA_LAS float* wsf, int r32, int hi, bool rowok = true) {
    const bool first = !R.started; R.started = true;
    float rm = rowmax(p0, p1); rm = rowok ? rm : -INFINITY;
    if (first || __any(rm > FA_THR)) { const float dl = first ? __builtin_fmaxf(rm, -64.f) : __builtin_fmaxf(rm, 0.f); R.mref += dl;
#pragma unroll
        for (int r = 0; r < 16; ++r) { p0[r] -= dl; p1[r] -= dl; R.negm[r] = -R.mref; }
        if (!first) { const float f = __builtin_amdgcn_exp2f(-dl); R.l *= f; if (hi == 0) wsf[r32] = f;
            asm volatile("s_waitcnt lgkmcnt(0)" ::: "memory");
#pragma unroll
            for (int r = 0; r < 16; ++r) { const float fr_ = wsf[crow(r, hi)]; R.o0[r] *= fr_; R.o1[r] *= fr_; }
            asm volatile("s_waitcnt lgkmcnt(0)" ::: "memory"); } }
    float s0 = 0.f, s1 = 0.f, s2 = 0.f, s3 = 0.f;
#pragma unroll
    for (int r = 0; r < 16; r += 2) { p0[r] = __builtin_amdgcn_exp2f(p0[r]); p0[r + 1] = __builtin_amdgcn_exp2f(p0[r + 1]); p1[r] = __builtin_amdgcn_exp2f(p1[r]); p1[r + 1] = __builtin_amdgcn_exp2f(p1[r + 1]);
        s0 += p0[r]; s1 += p0[r + 1]; s2 += p1[r]; s3 += p1[r + 1]; }
    const float st = (s0 + s1) + (s2 + s3); R.l += rowok ? st : 0.f;
}
__device__ __forceinline__ void pack_p(u32x4 (&pw)[4], const f32x16& p0, const f32x16& p1) {
    pw[0] = (u32x4){cvtpk(p0[0], p0[1]), cvtpk(p0[2], p0[3]), cvtpk(p0[4], p0[5]), cvtpk(p0[6], p0[7])};
    pw[1] = (u32x4){cvtpk(p0[8], p0[9]), cvtpk(p0[10], p0[11]), cvtpk(p0[12], p0[13]), cvtpk(p0[14], p0[15])};
    pw[2] = (u32x4){cvtpk(p1[0], p1[1]), cvtpk(p1[2], p1[3]), cvtpk(p1[4], p1[5]), cvtpk(p1[6], p1[7])};
    pw[3] = (u32x4){cvtpk(p1[8], p1[9]), cvtpk(p1[10], p1[11]), cvtpk(p1[12], p1[13]), cvtpk(p1[14], p1[15])};
}
__device__ __forceinline__ void pv_pw(f32x16& o0, f32x16& o1, const u32x4 (&pw)[4], lds_cptr vslot, int lane, int hi) {
    const lds_cptr vp = vslot + ((lane >> 4) & 1) * 32 + (lane & 3) * 8 + (4 * hi + ((lane & 15) >> 2)) * 64;
    s16x4 vl0[4], vh0[4], vl1[4], vh1[4];
#pragma unroll
    for (int ks = 0; ks < 4; ++ks) { vl0[ks] = vtr(vp + ks * 1024); vh0[ks] = vtr(vp + ks * 1024 + 512); vl1[ks] = vtr(vp + 4096 + ks * 1024); vh1[ks] = vtr(vp + 4096 + ks * 1024 + 512); }
    __builtin_amdgcn_sched_barrier(0);
#pragma unroll
    for (int ks = 0; ks < 4; ++ks) { const bf16x8 pa = __builtin_bit_cast(bf16x8, pw[ks]);
        o0 = FA_MFMA(pa, ((bf16x8){vl0[ks][0], vl0[ks][1], vl0[ks][2], vl0[ks][3], vh0[ks][0], vh0[ks][1], vh0[ks][2], vh0[ks][3]}), o0);
        o1 = FA_MFMA(pa, ((bf16x8){vl1[ks][0], vl1[ks][1], vl1[ks][2], vl1[ks][3], vh1[ks][0], vh1[ks][1], vh1[ks][2], vh1[ks][3]}), o1); }
}
__device__ __forceinline__ void pv(f32x16& o0, f32x16& o1, const f32x16& p0, const f32x16& p1, lds_cptr vslot, int lane, int hi, bool rowok = true) {
    u32x4 pw[4];
    pw[0] = (u32x4){cvtpk(p0[0], p0[1]), cvtpk(p0[2], p0[3]), cvtpk(p0[4], p0[5]), cvtpk(p0[6], p0[7])};
    pw[1] = (u32x4){cvtpk(p0[8], p0[9]), cvtpk(p0[10], p0[11]), cvtpk(p0[12], p0[13]), cvtpk(p0[14], p0[15])};
    pw[2] = (u32x4){cvtpk(p1[0], p1[1]), cvtpk(p1[2], p1[3]), cvtpk(p1[4], p1[5]), cvtpk(p1[6], p1[7])};
    pw[3] = (u32x4){cvtpk(p1[8], p1[9]), cvtpk(p1[10], p1[11]), cvtpk(p1[12], p1[13]), cvtpk(p1[14], p1[15])};
#pragma unroll
    for (int k = 0; k < 4; ++k) { pw[k].x = rowok ? pw[k].x : 0u; pw[k].y = rowok ? pw[k].y : 0u; pw[k].z = rowok ? pw[k].z : 0u; pw[k].w = rowok ? pw[k].w : 0u; }
    const lds_cptr vp = vslot + ((lane >> 4) & 1) * 32 + (lane & 3) * 8 + (4 * hi + ((lane & 15) >> 2)) * 64;
#pragma unroll
    for (int ks = 0; ks < 4; ++ks) {
        const s16x4 l0 = vtr(vp + ks * 1024), h0 = vtr(vp + ks * 1024 + 512), l1 = vtr(vp + 4096 + ks * 1024), h1 = vtr(vp + 4096 + ks * 1024 + 512);
        const bf16x8 pa = __builtin_bit_cast(bf16x8, pw[ks]);
        o0 = FA_MFMA(pa, ((bf16x8){l0[0], l0[1], l0[2], l0[3], h0[0], h0[1], h0[2], h0[3]}), o0);
        o1 = FA_MFMA(pa, ((bf16x8){l1[0], l1[1], l1[2], l1[3], h1[0], h1[1], h1[2], h1[3]}), o1); }
}
__device__ __forceinline__ void run_finish(Run& R, float (&rli)[16], FA_LAS float* wsf, int r32, int hi) {
    const float lt = swap_sum(R.l);
    asm volatile("s_waitcnt lgkmcnt(0)" ::: "memory");
    if (hi == 0) wsf[32 + r32] = lt;
    asm volatile("s_waitcnt lgkmcnt(0)" ::: "memory");
#pragma unroll
    for (int r = 0; r < 16; ++r) rli[r] = 1.0f / __builtin_fmaxf(wsf[32 + crow(r, hi)], 1e-30f);
    asm volatile("s_waitcnt lgkmcnt(0)" ::: "memory");
}
}
constexpr int NWAVES = 8;
constexpr int BATCH = 8, SEQ = 4096, MROWS = BATCH * SEQ, DM = 1024, FF = 2816;
constexpr int HYN = 2048, NSAN = 2560;
constexpr float LOG2E = 1.4426950408889634f;
constexpr size_t MiB = 1u << 20;
constexpr size_t WS_CTL = 0, CTL_ZERO_BYTES = 1 * MiB;
constexpr size_t WS_WGU = 2 * MiB;
constexpr size_t WS_WD = 46 * MiB;
constexpr size_t WS_WIN0 = 68 * MiB;
constexpr size_t WS_WUQ = 72 * MiB;
constexpr size_t WS_WUKV = 72 * MiB + 512 * 1024;
constexpr size_t WS_WOUT0 = 73 * MiB;
constexpr size_t WS_WIN1 = 75 * MiB;
constexpr size_t WS_WOUT1 = 81 * MiB;
constexpr size_t WS_CW1 = 83 * MiB;
constexpr size_t WS_WGT = 80 * MiB + 512 * 1024;
constexpr size_t WS_CW2 = 80 * MiB + 768 * 1024;
constexpr size_t WS_ROPE0 = 84 * MiB;
constexpr size_t WS_ROPE1 = 88 * MiB;
constexpr size_t WS_SSQ = 96 * MiB;
constexpr size_t WS_SSQQ = 98 * MiB;
constexpr size_t WS_SSQKV = 98 * MiB + 512 * 1024;
constexpr size_t WS_KR = 99 * MiB;
constexpr size_t WS_GA = 103 * MiB;
constexpr size_t WS_BIAS1 = 105 * MiB;
constexpr size_t WS_GT = 106 * MiB;
constexpr size_t WS_DEC = 112 * MiB;
constexpr size_t WS_KCMP = 113 * MiB, WS_VCMP = 114 * MiB;
constexpr size_t WS_HB = 116 * MiB;
constexpr size_t WS_BIG = 180 * MiB;
constexpr size_t WS_HID = WS_BIG;
constexpr size_t WS_U0 = WS_BIG;
constexpr size_t WS_QM = 308 * MiB;
constexpr size_t WS_KF = 356 * MiB;
constexpr size_t WS_VM = 404 * MiB;
constexpr size_t WS_O0 = 436 * MiB;
constexpr size_t WS_QN = WS_BIG;
constexpr size_t WS_KV6 = 244 * MiB;
constexpr size_t WS_O1 = 340 * MiB;
constexpr size_t WS_END = 500 * MiB;
constexpr int CW_TMO = 0;
constexpr int CW_BAR = 4096;
constexpr int CW_Q0 = 8192, CW_Q1 = 8192 + 4096;
constexpr int RING_OFF = 0, RING_BYTES = 151552;
constexpr int LDSCTL_OFF = RING_BYTES, MISC_OFF = LDSCTL_OFF + 320;
constexpr int LDS_BYTES = 155648;
static_assert(MISC_OFF + 128 <= LDS_BYTES, "LDS map");

#define GAS __attribute__((address_space(1)))
#define LAS __attribute__((address_space(3)))
typedef unsigned short bf16;
typedef unsigned v4u __attribute__((ext_vector_type(4)));
typedef float f32x4 __attribute__((ext_vector_type(4)));
typedef float f32x2 __attribute__((ext_vector_type(2)));
typedef float f32x16 __attribute__((ext_vector_type(16)));
typedef short bf16x8 __attribute__((ext_vector_type(8)));
typedef GAS unsigned gu32;
#define RLX_AGENT __ATOMIC_RELAXED, __HIP_MEMORY_SCOPE_AGENT
#define LDS_WAIT() asm volatile("s_waitcnt lgkmcnt(0)" ::: "memory")
#define VM_WAIT() asm volatile("s_waitcnt vmcnt(0)" ::: "memory")
__device__ __forceinline__ unsigned f2bf(float f) { unsigned u = __builtin_bit_cast(unsigned, f); return (u + 0x7fffu + ((u >> 16) & 1u)) >> 16; }
__device__ __forceinline__ unsigned pk2(float lo, float hi) { return f2bf(lo) | (f2bf(hi) << 16); }
__device__ __forceinline__ float bf2f(unsigned short b) { return __builtin_bit_cast(float, (unsigned)b << 16); }

#define XB_TMO      128
#define XB_XCNT(j)  (256  + 64 * (j))
#define XB_XSUB(j)  (1280 + 64 * (j))
#define XB_XGEN(j)  (2304 + 64 * (j))
#define XB_TOP      3328
#define XB_TOPGEN   3392
#define XCD_BAR_WORDS 3456
#define XB_SPIN_CAP (1u << 18)
__device__ __forceinline__ unsigned xb_ld(unsigned* p)              { return __hip_atomic_load(p, __ATOMIC_RELAXED, __HIP_MEMORY_SCOPE_AGENT); }
__device__ __forceinline__ unsigned xb_add(unsigned* p, unsigned v) { return __hip_atomic_fetch_add(p, v, __ATOMIC_RELAXED, __HIP_MEMORY_SCOPE_AGENT); }
__device__ __forceinline__ unsigned xb_xcc_id() { return (unsigned)__builtin_amdgcn_s_getreg((3 << 11) | 20) & 0xFu; }
#define XB_SPIN(cond, bar) do { unsigned _sp = 0; while (cond) { __builtin_amdgcn_s_sleep(1); \
    if ((++_sp & 255u) == 0u) { if (xb_ld(&(bar)[XB_TMO])) break; if (_sp > XB_SPIN_CAP) { atomicAdd(&(bar)[XB_TMO], 1u); break; } } } } while (0)
struct XcdBarrier { unsigned* bar; unsigned x; volatile LAS unsigned* st; };
__device__ __forceinline__ XcdBarrier xcd_barrier_post(unsigned* bar, volatile LAS unsigned* st) {
    XcdBarrier b; b.bar = bar; b.x = xb_xcc_id(); b.st = st;
    if (threadIdx.x == 0) (void)xb_add(&bar[XB_XCNT(b.x)], 1u);
    return b;
}
__device__ __forceinline__ void xcd_barrier_complete(unsigned* bar, unsigned x, unsigned& nloc, unsigned& nx) {
    const unsigned G = gridDim.x * gridDim.y * gridDim.z;
    unsigned sum, cnt, mine, sp = 0u;
    for (;;) {
        sum = 0u; cnt = 0u; mine = 0u;
#pragma unroll
        for (unsigned j = 0; j < 16; ++j) { const unsigned c = xb_ld(&bar[XB_XCNT(j)]); sum += c; cnt += (c > 0u) ? 1u : 0u; mine = (j == x) ? c : mine; }
        if (sum == G) break;
        __builtin_amdgcn_s_sleep(1);
        if ((++sp & 255u) == 0u) { if (xb_ld(&bar[XB_TMO])) break; if (sp > XB_SPIN_CAP) { atomicAdd(&bar[XB_TMO], 1u); break; } }
    }
    nloc = mine > 0u ? mine : 1u; nx = cnt > 0u ? cnt : 1u;
}
__device__ __forceinline__ void xcd_barrier(const XcdBarrier& b) {
    asm volatile("s_waitcnt vmcnt(0)" ::: "memory");
    __syncthreads();
    if (threadIdx.x == 0) {
        unsigned* bar = b.bar;
        __builtin_amdgcn_s_waitcnt(0);
        unsigned nloc = b.st[0], nx = b.st[1];
        if (nloc == 0u) { xcd_barrier_complete(bar, b.x, nloc, nx); b.st[0] = nloc; b.st[1] = nx; }
        const unsigned old = xb_add(&bar[XB_XSUB(b.x)], 1u);
        const unsigned gen = old / nloc;
        if (old + 1u == (gen + 1u) * nloc) {
            __builtin_amdgcn_fence(__ATOMIC_RELEASE, "agent");
            asm volatile("s_waitcnt vmcnt(0)" ::: "memory");
            const unsigned og = xb_add(&bar[XB_TOP], 1u);
            const unsigned tg = og / nx;
            if (og + 1u == (tg + 1u) * nx) xb_add(&bar[XB_TOPGEN], 1u);
            else XB_SPIN(xb_ld(&bar[XB_TOPGEN]) == tg, bar);
            __builtin_amdgcn_fence(__ATOMIC_ACQUIRE, "agent");
            xb_add(&bar[XB_XGEN(b.x)], 1u);
            asm volatile("s_waitcnt vmcnt(0)" ::: "memory");
        } else {
            XB_SPIN(xb_ld(&bar[XB_XGEN(b.x)]) == gen, bar);
            __builtin_amdgcn_fence(__ATOMIC_ACQUIRE, "agent");
            asm volatile("s_waitcnt vmcnt(0)" ::: "memory");
        }
    }
    __syncthreads();
}

struct Frame {
    LAS unsigned char* lds;
    volatile LAS unsigned* MISC;
    gu32* ctl;
    int vcu, G;
    unsigned char* ws;
};
__device__ __forceinline__ int opaque_tid() { int t = threadIdx.x; asm volatile("" : "+v"(t)); return t; }
__device__ __forceinline__ float wave_sum(float v) {
#pragma unroll
    for (int o = 1; o < 64; o <<= 1) v += __shfl_xor(v, o);
    return v;
}
__device__ __forceinline__ int wq_next(Frame& F, int word) {
    if (threadIdx.x == 0) F.MISC[0] = __hip_atomic_fetch_add((unsigned*)(F.ctl + word), 1u, __ATOMIC_RELAXED, __HIP_MEMORY_SCOPE_AGENT);
    __syncthreads(); const int v = (int)F.MISC[0]; __syncthreads(); return v;
}
struct Inputs {
    const float* x; const int* pos; const float* ffn_norm; const float* w_gate; const float* w_up; const float* w_down; const float* mix_norm;
    const float* hy_w_in; const float* q_norm; const float* w_uq; const float* kv_norm; const float* w_ukv; const float* w_a2; const float* b_a; const float* gla_norm; const float* hy_w_out;
    const float* nsa_w_in; const float* pos_k; const float* pos_v; const float* ck_w1; const float* ck_w2; const float* cv_w1; const float* cv_w2; const float* nsa_w_out; const float* final_norm;
};
struct ColSrc { const float* p; int ldn; };
__device__ __forceinline__ ColSrc map_gateup(const float* wg, const float* wu, int n) { const int T = n >> 8, j = n & 255; ColSrc c; c.ldn = FF; c.p = (j < 128) ? wg + T * 128 + j : wu + T * 128 + (j - 128); return c; }
__device__ __forceinline__ ColSrc map_ident(const float* w, int ldn, int n) { ColSrc c; c.ldn = ldn; c.p = w + n; return c; }
__device__ __forceinline__ ColSrc map_hyin(const float* w, int n) {
    ColSrc c; c.ldn = 1968; int s;
    if (n < 256) s = n; else if (n < 384) s = n; else if (n < 416) s = 384 + (n - 384); else if (n < 432) s = 1440 + (n - 416); else if (n < 512) s = -1;
    else if (n < 1024) s = 416 + (n - 512); else if (n < 1536) s = 928 + (n - 1024); else s = 1456 + (n - 1536);
    c.p = (s < 0) ? nullptr : w + s; return c; }
__device__ __forceinline__ ColSrc map_wuq(const float* w, int n) {
    ColSrc c; c.ldn = 768; int s;
    if (n < 512) s = (n >> 6) * 96 + (n & 63); else if (n < 640) { const int j = n - 512; s = (j >> 4) * 96 + 64 + (j & 15); } else { const int j = n - 640; s = (j >> 4) * 96 + 80 + (j & 15); }
    c.p = w + s; return c; }
__device__ __forceinline__ ColSrc map_nsain(const float* w, int n) {
    ColSrc c; c.ldn = 2608; const int T = n >> 8, j = n & 255; int s;
    if (T < 4) { const int hh = (j & 127) >> 5, i = j & 31; s = (4 * T + hh) * 64 + (j >> 7) * 32 + i; }
    else if (T == 6 || T == 8) { const int g = (j & 127) >> 5, i = j & 31; s = 1024 + (T - 4) * 256 + g * 64 + (j >> 7) * 32 + i; }
    else s = 1024 + (T - 4) * 256 + j;
    c.p = (s < 0) ? nullptr : w + s; return c; }
__device__ __forceinline__ ColSrc map_gates(const float* w, int n) { ColSrc c; c.ldn = 2608; c.p = (n < 48) ? w + 2560 + n : nullptr; return c; }
template <class Map> __device__ __forceinline__ void p0_item(const Map& mp, int K, bf16* WT, const float* gain, LAS float* scr, int kb, int nb, int lane) {
    const int k0 = 64 * kb, n0 = 64 * nb; const ColSrc cs = mp(n0 + lane);
    float v[64];
#pragma unroll
    for (int i = 0; i < 64; ++i) v[i] = cs.p ? cs.p[(size_t)(k0 + i) * cs.ldn] : 0.f;
#pragma unroll
    for (int i = 0; i < 64; ++i) scr[i * 65 + lane] = gain ? v[i] * gain[k0 + i] : v[i];
    LDS_WAIT(); asm volatile("" ::: "memory");
    const int c = lane & 7;
#pragma unroll
    for (int j = 0; j < 8; ++j) { const int n = (lane >> 3) + 8 * j; const LAS float* s = scr + (8 * c) * 65 + n;
        v4u o; o.x = pk2(s[0 * 65], s[1 * 65]); o.y = pk2(s[2 * 65], s[3 * 65]); o.z = pk2(s[4 * 65], s[5 * 65]); o.w = pk2(s[6 * 65], s[7 * 65]);
        *(GAS v4u*)(WT + (size_t)(n0 + n) * K + k0 + 8 * c) = o; }
    LDS_WAIT(); asm volatile("" ::: "memory");
}
__device__ __forceinline__ void sincos_d(double x, float& sn, float& cs) {
    const double k = rint(x * 0.63661977236758134308); double r = fma(-k, 1.57079632679489655800, x); r = fma(-k, 6.12323399573676603587e-17, r);
    const double r2 = r * r;
    double s = -7.6471637318198164759e-13; s = s * r2 + 1.6059043836821614599e-10; s = s * r2 - 2.5052108385441718775e-08; s = s * r2 + 2.7557319223985890653e-06; s = s * r2 - 1.9841269841269841270e-04; s = s * r2 + 8.3333333333333333333e-03; s = s * r2 - 1.6666666666666666667e-01; s = r + r * r2 * s;
    double c = 4.7794773323873852974e-14; c = c * r2 - 1.1470745597729724714e-11; c = c * r2 + 2.0876756987868098979e-09; c = c * r2 - 2.7557319223985890653e-07; c = c * r2 + 2.4801587301587301587e-05; c = c * r2 - 1.3888888888888888889e-03; c = c * r2 + 4.1666666666666666667e-02; c = c * r2 - 0.5; c = 1.0 + r2 * c;
    const int q = ((int)k) & 3; const double ss = (q == 0) ? s : (q == 1) ? c : (q == 2) ? -s : -c, cc = (q == 0) ? c : (q == 1) ? -s : (q == 2) ? -c : s;
    sn = (float)ss; cs = (float)cc;
}
struct RopeFreq { double f16[16]; double f32[32]; };
__device__ __forceinline__ void p0_prologue(Frame& F, const Inputs& I, const RopeFreq& RF) {
    const int tid = opaque_tid(), lane = tid & 63, wave = __builtin_amdgcn_readfirstlane(tid >> 6);
    LAS float* scr = (LAS float*)(F.lds + RING_OFF + wave * 16896);
    const int gw = F.vcu * NWAVES + wave, NGW = F.G * NWAVES;
    unsigned char* ws = F.ws;
    constexpr int I_GU = 16 * 88, I_DN = 44 * 16, I_IN0 = 16 * 32, I_UQ = 16 * 24, I_UKV = 8 * 32, I_OUT = 16 * 16, I_IN1 = 16 * 40, I_CW = 32 * 4, I_GT = 64, I_CW2 = 32;
    constexpr int NITEMS = 4 * I_GU + 4 * I_DN + I_IN0 + I_UQ + I_UKV + I_OUT + I_IN1 + I_OUT + 2 * I_CW + I_GT + I_CW2;
    for (int it = gw; it < NITEMS; it += NGW) {
        int r = it;
        if (r < 4 * I_GU) { const int f = r / I_GU; r -= f * I_GU; const float* wg = I.w_gate + (size_t)f * DM * FF; const float* wu = I.w_up + (size_t)f * DM * FF;
            auto mp = [&](int n) { return map_gateup(wg, wu, n); }; p0_item(mp, DM, (bf16*)(ws + WS_WGU) + (size_t)f * 5632 * DM, I.ffn_norm + f * DM, scr, r / 88, r % 88, lane); continue; } r -= 4 * I_GU;
        if (r < 4 * I_DN) { const int f = r / I_DN; r -= f * I_DN; const float* w = I.w_down + (size_t)f * FF * DM;
            auto mp = [&](int n) { return map_ident(w, DM, n); }; p0_item(mp, FF, (bf16*)(ws + WS_WD) + (size_t)f * DM * FF, nullptr, scr, r / 16, r % 16, lane); continue; } r -= 4 * I_DN;
        if (r < I_IN0) { auto mp = [&](int n) { return map_hyin(I.hy_w_in, n); }; p0_item(mp, DM, (bf16*)(ws + WS_WIN0), I.mix_norm, scr, r / 32, r % 32, lane); continue; } r -= I_IN0;
        if (r < I_UQ) { const int ks = r / 24, nblk = r % 24, r32 = lane & 31, hi = lane >> 5;
            const int col = (nblk < 16) ? ((32 * nblk + r32) >> 6) * 96 + ((32 * nblk + r32) & 63) : (2 * ((nblk - 16) & 3) + (r32 >> 4)) * 96 + (nblk < 20 ? 64 : 80) + (r32 & 15);
            float v[8];
#pragma unroll
            for (int j = 0; j < 8; ++j) { const int k = 16 * ks + 8 * hi + j; v[j] = I.w_uq[(size_t)k * 768 + col] * I.q_norm[k]; }
            v4u o; o.x = pk2(v[0], v[1]); o.y = pk2(v[2], v[3]); o.z = pk2(v[4], v[5]); o.w = pk2(v[6], v[7]); *(v4u*)((bf16*)(ws + WS_WUQ) + (size_t)r * 512 + lane * 8) = o; continue; } r -= I_UQ;
        if (r < I_UKV) { const int ks = r / 32, nblk = r % 32, r32 = lane & 31, hi = lane >> 5;
            float v[8];
#pragma unroll
            for (int j = 0; j < 8; ++j) { const int k = 16 * ks + 8 * hi + j; v[j] = I.w_ukv[(size_t)k * 1024 + 32 * nblk + r32] * I.kv_norm[k]; }
            v4u o; o.x = pk2(v[0], v[1]); o.y = pk2(v[2], v[3]); o.z = pk2(v[4], v[5]); o.w = pk2(v[6], v[7]); *(v4u*)((bf16*)(ws + WS_WUKV) + (size_t)r * 512 + lane * 8) = o; continue; } r -= I_UKV;
        if (r < I_OUT) { auto mp = [&](int n) { return map_ident(I.hy_w_out, DM, n); }; p0_item(mp, DM, (bf16*)(ws + WS_WOUT0), nullptr, scr, r / 16, r % 16, lane); continue; } r -= I_OUT;
        if (r < I_IN1) { auto mp = [&](int n) { return map_nsain(I.nsa_w_in, n); }; p0_item(mp, DM, (bf16*)(ws + WS_WIN1), I.mix_norm + DM, scr, r / 40, r % 40, lane); continue; } r -= I_IN1;
        if (r < I_OUT) { auto mp = [&](int n) { return map_ident(I.nsa_w_out, DM, n); }; p0_item(mp, DM, (bf16*)(ws + WS_WOUT1), nullptr, scr, r / 16, r % 16, lane); continue; } r -= I_OUT;
        if (r < 2 * I_CW) { const int kv = r / I_CW; r -= kv * I_CW; const float* w = kv ? I.cv_w1 : I.ck_w1;
            const int r32 = lane & 31, hi = lane >> 5; const float* wp = w + (size_t)(r * 16 + 8 * hi) * 128 + r32; bf16* dst = (bf16*)(ws + WS_CW1) + (size_t)kv * 262144 + (size_t)r * 2048 + lane * 8;
            float v[4][8];
#pragma unroll
            for (int q = 0; q < 4; ++q)
#pragma unroll
                for (int j = 0; j < 8; ++j) v[q][j] = wp[(size_t)j * 128 + 32 * q];
#pragma unroll
            for (int q = 0; q < 4; ++q) { v4u o; o.x = pk2(v[q][0], v[q][1]); o.y = pk2(v[q][2], v[q][3]); o.z = pk2(v[q][4], v[q][5]); o.w = pk2(v[q][6], v[q][7]); *(v4u*)(dst + q * 512) = o; }
            continue; } r -= 2 * I_CW;
        if (r >= I_GT) { r -= I_GT; const int kv = r >> 4, ks = (r >> 1) & 7, nblk = r & 1, r32 = lane & 31, hi = lane >> 5; const float* w2 = kv ? I.cv_w2 : I.ck_w2;
            float v[8];
#pragma unroll
            for (int j = 0; j < 8; ++j) v[j] = w2[(size_t)(16 * ks + 8 * hi + j) * 64 + 32 * nblk + r32];
            v4u o; o.x = pk2(v[0], v[1]); o.y = pk2(v[2], v[3]); o.z = pk2(v[4], v[5]); o.w = pk2(v[6], v[7]); *(v4u*)((bf16*)(ws + WS_CW2) + (size_t)r * 512 + lane * 8) = o; continue; }
        { const int r32 = lane & 31, hi = lane >> 5; const float* gm = I.mix_norm + DM;
            bf16* dst = (bf16*)(ws + WS_WGT) + (size_t)r * 1024 + lane * 8;
#pragma unroll
            for (int q = 0; q < 2; ++q) { float v[8]; const int n = 32 * q + r32;
#pragma unroll
                for (int j = 0; j < 8; ++j) { const int k = 16 * r + 8 * hi + j; v[j] = (n < 48) ? I.nsa_w_in[(size_t)k * 2608 + 2560 + n] * gm[k] : 0.f; }
                v4u o; o.x = pk2(v[0], v[1]); o.y = pk2(v[2], v[3]); o.z = pk2(v[4], v[5]); o.w = pk2(v[6], v[7]); *(v4u*)(dst + q * 512) = o; } }
    }
    bf16* hb = (bf16*)(ws + WS_HB); float* ssq = (float*)(ws + WS_SSQ);
    for (int m0 = 4 * gw; m0 < MROWS; m0 += 4 * NGW) {
        f32x4 v[4][4];
#pragma unroll
        for (int q = 0; q < 4; ++q) { const GAS f32x4* xr = (const GAS f32x4*)(I.x + (size_t)(m0 + q) * DM) + lane;
#pragma unroll
            for (int j = 0; j < 4; ++j) v[q][j] = xr[64 * j]; }
#pragma unroll
        for (int q = 0; q < 4; ++q) { float s = 0.f;
#pragma unroll
            for (int j = 0; j < 4; ++j) s += (v[q][j][0] * v[q][j][0] + v[q][j][1] * v[q][j][1]) + (v[q][j][2] * v[q][j][2] + v[q][j][3] * v[q][j][3]);
            s = wave_sum(s);
            GAS unsigned long long* o8 = (GAS unsigned long long*)(hb + (size_t)(m0 + q) * DM) + lane;
#pragma unroll
            for (int j = 0; j < 4; ++j) o8[64 * j] = (unsigned long long)pk2(v[q][j][0], v[q][j][1]) | ((unsigned long long)pk2(v[q][j][2], v[q][j][3]) << 32);
            if (lane < 16) ssq[(size_t)(m0 + q) * 16 + lane] = (lane == 0) ? s : 0.f; }
    }
    { const int gt = (F.vcu * NWAVES + wave) * 64 + lane, NGT = NGW * 64;
      f32x2* r0 = (f32x2*)(ws + WS_ROPE0); f32x2* r1 = (f32x2*)(ws + WS_ROPE1);
      for (int e = gt; e < MROWS * 48; e += NGT) { const int row = e / 48, j = e % 48; const double p = (double)I.pos[row];
          float sn, cs; if (j < 16) { sincos_d(p * RF.f16[j], sn, cs); r0[(size_t)row * 16 + j] = (f32x2){cs, sn}; } else { sincos_d(p * RF.f32[j - 16], sn, cs); r1[(size_t)row * 32 + (j - 16)] = (f32x2){cs, sn}; } } }
    for (int o = gw; o < 256; o += NGW) { const int kv = o >> 7, j = o & 127; const float* w = kv ? I.cv_w1 : I.ck_w1; const float* pe = kv ? I.pos_v : I.pos_k; float s = 0.f;
#pragma unroll
        for (int t = 0; t < 32; ++t) s += pe[lane + 64 * t] * w[(size_t)(lane + 64 * t) * 128 + j];
        s = wave_sum(s); if (lane == 0) ((float*)(ws + WS_BIAS1))[o] = s; }
}
constexpr int ML_NS = 5, ML_K = 0, ML_KSLOT = 12288, ML_V = ML_NS * ML_KSLOT, ML_VSLOT = 8192, ML_WS = ML_V + ML_NS * ML_VSLOT, ML_OST = ML_WS + 8 * 512, ML_END = ML_OST + 8 * 4096;
constexpr int NS_K = 0, NS_KSLOT = 8192, NS_V = 3 * NS_KSLOT, NS_VSLOT = 8192, NS_WS = NS_V + 4 * NS_VSLOT, NS_IMP = NS_WS + 8 * 512, NS_CK = NS_IMP + 16384, NS_CV = NS_CK + 32768, NS_END = NS_CV + 32768;
constexpr int AT_END = NS_END > ML_END ? NS_END : ML_END;
static_assert(AT_END <= RING_BYTES, "attention LDS map");
template <class RowPtr> __device__ __forceinline__ void store_o_tile(const f32x16& o0, const f32x16& o1, LAS unsigned char* stage, int lane, const RowPtr& rowptr) {
    const int r32 = lane & 31, hi = lane >> 5; LAS unsigned short* stg = (LAS unsigned short*)stage;
#pragma unroll
    for (int r = 0; r < 16; ++r) { const int orow = fa::crow(r, hi); stg[orow * 64 + r32] = (unsigned short)f2bf(o0[r]); stg[orow * 64 + 32 + r32] = (unsigned short)f2bf(o1[r]); }
    LDS_WAIT();
#pragma unroll
    for (int i = 0; i < 4; ++i) { const int row = i * 8 + (lane >> 3), ch = lane & 7; const v4u v = *(const LAS v4u*)(stg + row * 64 + ch * 8); *(v4u*)(rowptr(row) + ch * 8) = v; }
    LDS_WAIT();
}
__device__ __forceinline__ void mla_attn_unit(Frame& F, int b, int h, int qb, const bf16* QM, const bf16* KF, const bf16* VM, bf16* O0) {
    const int tid = opaque_tid(), lane = tid & 63, r32 = lane & 31, hi = lane >> 5, wid = __builtin_amdgcn_readfirstlane(tid >> 6);
    const size_t rowbase = (size_t)b * SEQ; const int q0 = qb * 256, NT = (q0 + 256) / 64;
    const fa::lds_cptr L = (fa::lds_cptr)(F.lds + RING_OFF); const unsigned l0 = fa::lds_addr(L);
    LAS float* wsf = (LAS float*)(F.lds + RING_OFF + ML_WS) + wid * 128;
    const bf16* Qw = QM + (rowbase + q0 + wid * 32 + r32) * 768 + h * 96;
    fa::bf16x8 qr[6];
#pragma unroll
    for (int d0 = 0; d0 < 6; ++d0) qr[d0] = *(const fa::bf16x8*)(Qw + d0 * 16 + hi * 8);
    __builtin_amdgcn_s_waitcnt(0x0F70);
    const bf16* Kh = KF + rowbase * 768 + h * 96; const bf16* Vh = VM + rowbase * 512 + h * 64;
    const int qpos = q0 + wid * 32 + r32, wq_lo = q0 + wid * 32, my_last = (wq_lo + 31) >> 6;
    const bool g1 = wid >= 4;
    fa::Run R; fa::run_init(R);
    auto dma_tile = [&](int t, int slot) { fa::dma_k<96>(Kh + (size_t)t * 64 * 768, 768, l0 + ML_K + slot * ML_KSLOT, wid, lane); fa::dma_v(Vh + (size_t)t * 64 * 512, 512, l0 + ML_V + slot * ML_VSLOT, wid, lane); };
    dma_tile(0, 0); dma_tile(1, 1); dma_tile(2, 2);
    if (g1) FA_WAIT_BAR(6);
    FA_WAIT_BAR(6);
    fa::u32x4 pw[4] = {}; fa::f32x16 p0 = fa::f32x16{}, p1 = fa::f32x16{};
    int sc = 0, sp = 0, sn = 3;
    for (int t = 0; t < NT; ++t) {
        if (t + 3 < NT) dma_tile(t + 3, sn);
        __builtin_amdgcn_s_setprio(1);
        if (t > 0 && t - 1 <= my_last) fa::pv_pw(R.o0, R.o1, pw, L + ML_V + sp * ML_VSLOT, lane, hi);
        if (t <= my_last) fa::qkt<96>(p0, p1, L + ML_K + sc * ML_KSLOT, qr, R.negm, r32, hi);
        __builtin_amdgcn_s_setprio(0);
        if (t + 3 < NT) FA_WAIT_BAR(6); else if (t + 2 < NT) FA_WAIT_BAR(3); else FA_WAIT_BAR(0);
        __builtin_amdgcn_sched_barrier(0);
        if (t <= my_last) {
            if (t * 64 + 63 > wq_lo) { asm volatile("; causal band (a real branch)"); fa::mask_range(p0, p1, t * 64, 0, qpos, hi); }
            fa::softmax_step(R, p0, p1, wsf, r32, hi);
            fa::pack_p(pw, p0, p1); }
        asm volatile("s_waitcnt lgkmcnt(0)\n\ts_barrier" ::: "memory");
        __builtin_amdgcn_sched_barrier(0);
        sp = sc; sc = (sc == ML_NS - 1) ? 0 : sc + 1; sn = (sn == ML_NS - 1) ? 0 : sn + 1;
    }
    if (NT - 1 <= my_last) fa::pv_pw(R.o0, R.o1, pw, L + ML_V + sp * ML_VSLOT, lane, hi);
    if (!g1) asm volatile("s_waitcnt lgkmcnt(0)\n\ts_barrier" ::: "memory");
    float rli[16]; fa::run_finish(R, rli, wsf, r32, hi);
#pragma unroll
    for (int r = 0; r < 16; ++r) { R.o0[r] *= rli[r]; R.o1[r] *= rli[r]; }
    bf16* Ow = O0 + (rowbase + q0 + wid * 32) * 1024 + h * 64;
    store_o_tile(R.o0, R.o1, F.lds + RING_OFF + ML_OST + wid * 4096, lane, [&](int rr) { return Ow + (size_t)rr * 1024; });
    FA_WAIT_BAR(0);
}
constexpr int UP_AQ = 0, UP_AKV = 65536, UP_RS = UP_AKV + 32768, UP_STG = UP_RS + 1024, UP_END = UP_STG + 8 * 4096;
static_assert(UP_END <= RING_BYTES, "up-projection LDS map");
__device__ __forceinline__ void mla_up_unit(Frame& F, int hm, const bf16* U0, const bf16* WUQF, const bf16* WUKVF, const float* ssqq, const float* ssqkv, const float* rope, float c2, bf16* QM, bf16* KF, bf16* VM) {
    const int tid = opaque_tid(), lane = tid & 63, r32 = lane & 31, hi = lane >> 5, wid = __builtin_amdgcn_readfirstlane(tid >> 6);
    const int rb = wid & 3, hf = wid >> 2, row0 = hm * 128, rot = (int)(blockIdx.x >> 3);
    const fa::lds_cptr L = (fa::lds_cptr)(F.lds + RING_OFF); const unsigned l0 = fa::lds_addr(L);
    LAS float* rsl = (LAS float*)(F.lds + RING_OFF + UP_RS); LAS unsigned short* stg = (LAS unsigned short*)(F.lds + RING_OFF + UP_STG + wid * 4096);
    if (tid < 256) { const int row = tid & 127; const f32x4 p = *(const f32x4*)((tid < 128 ? ssqq : ssqkv) + (size_t)(row0 + row) * 4); const float sm = (p[0] + p[1]) + (p[2] + p[3]);
        rsl[tid] = (tid < 128) ? __builtin_amdgcn_rsqf(sm * (1.0f / 256.0f) + pg8::NORM_EPS) * c2 : __builtin_amdgcn_rsqf(sm * (1.0f / 128.0f) + pg8::NORM_EPS); }
    __builtin_amdgcn_s_waitcnt(0x0F70);
#pragma unroll
    for (int q = 0; q < 8; ++q) { const int i = 8 * wid + q, p = 64 * i + lane, row = p >> 5, slot = p & 31, ch = slot ^ (row & 7);
        fa::glds16(U0 + (size_t)(row0 + row) * 2048 + ch * 8, (unsigned)__builtin_amdgcn_readfirstlane(l0 + UP_AQ + i * 1024)); }
#pragma unroll
    for (int q = 0; q < 4; ++q) { const int i = 4 * wid + q, p = 64 * i + lane, row = p >> 4, slot = p & 15, ch = slot ^ (row & 7);
        fa::glds16(U0 + (size_t)(row0 + row) * 2048 + 256 + ch * 8, (unsigned)__builtin_amdgcn_readfirstlane(l0 + UP_AKV + i * 1024)); }
    FA_WAIT_BAR(0);
    const int arow = 32 * rb + r32;
    auto put32 = [&](const fa::f32x16& v, int ncols, int coff) {
#pragma unroll
        for (int r = 0; r < 16; ++r) stg[fa::crow(r, hi) * ncols + coff] = (unsigned short)f2bf(v[r]); };
    { fa::bf16x8 af[16];
#pragma unroll
      for (int ks = 0; ks < 16; ++ks) af[ks] = *(const FA_LAS fa::bf16x8*)(L + UP_AQ + arow * 512 + (((2 * ks + hi) ^ (arow & 7)) * 16));
      float rsq[16];
#pragma unroll
      for (int r = 0; r < 16; ++r) rsq[r] = rsl[32 * rb + fa::crow(r, hi)];
      const bf16* wf = WUQF + lane * 8;
      const int nplain = hf ? 4 : 12;
      for (int t = 0; t < nplain; ++t) { const int tr = (t + rot) % nplain, nblk = hf ? 12 + tr : tr; fa::f32x16 acc = fa::f32x16{};
#pragma unroll
          for (int ks = 0; ks < 16; ++ks) acc = FA_MFMA(af[ks], *(const fa::bf16x8*)(wf + (size_t)(ks * 24 + nblk) * 512), acc);
#pragma unroll
          for (int r = 0; r < 16; ++r) acc[r] *= rsq[r];
          put32(acc, 32, r32); LDS_WAIT();
          bf16* dstb = QM + (size_t)(row0 + 32 * rb) * 768 + (nblk >> 1) * 96 + 32 * (nblk & 1);
#pragma unroll
          for (int it = 0; it < 2; ++it) { const int idx = it * 64 + lane, row = idx >> 2, ch = idx & 3; *(v4u*)(dstb + (size_t)row * 768 + ch * 8) = *(const LAS v4u*)(stg + row * 32 + ch * 8); }
          LDS_WAIT(); }
      if (hf) for (int jj = 0; jj < 4; ++jj) { const int j = (jj + rot) & 3; fa::f32x16 a1 = fa::f32x16{}, a2 = fa::f32x16{};
#pragma unroll
          for (int ks = 0; ks < 16; ++ks) { a1 = FA_MFMA(af[ks], *(const fa::bf16x8*)(wf + (size_t)(ks * 24 + 16 + j) * 512), a1); a2 = FA_MFMA(af[ks], *(const fa::bf16x8*)(wf + (size_t)(ks * 24 + 20 + j) * 512), a2); }
          fa::f32x16 y1, y2;
#pragma unroll
          for (int r = 0; r < 16; ++r) { const f32x2 cs = *(const f32x2*)(rope + ((size_t)(row0 + 32 * rb + fa::crow(r, hi)) * 16 + (r32 & 15)) * 2); const float x1 = a1[r] * rsq[r], x2 = a2[r] * rsq[r];
              y1[r] = x1 * cs[0] - x2 * cs[1]; y2[r] = x2 * cs[0] + x1 * cs[1]; }
          const int co = (r32 >> 4) * 32 + (r32 & 15);
          put32(y1, 64, co); put32(y2, 64, co + 16); LDS_WAIT();
          bf16* dstb = QM + (size_t)(row0 + 32 * rb) * 768 + (2 * j) * 96 + 64;
#pragma unroll
          for (int it = 0; it < 4; ++it) { const int idx = it * 64 + lane, row = idx >> 3, ch = idx & 7; *(v4u*)(dstb + (size_t)row * 768 + (ch >> 2) * 96 + (ch & 3) * 8) = *(const LAS v4u*)(stg + row * 64 + ch * 8); }
          LDS_WAIT(); } }
    { fa::bf16x8 af[8];
#pragma unroll
      for (int ks = 0; ks < 8; ++ks) af[ks] = *(const FA_LAS fa::bf16x8*)(L + UP_AKV + arow * 256 + (((2 * ks + hi) ^ (arow & 7)) * 16));
      float rsk[16];
#pragma unroll
      for (int r = 0; r < 16; ++r) rsk[r] = rsl[128 + 32 * rb + fa::crow(r, hi)];
      const bf16* wf = WUKVF + lane * 8;
      for (int t = 0; t < 16; ++t) { const int nblk = 16 * hf + ((t + rot) & 15); fa::f32x16 acc = fa::f32x16{};
#pragma unroll
          for (int ks = 0; ks < 8; ++ks) acc = FA_MFMA(af[ks], *(const fa::bf16x8*)(wf + (size_t)(ks * 32 + nblk) * 512), acc);
#pragma unroll
          for (int r = 0; r < 16; ++r) acc[r] *= rsk[r];
          put32(acc, 32, r32); LDS_WAIT();
          const int head = nblk >> 2, part = nblk & 3;
          bf16* dstb = (part < 2) ? KF + (size_t)(row0 + 32 * rb) * 768 + head * 96 + 32 * part : VM + (size_t)(row0 + 32 * rb) * 512 + head * 64 + 32 * (part - 2);
          const int pitch = (part < 2) ? 768 : 512;
#pragma unroll
          for (int it = 0; it < 2; ++it) { const int idx = it * 64 + lane, row = idx >> 2, ch = idx & 3; *(v4u*)(dstb + (size_t)row * pitch + ch * 8) = *(const LAS v4u*)(stg + row * 32 + ch * 8); }
          LDS_WAIT(); } }
    asm volatile("s_waitcnt lgkmcnt(0)\n\ts_barrier" ::: "memory");
}
__device__ __forceinline__ void krot_pass(Frame& F, const float* KR, const float* rope, bf16* KF) {
    const int tid = opaque_tid(); const int gt = (F.vcu * NWAVES + __builtin_amdgcn_readfirstlane(tid >> 6)) * 64 + (tid & 63), NGT = F.G * NWAVES * 64;
    for (int e = gt; e < MROWS * 8; e += NGT) { const int row = e >> 3, h = e & 7; const f32x4* kr = (const f32x4*)(KR + (size_t)row * 32); const f32x4* cs = (const f32x4*)(rope + (size_t)row * 32);
        float x[32], c[16], s[16];
#pragma unroll
        for (int i = 0; i < 8; ++i) { const f32x4 v = kr[i]; x[4 * i] = v[0]; x[4 * i + 1] = v[1]; x[4 * i + 2] = v[2]; x[4 * i + 3] = v[3]; const f32x4 t = cs[i]; c[2 * i] = t[0]; s[2 * i] = t[1]; c[2 * i + 1] = t[2]; s[2 * i + 1] = t[3]; }
        v4u o[4];
#pragma unroll
        for (int i = 0; i < 16; i += 2) { const float y0 = x[i] * c[i] - x[16 + i] * s[i], y1 = x[i + 1] * c[i + 1] - x[17 + i] * s[i + 1]; o[i >> 3][(i >> 1) & 3] = pk2(y0, y1); }
#pragma unroll
        for (int i = 0; i < 16; i += 2) { const float y0 = x[16 + i] * c[i] + x[i] * s[i], y1 = x[17 + i] * c[i + 1] + x[i + 1] * s[i + 1]; o[2 + (i >> 3)][(i >> 1) & 3] = pk2(y0, y1); }
        v4u* dst = (v4u*)(KF + (size_t)row * 768 + h * 96 + 64);
#pragma unroll
        for (int i = 0; i < 4; ++i) dst[i] = o[i]; }
}
__device__ __forceinline__ void gla_pre(Frame& F, const bf16* U0, const float* GA, const float* w_a2, const float* b_a, bf16* KD, bf16* QA, bf16* QI, float* DEC) {
    const int tid = opaque_tid(); const int gw = F.vcu * NWAVES + __builtin_amdgcn_readfirstlane(tid >> 6), NGW = F.G * NWAVES, lane = tid & 63;
    for (int u = gw; u < BATCH * 64 * 4; u += NGW) { const int h = u & 3, bn = u >> 2; const size_t tok = (size_t)bn * 64 + lane;
        float wv[16];
#pragma unroll
        for (int j = 0; j < 16; ++j) wv[j] = w_a2[j * 256 + h * 64 + lane];
        const float bav = b_a[h * 64 + lane];
        float ha[16];
#pragma unroll
        for (int i = 0; i < 4; ++i) { const f32x4 v = *(const f32x4*)(GA + tok * 16 + 4 * i); ha[4 * i] = v[0]; ha[4 * i + 1] = v[1]; ha[4 * i + 2] = v[2]; ha[4 * i + 3] = v[3]; }
        const bf16* qp = U0 + tok * 2048 + 512 + h * 64; const bf16* kp = U0 + tok * 2048 + 768 + h * 64;
        for (int dg = 0; dg < 8; ++dg) { const v4u q8 = *(const v4u*)(qp + dg * 8), k8 = *(const v4u*)(kp + dg * 8); float okd[8], oqa[8], oqi[8];
#pragma unroll
            for (int e = 0; e < 8; ++e) { const int dl_ = dg * 8 + e, d = h * 64 + dl_; float g = __builtin_bit_cast(float, __builtin_amdgcn_readlane(__builtin_bit_cast(int, bav), dl_));
#pragma unroll
                for (int j = 0; j < 16; ++j) g += ha[j] * __builtin_bit_cast(float, __builtin_amdgcn_readlane(__builtin_bit_cast(int, wv[j]), dl_));
                const float la = (__builtin_fminf(g, 0.f) - __logf(1.0f + __expf(-__builtin_fabsf(g)))) * (1.0f / 16.0f);
                float bc = la;
#pragma unroll
                for (int off = 1; off < 64; off <<= 1) { const float t = __shfl_up(bc, off); if (lane >= off) bc += t; }
                const float bl = __shfl(bc, 63);
                const unsigned qw = q8[e >> 1], kw = k8[e >> 1]; const float qv = bf2f((unsigned short)((e & 1) ? (qw >> 16) : (qw & 0xffffu))) * 0.125f, kv = bf2f((unsigned short)((e & 1) ? (kw >> 16) : (kw & 0xffffu)));
                okd[e] = kv * __expf(bl - bc); oqa[e] = qv * __expf(bc - bl); oqi[e] = qv * __expf(bc);
                if (lane == 0) DEC[(size_t)bn * 256 + d] = __expf(bl); }
            v4u w; w.x = pk2(okd[0], okd[1]); w.y = pk2(okd[2], okd[3]); w.z = pk2(okd[4], okd[5]); w.w = pk2(okd[6], okd[7]); *(v4u*)(KD + tok * 256 + h * 64 + dg * 8) = w;
            w.x = pk2(oqa[0], oqa[1]); w.y = pk2(oqa[2], oqa[3]); w.z = pk2(oqa[4], oqa[5]); w.w = pk2(oqa[6], oqa[7]); *(v4u*)(QA + tok * 256 + h * 64 + dg * 8) = w;
            w.x = pk2(oqi[0], oqi[1]); w.y = pk2(oqi[2], oqi[3]); w.z = pk2(oqi[4], oqi[5]); w.w = pk2(oqi[6], oqi[7]); *(v4u*)(QI + tok * 256 + h * 64 + dg * 8) = w; } }
}
constexpr int GL_SET = 49152, GL_KDK = 0, GL_KDV = 8192, GL_QA = 16384, GL_QI = 24576, GL_VV = 32768, GL_S = 2 * GL_SET, GL_OB = GL_S + 16384, GL_OBP = 132, GL_END = GL_OB + 64 * GL_OBP * 4;
static_assert(GL_END <= RING_BYTES, "GLA LDS map");
__device__ __forceinline__ void gla_unit(Frame& F, int b, int h, const bf16* U0, const bf16* KD, const bf16* QA, const bf16* QI, const float* DEC, const float* gnorm, bf16* O0) {
    const int tid = opaque_tid(), lane = tid & 63, r32 = lane & 31, hi = lane >> 5, wid = __builtin_amdgcn_readfirstlane(tid >> 6);
    const int ib = wid & 1, vb = wid >> 1;
    const fa::lds_cptr L = (fa::lds_cptr)(F.lds + RING_OFF); const unsigned l0 = fa::lds_addr(L);
    const size_t tokb = (size_t)b * SEQ;
    const int trn = ((lane >> 4) & 1) * 32 + (lane & 3) * 8 + (8 * hi + ((lane & 15) >> 2)) * 64;
    const int trp = ((lane >> 4) & 1) * 32 + (lane & 3) * 8 + (4 * hi + ((lane & 15) >> 2)) * 64;
    auto dma_chunk = [&](int n, int s) { const size_t t0 = tokb + (size_t)n * 64; const unsigned base = l0 + s * GL_SET;
        fa::glds16(KD + (t0 + lane) * 256 + h * 64 + wid * 8, (unsigned)__builtin_amdgcn_readfirstlane(base + GL_KDK + wid * 1024));
        fa::glds16(QA + (t0 + lane) * 256 + h * 64 + wid * 8, (unsigned)__builtin_amdgcn_readfirstlane(base + GL_QA + wid * 1024));
        fa::glds16(QI + (t0 + lane) * 256 + h * 64 + wid * 8, (unsigned)__builtin_amdgcn_readfirstlane(base + GL_QI + wid * 1024));
        fa::glds16(KD + (t0 + 16 * (wid & 3) + (lane >> 2)) * 256 + h * 64 + (wid >> 2) * 32 + (lane & 3) * 8, (unsigned)__builtin_amdgcn_readfirstlane(base + GL_KDV + wid * 1024));
#pragma unroll
        for (int k = 0; k < 2; ++k) { const int p = wid + 8 * k; fa::glds16(U0 + (t0 + 16 * (p & 3) + (lane >> 2)) * 2048 + 1024 + h * 128 + (p >> 2) * 32 + (lane & 3) * 8, (unsigned)__builtin_amdgcn_readfirstlane(base + GL_VV + p * 1024)); } };
    fa::f32x16 st = fa::f32x16{};
    const int fi = tid >> 3, fs = tid & 7; float gn[16];
#pragma unroll
    for (int e = 0; e < 16; ++e) gn[e] = gnorm[fs * 16 + e];
    float dec[16]; v4u rr0, rr1;
    auto load_side = [&](int n) { const float* dp = DEC + ((size_t)b * 64 + n) * 256 + h * 64 + 32 * ib;
#pragma unroll
        for (int r = 0; r < 16; ++r) dec[r] = dp[fa::crow(r, hi)];
        const v4u* rp = (const v4u*)(U0 + (tokb + (size_t)n * 64 + fi) * 2048 + 1536 + h * 128 + fs * 16); rr0 = rp[0]; rr1 = rp[1]; };
    dma_chunk(0, 0); load_side(0);
    for (int n = 0; n < 64; ++n) { const int s = n & 1; const fa::lds_cptr IM = L + s * GL_SET;
        { LAS unsigned short* sp = (LAS unsigned short*)(F.lds + RING_OFF + GL_S) + vb * 2048 + r32;
#pragma unroll
          for (int r = 0; r < 16; ++r) sp[(32 * ib + fa::crow(r, hi)) * 32] = (unsigned short)f2bf(st[r]); }
        float decc[16]; v4u rc0 = rr0, rc1 = rr1;
#pragma unroll
        for (int r = 0; r < 16; ++r) decc[r] = dec[r];
        FA_WAIT_BAR(2);
        if (n + 1 < 64) { dma_chunk(n + 1, s ^ 1); load_side(n + 1); }
        fa::f32x16 p0 = fa::f32x16{}, p1 = fa::f32x16{};
        { const fa::lds_cptr kb = IM + GL_KDK + hi * 1024 + r32 * 16; const fa::lds_cptr qb_ = IM + GL_QA + hi * 1024 + (32 * ib + r32) * 16;
#pragma unroll
          for (int d0 = 0; d0 < 4; ++d0) { const fa::bf16x8 a0 = *(const FA_LAS fa::bf16x8*)(kb + d0 * 2048), a1 = *(const FA_LAS fa::bf16x8*)(kb + d0 * 2048 + 512), q = *(const FA_LAS fa::bf16x8*)(qb_ + d0 * 2048);
              p0 = FA_MFMA(a0, q, p0); p1 = FA_MFMA(a1, q, p1); } }
        { const int i = 32 * ib + r32;
#pragma unroll
          for (int r = 0; r < 16; ++r) { const int j0 = fa::crow(r, hi); if (j0 > i) p0[r] = 0.f; if (j0 + 32 > i) p1[r] = 0.f; } }
        fa::f32x16 o = fa::f32x16{};
        { fa::u32x4 pw[4];
          pw[0] = (fa::u32x4){fa::cvtpk(p0[0], p0[1]), fa::cvtpk(p0[2], p0[3]), fa::cvtpk(p0[4], p0[5]), fa::cvtpk(p0[6], p0[7])};
          pw[1] = (fa::u32x4){fa::cvtpk(p0[8], p0[9]), fa::cvtpk(p0[10], p0[11]), fa::cvtpk(p0[12], p0[13]), fa::cvtpk(p0[14], p0[15])};
          pw[2] = (fa::u32x4){fa::cvtpk(p1[0], p1[1]), fa::cvtpk(p1[2], p1[3]), fa::cvtpk(p1[4], p1[5]), fa::cvtpk(p1[6], p1[7])};
          pw[3] = (fa::u32x4){fa::cvtpk(p1[8], p1[9]), fa::cvtpk(p1[10], p1[11]), fa::cvtpk(p1[12], p1[13]), fa::cvtpk(p1[14], p1[15])};
          const fa::lds_cptr vp = IM + GL_VV + vb * 4096 + trp;
#pragma unroll
          for (int ks = 0; ks < 4; ++ks) { const fa::s16x4 lo = fa::vtr(vp + ks * 1024), hh = fa::vtr(vp + ks * 1024 + 512);
              o = FA_MFMA(__builtin_bit_cast(fa::bf16x8, pw[ks]), ((fa::bf16x8){lo[0], lo[1], lo[2], lo[3], hh[0], hh[1], hh[2], hh[3]}), o); } }
        { const fa::lds_cptr qi = IM + GL_QI + hi * 1024 + (32 * ib + r32) * 16; const fa::lds_cptr sp = L + GL_S + vb * 4096 + trn;
#pragma unroll
          for (int d0 = 0; d0 < 4; ++d0) { const fa::bf16x8 a = *(const FA_LAS fa::bf16x8*)(qi + d0 * 2048); const fa::s16x4 lo = fa::vtr(sp + d0 * 1024), hh = fa::vtr(sp + d0 * 1024 + 256);
              o = FA_MFMA(a, ((fa::bf16x8){lo[0], lo[1], lo[2], lo[3], hh[0], hh[1], hh[2], hh[3]}), o); } }
        { LAS float* ob = (LAS float*)(F.lds + RING_OFF + GL_OB) + 32 * vb + r32;
#pragma unroll
          for (int r = 0; r < 16; ++r) ob[(32 * ib + fa::crow(r, hi)) * GL_OBP] = o[r]; }
#pragma unroll
        for (int r = 0; r < 16; ++r) st[r] *= decc[r];
        { const fa::lds_cptr ap = IM + GL_KDV + ib * 4096 + trn; const fa::lds_cptr bp = IM + GL_VV + vb * 4096 + trn;
#pragma unroll
          for (int ks = 0; ks < 4; ++ks) { const fa::s16x4 al = fa::vtr(ap + ks * 1024), ah = fa::vtr(ap + ks * 1024 + 256), bl = fa::vtr(bp + ks * 1024), bh = fa::vtr(bp + ks * 1024 + 256);
              st = FA_MFMA(((fa::bf16x8){al[0], al[1], al[2], al[3], ah[0], ah[1], ah[2], ah[3]}), ((fa::bf16x8){bl[0], bl[1], bl[2], bl[3], bh[0], bh[1], bh[2], bh[3]}), st); } }
        asm volatile("s_waitcnt lgkmcnt(0)\n\ts_barrier" ::: "memory");
        { const LAS f32x4* op = (const LAS f32x4*)((LAS float*)(F.lds + RING_OFF + GL_OB) + fi * GL_OBP + fs * 16); float x[16]; float ss = 0.f;
#pragma unroll
          for (int q = 0; q < 4; ++q) { const f32x4 v = op[q]; x[4 * q] = v[0]; x[4 * q + 1] = v[1]; x[4 * q + 2] = v[2]; x[4 * q + 3] = v[3]; ss += (v[0] * v[0] + v[1] * v[1]) + (v[2] * v[2] + v[3] * v[3]); }
          ss += __shfl_xor(ss, 1); ss += __shfl_xor(ss, 2); ss += __shfl_xor(ss, 4);
          const float rstd = 1.0f / sqrtf(ss * (1.0f / 128.0f) + pg8::NORM_EPS); float y[16];
#pragma unroll
          for (int e = 0; e < 16; ++e) { const unsigned w = (e < 8) ? rc0[e >> 1] : rc1[(e - 8) >> 1]; const float rv = bf2f((unsigned short)((e & 1) ? (w >> 16) : (w & 0xffffu))); y[e] = x[e] * rstd * gn[e] * pg8::silu_f(rv); }
          v4u w0, w1; w0.x = pk2(y[0], y[1]); w0.y = pk2(y[2], y[3]); w0.z = pk2(y[4], y[5]); w0.w = pk2(y[6], y[7]); w1.x = pk2(y[8], y[9]); w1.y = pk2(y[10], y[11]); w1.z = pk2(y[12], y[13]); w1.w = pk2(y[14], y[15]);
          v4u* dst = (v4u*)(O0 + (tokb + (size_t)n * 64 + fi) * 1024 + 512 + h * 128 + fs * 16); dst[0] = w0; dst[1] = w1; }
    }
    FA_WAIT_BAR(0);
}
namespace np {
using fa::bf16x8; using fa::s16x4; using fa::f32x16; using fa::u32x4; using fa::lds_cptr; using fa::crow;
#define NP_SBAR() __builtin_amdgcn_sched_barrier(0)
#define NP_WAIT_BAR(N) asm volatile("s_waitcnt vmcnt(" #N ") lgkmcnt(0)\n\ts_barrier" ::: "memory")
#define NP_PIN(x) asm volatile("" : "+v"(x))
#define NP_MX3(a, b, c) __builtin_fmaxf(__builtin_fmaxf((a), (b)), (c))
#define NP_MFMA(a, b, c) __builtin_amdgcn_mfma_f32_32x32x16_bf16(a, b, c, 0, 0, 0)
__device__ __forceinline__ void kload8(bf16x8* kf, lds_cptr kp) {
    kf[0] = *(const FA_LAS bf16x8*)(kp);        kf[1] = *(const FA_LAS bf16x8*)(kp + 512);  kf[2] = *(const FA_LAS bf16x8*)(kp + 2048); kf[3] = *(const FA_LAS bf16x8*)(kp + 2560);
    kf[4] = *(const FA_LAS bf16x8*)(kp + 4096); kf[5] = *(const FA_LAS bf16x8*)(kp + 4608); kf[6] = *(const FA_LAS bf16x8*)(kp + 6144); kf[7] = *(const FA_LAS bf16x8*)(kp + 6656);
}
__device__ __forceinline__ void kload2(bf16x8* kf, lds_cptr kp, int j) { kf[2 * j] = *(const FA_LAS bf16x8*)(kp + j * 2048); kf[2 * j + 1] = *(const FA_LAS bf16x8*)(kp + j * 2048 + 512); }
}
struct NsaTiles {
    const bf16* kSp; const bf16* vSp; unsigned kdst, vdst; int NS, wlo, NTOT, NT, cur; size_t KVB;
    __device__ __forceinline__ void init(const bf16* KV6, int b, int g, int cur_, unsigned lds0, int lane, int wid) {
        cur = cur_; NS = cur + 1; wlo = cur >= 8 ? cur - 8 : 0; NTOT = NS + (cur - wlo + 1); NT = (NTOT + 1) & ~1; if (NT < 4) NT = 4; KVB = (size_t)MROWS * 256;
        kSp = KV6 + 2 * KVB + (size_t)b * SEQ * 256 + g * 64 + (size_t)lane * 256 + wid * 8;
        vSp = KV6 + 3 * KVB + (size_t)b * SEQ * 256 + g * 64 + (size_t)(16 * (wid & 3) + (lane >> 2)) * 256 + (wid >> 2) * 32 + (lane & 3) * 8;
        kdst = lds0 + NS_K + wid * 1024; vdst = lds0 + NS_V + wid * 1024; }
    __device__ __forceinline__ size_t toff(int t) const { return (size_t)((t < NS) ? t : ((t < NTOT) ? wlo + (t - NS) : cur)) * (64 * 256) + ((t < NS) ? (size_t)0 : 2 * KVB); }
    __device__ __forceinline__ void dma_k(int t, int slot) const { fa::glds16(kSp + toff(t), (unsigned)__builtin_amdgcn_readfirstlane(kdst + slot)); }
    __device__ __forceinline__ void dma_v(int t, int slot) const { fa::glds16(vSp + toff(t), (unsigned)__builtin_amdgcn_readfirstlane(vdst + slot)); }
    __device__ __forceinline__ void prologue() const { dma_k(0, 0); dma_v(0, 0); dma_k(1, 8192); dma_k(2, 16384); dma_v(1, 8192); }
};
__device__ __forceinline__ void nsa_stream_pipe(Frame& F, const fa::bf16x8 (&qr)[4], const NsaTiles& TL, int tq, unsigned long long selmask,
                                                fa::f32x16& oc0, fa::f32x16& oc1, bf16* Ow, int lane, int wid) {
    using namespace np;
    const int r32 = lane & 31, hi = lane >> 5;
    const fa::lds_cptr L = (fa::lds_cptr)(F.lds + RING_OFF); const unsigned lds0 = fa::lds_addr(L);
    LAS float* wsf = (LAS float*)(F.lds + RING_OFF + NS_WS) + wid * 128;
    LAS float* OF = (LAS float*)(F.lds + RING_OFF + NS_CK + wid * 8192) + lane;
    constexpr int SLOTB = 8192;
    const int NS = TL.NS, wlo = TL.wlo, NTOT = TL.NTOT, NT = TL.NT, cur = TL.cur;
#define NP_DMA_K(t, slot) TL.dma_k((t), (slot))
#define NP_DMA_V(t, slot) TL.dma_v((t), (slot))
    const lds_cptr kp0 = L + NS_K + hi * 1024 + r32 * 16; const lds_cptr vp0 = L + NS_V + ((lane >> 4) & 1) * 32 + (lane & 3) * 8 + (4 * hi + ((lane & 15) >> 2)) * 64;
    bf16x8 kf[8];
    float mhat = 0.f, l_reg = 0.f; f32x16 o[2]; o[0] = f32x16{}; o[1] = f32x16{}; f32x16 negm = f32x16{}; NP_PIN(negm);
    bool resc = false;
#define NP_MASK(C0, C1, t) do { const int t_ = (t); const bool sel_ = t_ < NS; const int j_ = sel_ ? t_ : wlo + (t_ - NS); \
        const bool rowok_ = sel_ ? (((selmask >> j_) & 1ull) != 0ull) : (t_ < NTOT); \
        if (!__all(rowok_)) { asm volatile("; row mask (a real branch: the asm keeps hipcc from if-converting it into every step)"); _Pragma("unroll") for (int r = 0; r < 16; ++r) { C0[r] = rowok_ ? C0[r] : -INFINITY; C1[r] = rowok_ ? C1[r] : -INFINITY; } } \
        if (t_ < NTOT && (j_ == cur || (!sel_ && cur >= 8 && j_ == wlo))) { asm volatile("; key mask (a real branch)"); fa::mask_range(C0, C1, j_ * 64, sel_ ? 0 : tq - 511, tq, hi); } } while (0)
#define NP_RESC() do { if (resc) { asm volatile("s_waitcnt lgkmcnt(0)" ::: "memory"); \
        _Pragma("unroll") for (int d_ = 0; d_ < 2; ++d_) _Pragma("unroll") for (int r = 0; r < 16; ++r) o[d_][r] *= wsf[crow(r, hi)]; } } while (0)
#define NP_FOLD(gofs) do { const float lt_ = fa::swap_sum(l_reg); asm volatile("s_waitcnt lgkmcnt(0)" ::: "memory"); if (hi == 0) wsf[32 + r32] = lt_; asm volatile("s_waitcnt lgkmcnt(0)" ::: "memory"); \
        _Pragma("unroll") for (int r = 0; r < 16; ++r) { const float s_ = wsf[(gofs) + crow(r, hi)] / __builtin_fmaxf(wsf[32 + crow(r, hi)], 1e-30f); OF[64 * r] += s_ * o[0][r]; OF[64 * (16 + r)] += s_ * o[1][r]; } \
        asm volatile("s_waitcnt lgkmcnt(0)" ::: "memory"); o[0] = f32x16{}; o[1] = f32x16{}; l_reg = 0.f; } while (0)
    f32x16 pA0, pA1, pB0, pB1;
    int sl_cur = 0, sl_next = SLOTB;
    int vs_prev = 0, vs_cur = 0, vs_nn = 2 * SLOTB;
#define NP_ROT() do { sl_cur = sl_next; sl_next = (sl_next == 2 * SLOTB) ? 0 : sl_next + SLOTB; vs_prev = vs_cur; vs_cur = (vs_cur == 3 * SLOTB) ? 0 : vs_cur + SLOTB; vs_nn = (vs_nn == 3 * SLOTB) ? 0 : vs_nn + SLOTB; } while (0)
    NP_WAIT_BAR(4);
#pragma unroll
    for (int r = 0; r < 16; ++r) { OF[64 * r] = oc0[r]; OF[64 * (16 + r)] = oc1[r]; }
    { const lds_cptr kb = L + NS_K + hi * 1024 + r32 * 16;
#pragma unroll
      for (int d0 = 0; d0 < 4; ++d0) { const bf16x8 b0 = *(const FA_LAS bf16x8*)(kb + d0 * 2048), b1 = *(const FA_LAS bf16x8*)(kb + d0 * 2048 + 512);
          if (d0 == 0) { pA0 = NP_MFMA(b0, qr[0], negm); pA1 = NP_MFMA(b1, qr[0], negm); } else { pA0 = NP_MFMA(b0, qr[d0], pA0); pA1 = NP_MFMA(b1, qr[d0], pA1); } } }
    NP_MASK(pA0, pA1, 0);
    { const float rm = fa::rowmax(pA0, pA1); const float dl = __builtin_fmaxf(rm, -64.f); mhat += dl;
#pragma unroll
      for (int r = 0; r < 16; ++r) { pA0[r] -= dl; pA1[r] -= dl; negm[r] = -mhat; }
      NP_PIN(negm);
#pragma unroll
      for (int r = 0; r < 16; ++r) { pA0[r] = __builtin_amdgcn_exp2f(pA0[r]); pA1[r] = __builtin_amdgcn_exp2f(pA1[r]); } }
    NP_WAIT_BAR(0);
    NP_DMA_K(3, 0); NP_DMA_V(2, 2 * SLOTB);
    NP_ROT();
    kload8(kf, kp0 + sl_cur);
    NP_WAIT_BAR(2);
    s16x4 vlo[8], vhi[8]; u32x4 pw0, pw1, pw2, pw3;
#define NP_PKW(P, B) fa::cvtpk(P[B], P[B + 1])
#define NP_PAF(k) __builtin_bit_cast(bf16x8, pw##k)
#define NP_VFR(i) (bf16x8){vlo[i][0], vlo[i][1], vlo[i][2], vlo[i][3], vhi[i][0], vhi[i][1], vhi[i][2], vhi[i][3]}
#define NP_GAPA(MF, A0, A1, A2, A3, W0, W1, PW) do { MF; sacc += A0; sacc += A1; sacc += A2; sacc += A3; NP_PIN(sacc); W0; W1; NP_PIN(PW); NP_SBAR(); } while (0)
#define NP_EX(v) __builtin_amdgcn_exp2f(v)
#define NP_GAPB(MF, X, B) do { MF; X[B] = NP_EX(X[B]); X[B + 1] = NP_EX(X[B + 1]); X[B + 2] = NP_EX(X[B + 2]); X[B + 3] = NP_EX(X[B + 3]); NP_PIN(X); NP_SBAR(); } while (0)
#define NP_VRD(i) do { vlo[i] = fa::vtr(vp_ + (((i) >> 2) * 4096 + ((i) & 3) * 1024)); vhi[i] = fa::vtr(vp_ + (((i) >> 2) * 4096 + ((i) & 3) * 1024 + 512)); } while (0)
#define NP_KRD(G, j) do { if (G) { kload2(kf, kp0 + sl_next, j); NP_SBAR(); } } while (0)
#ifndef NSX
#define NSX 0
#endif
    f32x16 xd0 = f32x16{}, xd1 = f32x16{}; float xv = 1.0f;
#define NP_EXTRA() do { \
    if (NSX == 1) { _Pragma("unroll") for (int q_ = 0; q_ < 8; ++q_) { xd0 = NP_MFMA(kf[q_], qr[q_ & 3], xd0); xd1 = NP_MFMA(kf[q_], qr[(q_ + 1) & 3], xd1); } NP_PIN(xd0); NP_PIN(xd1); } \
    if (NSX == 2) { _Pragma("unroll") for (int q_ = 0; q_ < 64; ++q_) { xv = NP_EX(xv * 0.999f); NP_PIN(xv); } } \
    if (NSX == 3) { asm volatile("s_barrier" ::: "memory"); } \
    if (NSX == 4) { bf16x8 xk[8]; kload8(xk, kp0 + sl_cur); _Pragma("unroll") for (int q_ = 0; q_ < 8; ++q_) asm volatile("" :: "v"(xk[q_])); kload8(xk, kp0 + sl_next); _Pragma("unroll") for (int q_ = 0; q_ < 8; ++q_) asm volatile("" :: "v"(xk[q_])); kload8(xk, kp0); _Pragma("unroll") for (int q_ = 0; q_ < 8; ++q_) asm volatile("" :: "v"(xk[q_])); } \
    } while (0)
#define NP_STEP(C0, C1, P0, P1, t, GK, GV, GL) do { NP_SBAR(); \
    const lds_cptr vp_ = vp0 + vs_prev; \
    NP_VRD(0); NP_SBAR(); float sacc = (P0[0] + P0[1]); \
    NP_GAPA(C0 = NP_MFMA(kf[0], qr[0], negm), P0[2], P0[3], P0[4], P0[5],     pw0[0] = NP_PKW(P0, 0), pw0[1] = NP_PKW(P0, 2), pw0); \
    NP_VRD(4); NP_SBAR(); NP_GAPA(C1 = NP_MFMA(kf[1], qr[0], negm), P0[6], P0[7], P0[8], P0[9],     pw0[2] = NP_PKW(P0, 4), pw0[3] = NP_PKW(P0, 6), pw0); \
    NP_VRD(1); NP_SBAR(); NP_GAPA(C0 = NP_MFMA(kf[2], qr[1], C0),   P0[10], P0[11], P0[12], P0[13], pw1[0] = NP_PKW(P0, 8), pw1[1] = NP_PKW(P0, 10), pw1); \
    NP_VRD(5); NP_SBAR(); NP_GAPA(C1 = NP_MFMA(kf[3], qr[1], C1),   P0[14], P0[15], P1[0], P1[1],   pw1[2] = NP_PKW(P0, 12), pw1[3] = NP_PKW(P0, 14), pw1); \
    NP_VRD(2); NP_SBAR(); NP_GAPA(C0 = NP_MFMA(kf[4], qr[2], C0),   P1[2], P1[3], P1[4], P1[5],     pw2[0] = NP_PKW(P1, 0), pw2[1] = NP_PKW(P1, 2), pw2); \
    NP_VRD(6); NP_SBAR(); NP_GAPA(C1 = NP_MFMA(kf[5], qr[2], C1),   P1[6], P1[7], P1[8], P1[9],     pw2[2] = NP_PKW(P1, 4), pw2[3] = NP_PKW(P1, 6), pw2); \
    NP_VRD(3); NP_SBAR(); NP_GAPA(C0 = NP_MFMA(kf[6], qr[3], C0),   P1[10], P1[11], P1[12], P1[13], pw3[0] = NP_PKW(P1, 8), pw3[1] = NP_PKW(P1, 10), pw3); \
    NP_VRD(7); NP_SBAR(); NP_GAPA(C1 = NP_MFMA(kf[7], qr[3], C1),   P1[14], P1[15], 0.f, 0.f,       pw3[2] = NP_PKW(P1, 12), pw3[3] = NP_PKW(P1, 14), pw3); \
    l_reg += sacc; \
    if (GK) { NP_DMA_K((t) + 3, sl_cur); } if (GV) { NP_DMA_V((t) + 2, vs_nn); } \
    NP_MASK(C0, C1, t); \
    { float a = NP_MX3(C0[0], C0[1], C1[0]), b_ = NP_MX3(C0[2], C0[3], C1[1]); a = NP_MX3(a, C1[2], C1[3]); \
      _Pragma("unroll") for (int r = 4; r < 16; r += 4) { a = NP_MX3(a, C0[r], C0[r + 1]); b_ = NP_MX3(b_, C0[r + 2], C0[r + 3]); a = NP_MX3(a, C1[r], C1[r + 1]); b_ = NP_MX3(b_, C1[r + 2], C1[r + 3]); } \
      const float rm = fa::swap_max(__builtin_fmaxf(a, b_)); \
      resc = false; \
      if (__builtin_expect(__any(rm > fa::FA_THR), 0)) { const float dl = __builtin_fmaxf(rm, 0.f); mhat += dl; \
        _Pragma("unroll") for (int r = 0; r < 16; ++r) { C0[r] -= dl; C1[r] -= dl; } \
        _Pragma("unroll") for (int r = 0; r < 16; ++r) negm[r] = -mhat; NP_PIN(negm); \
        const float f = __builtin_amdgcn_exp2f(-dl); l_reg *= f; if (hi == 0) wsf[r32] = f; resc = true; } } \
    NP_SBAR(); \
    NP_GAPB(o[0] = NP_MFMA(NP_PAF(0), NP_VFR(0), o[0]), C0, 0); \
    NP_GAPB(o[1] = NP_MFMA(NP_PAF(0), NP_VFR(4), o[1]), C0, 4); \
    NP_KRD(GL, 0); NP_GAPB(o[0] = NP_MFMA(NP_PAF(1), NP_VFR(1), o[0]), C0, 8); \
    NP_KRD(GL, 1); NP_GAPB(o[1] = NP_MFMA(NP_PAF(1), NP_VFR(5), o[1]), C0, 12); \
    NP_KRD(GL, 2); NP_GAPB(o[0] = NP_MFMA(NP_PAF(2), NP_VFR(2), o[0]), C1, 0); \
    NP_KRD(GL, 3); NP_GAPB(o[1] = NP_MFMA(NP_PAF(2), NP_VFR(6), o[1]), C1, 4); \
    NP_GAPB(o[0] = NP_MFMA(NP_PAF(3), NP_VFR(3), o[0]), C1, 8); \
    NP_GAPB(o[1] = NP_MFMA(NP_PAF(3), NP_VFR(7), o[1]), C1, 12); \
    NP_EXTRA(); \
    } while (0)
#define NP_ENDW(tt) do { if ((tt) + 3 < NT) { NP_WAIT_BAR(3); } else if ((tt) + 2 < NT) { NP_WAIT_BAR(2); } else { NP_WAIT_BAR(0); } } while (0)
#define NP_HOOK(t) do { if ((t) == NS) NP_FOLD(96); } while (0)
    int t = 1;
    for (; t + 1 < NT; t += 2) {
        NP_STEP(pB0, pB1, pA0, pA1, t, (t + 3 < NT), (t + 2 < NT), (t + 1 < NT));         NP_ENDW(t);     NP_RESC(); NP_ROT(); NP_HOOK(t);
        NP_STEP(pA0, pA1, pB0, pB1, t + 1, (t + 4 < NT), (t + 3 < NT), (t + 2 < NT));     NP_ENDW(t + 1); NP_RESC(); NP_ROT(); NP_HOOK(t + 1);
    }
    NP_STEP(pB0, pB1, pA0, pA1, NT - 1, false, false, false); NP_RESC(); NP_HOOK(NT - 1);
    { float sacc = pB0[0] + pB0[1];
#pragma unroll
      for (int r = 2; r < 16; ++r) sacc += pB0[r];
#pragma unroll
      for (int r = 0; r < 16; ++r) sacc += pB1[r];
      l_reg += sacc; NP_SBAR();
      fa::pv(o[0], o[1], pB0, pB1, L + NS_V + vs_cur, lane, hi); }
    { const float lt_ = fa::swap_sum(l_reg); asm volatile("s_waitcnt lgkmcnt(0)" ::: "memory"); if (hi == 0) wsf[32 + r32] = lt_; asm volatile("s_waitcnt lgkmcnt(0)" ::: "memory");
#pragma unroll
      for (int r = 0; r < 16; ++r) { const float s_ = wsf[64 + crow(r, hi)] / __builtin_fmaxf(wsf[32 + crow(r, hi)], 1e-30f); o[0][r] = OF[64 * r] + s_ * o[0][r]; o[1][r] = OF[64 * (16 + r)] + s_ * o[1][r]; }
      asm volatile("s_waitcnt lgkmcnt(0)" ::: "memory"); }
    store_o_tile(o[0], o[1], F.lds + RING_OFF + NS_CK + wid * 8192, lane, [&](int rr) { return Ow + (size_t)(rr >> 2) * 1024 + (rr & 3) * 64; });
    asm volatile("s_waitcnt lgkmcnt(0)\n\ts_barrier" ::: "memory");
#undef NP_DMA_K
#undef NP_DMA_V
#undef NP_MASK
#undef NP_RESC
#undef NP_FOLD
#undef NP_ROT
#undef NP_PKW
#undef NP_PAF
#undef NP_VFR
#undef NP_GAPA
#undef NP_EX
#undef NP_GAPB
#undef NP_VRD
#undef NP_KRD
#undef NP_STEP
#undef NP_ENDW
#undef NP_EXTRA
#undef NP_HOOK
}
constexpr int GA_A = 0, GA_ASZ = 32768, GA_B = 2 * GA_ASZ, GA_BSZ = 16384, GA_WS = GA_B + 2 * GA_BSZ;
__device__ __forceinline__ void nsa_gates_unit(Frame& F, int hm, const bf16* HBp, const bf16* WGT, const float* ssq, float* GT) {
    const int tid = opaque_tid(), lane = tid & 63, r32 = lane & 31, hi = lane >> 5, wid = __builtin_amdgcn_readfirstlane(tid >> 6);
    const int rb = wid & 3, nb = wid >> 2, row0 = hm * 128; const fa::lds_cptr L = (fa::lds_cptr)(F.lds + RING_OFF); const unsigned l0 = fa::lds_addr(L);
    LAS float* wsf = (LAS float*)(F.lds + RING_OFF + GA_WS) + rb * 32;
    float rsown;
    { const f32x4* sp = (const f32x4*)(ssq + (size_t)(row0 + rb * 32 + r32) * 16); const f32x4 a = sp[0], b = sp[1], c = sp[2], d = sp[3];
      const float s = ((a[0] + a[1]) + (a[2] + a[3])) + ((b[0] + b[1]) + (b[2] + b[3])) + ((c[0] + c[1]) + (c[2] + c[3])) + ((d[0] + d[1]) + (d[2] + d[3]));
      rsown = __builtin_amdgcn_rsqf(s * (1.0f / 1024.0f) + pg8::NORM_EPS); }
    __builtin_amdgcn_s_waitcnt(0x0F70);
    if (nb == 0 && hi == 0) wsf[r32] = rsown;
    auto dma_chunk = [&](int kc, int buf) {
#pragma unroll
        for (int q = 0; q < 4; ++q) { const int i = 4 * wid + q, p = 64 * i + lane, row = p >> 4, slot = p & 15, ch = slot ^ (row & 7);
            fa::glds16(HBp + (size_t)(row0 + row) * 1024 + kc * 128 + ch * 8, (unsigned)__builtin_amdgcn_readfirstlane(l0 + GA_A + buf * GA_ASZ + i * 1024)); }
#pragma unroll
        for (int q = 0; q < 2; ++q) { const int i = 2 * wid + q; fa::glds16(WGT + (size_t)kc * 8192 + i * 512 + lane * 8, (unsigned)__builtin_amdgcn_readfirstlane(l0 + GA_B + buf * GA_BSZ + i * 1024)); } };
    fa::f32x16 acc = fa::f32x16{};
    const int rot = (int)(blockIdx.x >> 3);
    dma_chunk(rot & 7, 0); dma_chunk((rot + 1) & 7, 1);
    const int arow = 32 * rb + r32;
    for (int kc = 0; kc < 8; ++kc) { const int buf = kc & 1;
        if (kc + 1 < 8) FA_WAIT_BAR(6); else FA_WAIT_BAR(0);
        const fa::lds_cptr ab = L + GA_A + buf * GA_ASZ + arow * 256, bb = L + GA_B + buf * GA_BSZ + nb * 1024 + lane * 16;
#pragma unroll
        for (int s = 0; s < 8; ++s) { const fa::bf16x8 a = *(const FA_LAS fa::bf16x8*)(ab + (((2 * s + hi) ^ (arow & 7)) * 16)), b = *(const FA_LAS fa::bf16x8*)(bb + s * 2048);
            acc = FA_MFMA(a, b, acc); }
        asm volatile("s_waitcnt lgkmcnt(0)\n\ts_barrier" ::: "memory");
        if (kc + 2 < 8) dma_chunk((kc + 2 + rot) & 7, buf);
    }
#pragma unroll
    for (int r = 0; r < 16; ++r) { const int rr = fa::crow(r, hi); const float rs = wsf[rr]; const int col = 32 * nb + r32;
        if (col < 48) GT[(size_t)(row0 + 32 * rb + rr) * 48 + col] = pg8::sigmoid_f(acc[r] * rs); }
    asm volatile("s_waitcnt lgkmcnt(0)\n\ts_barrier" ::: "memory");
}
constexpr int CP_A = 0, CP_RED = 67584, CP_H1 = CP_RED + 65536, CP_END = CP_H1 + 16384;
static_assert(CP_END <= RING_BYTES, "compress LDS map");
__device__ __forceinline__ void compress_unit(Frame& F, int u, const bf16* KV6, const bf16* CW1, const bf16* CW2, const float* BIAS1, const float* rope, bf16* KCMP, bf16* VCMP) {
    const int tid = opaque_tid(), lane = tid & 63, r32 = lane & 31, hi = lane >> 5, wid = __builtin_amdgcn_readfirstlane(tid >> 6);
    const int nb = u & 7, g = (u >> 3) & 3, b = (u >> 5) & 7, kv = u >> 8;
    const fa::lds_cptr L = (fa::lds_cptr)(F.lds + RING_OFF); const unsigned l0 = fa::lds_addr(L);
    const bf16* src = KV6 + (size_t)kv * ((size_t)MROWS * 256) + (size_t)b * SEQ * 256 + g * 64;
    const bf16* w1f = CW1 + (size_t)kv * 262144 + lane * 8;
    const int tok0 = 512 * nb;
    for (int i = wid; i < 66; i += 8) { const int p = 64 * i + lane, row = p >> 3, slot = p & 7, ch = slot ^ ((row >> 4) & 7); int trow = tok0 + row; if (trow > SEQ - 1) trow = SEQ - 1;
        fa::glds16(src + (size_t)trow * 256 + ch * 8, (unsigned)__builtin_amdgcn_readfirstlane(l0 + CP_A + i * 1024)); }
    FA_WAIT_BAR(0);
    const int wk = wid & 3, nh = wid >> 2, crot = (int)(blockIdx.x >> 3) & 7;
    fa::f32x16 acc0 = fa::f32x16{}, acc1 = fa::f32x16{};
#pragma unroll 8
    for (int kk = 0; kk < 32; ++kk) { const int l = 8 * wk + (((kk >> 2) + crot) & 7), d0 = kk & 3, row = 16 * r32 + l, slot = (2 * d0 + hi) ^ ((row >> 4) & 7);
        const fa::bf16x8 a = *(const FA_LAS fa::bf16x8*)(L + CP_A + row * 128 + slot * 16);
        const fa::bf16x8 b0 = *(const fa::bf16x8*)(w1f + (size_t)((l * 4 + d0) * 4 + 2 * nh) * 512), b1 = *(const fa::bf16x8*)(w1f + (size_t)((l * 4 + d0) * 4 + 2 * nh + 1) * 512);
        acc0 = FA_MFMA(a, b0, acc0); acc1 = FA_MFMA(a, b1, acc1); }
    { LAS float* red = (LAS float*)(F.lds + RING_OFF + CP_RED) + wid * 2048 + r32;
#pragma unroll
      for (int r = 0; r < 16; ++r) { red[fa::crow(r, hi) * 64] = acc0[r]; red[fa::crow(r, hi) * 64 + 32] = acc1[r]; } }
    __syncthreads();
    { const int row = tid >> 4, c0 = (tid & 15) * 8, nhh = c0 >> 6; const LAS float* red = (const LAS float*)(F.lds + RING_OFF + CP_RED) + (nhh * 4 * 32 + row) * 64 + (c0 & 63);
      float s[8];
#pragma unroll
      for (int e = 0; e < 8; ++e) s[e] = BIAS1[kv * 128 + c0 + e];
#pragma unroll
      for (int w = 0; w < 4; ++w) { const f32x4 x0 = *(const LAS f32x4*)(red + w * 2048), x1 = *(const LAS f32x4*)(red + w * 2048 + 4); s[0] += x0[0]; s[1] += x0[1]; s[2] += x0[2]; s[3] += x0[3]; s[4] += x1[0]; s[5] += x1[1]; s[6] += x1[2]; s[7] += x1[3]; }
      { const int ch = (tid & 15) ^ (row & 15);
        v4u o; o.x = pk2(pg8::silu_f(s[0]), pg8::silu_f(s[1])); o.y = pk2(pg8::silu_f(s[2]), pg8::silu_f(s[3])); o.z = pk2(pg8::silu_f(s[4]), pg8::silu_f(s[5])); o.w = pk2(pg8::silu_f(s[6]), pg8::silu_f(s[7]));
        *(LAS v4u*)(F.lds + RING_OFF + CP_H1 + row * 256 + ch * 16) = o; } }
    __syncthreads();
    if (wid == 0) {
        const bf16* w2f = CW2 + (size_t)kv * 8192 + lane * 8; fa::f32x16 o1 = fa::f32x16{}, o2 = fa::f32x16{};
#pragma unroll
        for (int ks = 0; ks < 8; ++ks) { const fa::bf16x8 a = *(const FA_LAS fa::bf16x8*)(L + CP_H1 + r32 * 256 + (((2 * ks + hi) ^ (r32 & 15)) * 16));
            o1 = FA_MFMA(a, *(const fa::bf16x8*)(w2f + (size_t)(ks * 2) * 512), o1); o2 = FA_MFMA(a, *(const fa::bf16x8*)(w2f + (size_t)(ks * 2 + 1) * 512), o2); }
#pragma unroll
        for (int r = 0; r < 16; ++r) { const int nn = nb * 32 + fa::crow(r, hi); float x1 = o1[r], x2 = o2[r];
            if (kv == 0 && nn < 255) { const size_t prow = (size_t)b * SEQ + 16 * nn + 31; const f32x2 cs = *(const f32x2*)(rope + (prow * 32 + r32) * 2);
                const float y1 = x1 * cs[0] - x2 * cs[1], y2 = x2 * cs[0] + x1 * cs[1]; x1 = y1; x2 = y2; }
            if (nn >= 255) { x1 = 0.f; x2 = 0.f; }
            bf16* dst = (kv ? VCMP : KCMP) + (((size_t)b * 256 + nn) * 4 + g) * 64 + r32;
            dst[0] = (bf16)f2bf(x1); dst[32] = (bf16)f2bf(x2); } }
    __syncthreads();
}
template <int MODE> __device__ __forceinline__ void nsa_unit(Frame& F, int b, int g, int qb, const bf16* QN, const bf16* KV6, const bf16* KCMP, const bf16* VCMP, const float* GT, bf16* O1) {
    const int tid = opaque_tid(), lane = tid & 63, r32 = lane & 31, hi = lane >> 5, wid = __builtin_amdgcn_readfirstlane(tid >> 6);
    const fa::lds_cptr L = (fa::lds_cptr)(F.lds + RING_OFF); const unsigned l0 = fa::lds_addr(L);
    LAS float* wsf = (LAS float*)(F.lds + RING_OFF + NS_WS) + wid * 128;
    const int tl = 8 * wid + (r32 >> 2), hh = r32 & 3, head = 4 * g + hh, t = 64 * qb + tl, cur = qb;
    const size_t tok = (size_t)b * SEQ + t;
    fa::bf16x8 qr[4];
#pragma unroll
    for (int d0 = 0; d0 < 4; ++d0) qr[d0] = *(const fa::bf16x8*)(QN + tok * 1024 + head * 64 + d0 * 16 + hi * 8);
    const float g0own = GT[tok * 48 + head * 3], g1own = GT[tok * 48 + head * 3 + 1], g2own = GT[tok * 48 + head * 3 + 2];
    __builtin_amdgcn_s_waitcnt(0x0F70);
    if (hi == 0) { wsf[64 + r32] = g0own; wsf[96 + r32] = g1own; }
    const int NTC = ((4 * qb + 2) >> 6) + 1;
    const bf16* kc = KCMP + (size_t)b * 256 * 256 + g * 64; const bf16* vc = VCMP + (size_t)b * 256 * 256 + g * 64;
    for (int T = 0; T < NTC; ++T) { fa::dma_k<64>(kc + (size_t)T * 64 * 256, 256, l0 + NS_CK + T * 8192, wid, lane); fa::dma_v(vc + (size_t)T * 64 * 256, 256, l0 + NS_CV + T * 8192, wid, lane); }
    NsaTiles TL; TL.init(KV6, b, g, cur, l0, lane, wid); TL.prologue();
    const int khc = (t >= 31) ? ((t - 31) >> 4) : -1;
    FA_WAIT_BAR(5);
    const fa::f32x16 zero16 = fa::f32x16{};
    const int twlo = 64 * qb + 8 * wid, khc_lo = (twlo >= 31) ? ((twlo - 31) >> 4) : -1, khc_hi = (twlo + 7 >= 31) ? ((twlo + 7 - 31) >> 4) : -1;
    const int NTW = (khc_hi >> 6) + 1;
    float mc = -1e30f;
    for (int T = 0; T < NTW; ++T) { fa::f32x16 p0, p1; fa::qkt<64>(p0, p1, L + NS_CK + T * 8192, qr, zero16, r32, hi); if (T * 64 + 63 > khc_lo) { asm volatile("; cmp mask (a real branch)"); fa::mask_range(p0, p1, T * 64, 0, khc, hi); }
        mc = __builtin_fmaxf(mc, fa::rowmax(p0, p1)); }
    float lc = 0.f; fa::f32x16 oc0 = fa::f32x16{}, oc1 = fa::f32x16{};
    float ia[32], ic[32];
#pragma unroll
    for (int i = 0; i < 32; ++i) { ia[i] = 0.f; ic[i] = 0.f; }
#pragma unroll
    for (int T = 0; T < 4; ++T) if (T < NTW) { fa::f32x16 p0, p1; fa::qkt<64>(p0, p1, L + NS_CK + T * 8192, qr, zero16, r32, hi); if (T * 64 + 63 > khc_lo) { asm volatile("; cmp mask (a real branch)"); fa::mask_range(p0, p1, T * 64, 0, khc, hi); }
        float s0 = 0.f, s1 = 0.f;
#pragma unroll
        for (int r = 0; r < 16; ++r) { p0[r] = __builtin_amdgcn_exp2f(p0[r] - mc); p1[r] = __builtin_amdgcn_exp2f(p1[r] - mc); s0 += p0[r]; s1 += p1[r]; }
        lc += s0 + s1;
#pragma unroll
        for (int jj = 0; jj < 4; ++jj) { ia[T * 8 + jj] = (p0[4 * jj] + p0[4 * jj + 1]) + (p0[4 * jj + 2] + 0.5f * p0[4 * jj + 3]); ic[T * 8 + jj] = 0.5f * p0[4 * jj + 3];
            ia[T * 8 + 4 + jj] = (p1[4 * jj] + p1[4 * jj + 1]) + (p1[4 * jj + 2] + 0.5f * p1[4 * jj + 3]); ic[T * 8 + 4 + jj] = 0.5f * p1[4 * jj + 3]; }
        fa::pv(oc0, oc1, p0, p1, L + NS_CV + T * 8192, lane, hi); }
    lc = fa::swap_sum(lc);
    const float ilc = 1.0f / __builtin_fmaxf(lc, 1e-30f);
    LDS_WAIT(); if (hi == 0) wsf[32 + r32] = ilc; LDS_WAIT();
#pragma unroll
    for (int r = 0; r < 16; ++r) { const float f = wsf[32 + fa::crow(r, hi)]; oc0[r] *= f; oc1[r] *= f; }
    unsigned long long selmask;
    if (cur < 16) selmask = (2ull << cur) - 1ull;
    else {
        LAS int* impb = (LAS int*)(F.lds + RING_OFF + NS_IMP + wid * 2048) + (r32 >> 2) * 64;
#pragma unroll
        for (int i = 0; i < 32; ++i) { ia[i] *= ilc; ic[i] *= ilc;
            ia[i] += __builtin_bit_cast(float, __builtin_amdgcn_update_dpp(0, __builtin_bit_cast(int, ia[i]), 0xB1, 0xf, 0xf, true)); ia[i] += __builtin_bit_cast(float, __builtin_amdgcn_update_dpp(0, __builtin_bit_cast(int, ia[i]), 0x4E, 0xf, 0xf, true));
            ic[i] += __builtin_bit_cast(float, __builtin_amdgcn_update_dpp(0, __builtin_bit_cast(int, ic[i]), 0xB1, 0xf, 0xf, true)); ic[i] += __builtin_bit_cast(float, __builtin_amdgcn_update_dpp(0, __builtin_bit_cast(int, ic[i]), 0x4E, 0xf, 0xf, true)); }
#pragma unroll
        for (int i = 0; i < 32; ++i) { auto rr = __builtin_amdgcn_permlane32_swap(__float_as_uint(ic[i]), __float_as_uint(ic[i]), false, false); ic[i] = __uint_as_float(hi ? rr[0] : rr[1]); }
#pragma unroll
        for (int i = 0; i < 32; ++i) { const float add = hi ? ic[i] : (i > 0 ? ic[i > 0 ? i - 1 : 0] : 0.f); const int mb = 2 * i + hi; const float v = ia[i] + add;
            int key = (int)((__float_as_uint(v) & ~63u) | (unsigned)(63 - mb)); if (mb < 1 || mb > cur - 2) key = (int)0x80000000;
            if (hh == 0) impb[mb] = key; }
        LDS_WAIT();
        const int sub = hh * 2 + hi; int mine[8]; int cnt[8];
#pragma unroll
        for (int e = 0; e < 8; ++e) { mine[e] = impb[8 * sub + e]; cnt[e] = 0; }
        for (int q4 = 0; q4 < 16; ++q4) { const v4u v = *(const LAS v4u*)(impb + 4 * q4);
#pragma unroll
            for (int k = 0; k < 4; ++k) { const int ko = (int)v[k];
#pragma unroll
                for (int e = 0; e < 8; ++e) cnt[e] += (ko > mine[e]) ? 1 : 0; } }
        unsigned bits = 0u;
#pragma unroll
        for (int e = 0; e < 8; ++e) { const int mb = 8 * sub + e; const bool cand = (mb >= 1 && mb <= cur - 2); const bool forced = (mb == 0 || mb == cur || mb == cur - 1); if (forced || (cand && cnt[e] < 13)) bits |= 1u << e; }
        unsigned lo = (sub < 4) ? bits << (8 * sub) : 0u, hi32 = (sub >= 4) ? bits << (8 * (sub - 4)) : 0u;
        lo |= __shfl_xor(lo, 1); lo |= __shfl_xor(lo, 2); lo |= __shfl_xor(lo, 32); hi32 |= __shfl_xor(hi32, 1); hi32 |= __shfl_xor(hi32, 2); hi32 |= __shfl_xor(hi32, 32);
        selmask = ((unsigned long long)hi32 << 32) | lo;
        LDS_WAIT();
    }
#pragma unroll
    for (int r = 0; r < 16; ++r) { const float gc = wsf[64 + fa::crow(r, hi)]; oc0[r] *= gc; oc1[r] *= gc; }
    LDS_WAIT(); if (hi == 0) wsf[64 + r32] = g2own; LDS_WAIT();
    if (MODE == 1) { asm volatile("" :: "v"(oc0), "v"(oc1), "v"(selmask)); FA_WAIT_BAR(0); return; }
    bf16* Ow = O1 + ((size_t)b * SEQ + 64 * qb + 8 * wid) * 1024 + 4 * g * 64;
    nsa_stream_pipe(F, qr, TL, t, selmask, oc0, oc1, Ow, lane, wid);
}
__device__ __forceinline__ void final_norm(Frame& F, const bf16* src, float* out, const float* ssq, const float* gain) {
    const int tid = opaque_tid(), lane = tid & 63; const int gw = F.vcu * NWAVES + __builtin_amdgcn_readfirstlane(tid >> 6), NGW = F.G * NWAVES;
    f32x4 gv[4];
#pragma unroll
    for (int j = 0; j < 4; ++j) gv[j] = *((const f32x4*)gain + 2 * lane + 128 * (j >> 1) + (j & 1));
    for (int m = gw; m < MROWS; m += NGW) { float s = (lane < 16) ? ssq[(size_t)m * 16 + lane] : 0.f; s = wave_sum(s); const float rstd = 1.0f / sqrtf(s * (1.0f / 1024.0f) + pg8::NORM_EPS);
        const v4u* xs = (const v4u*)(src + (size_t)m * DM) + lane; f32x4* xr = (f32x4*)(out + (size_t)m * DM) + 2 * lane;
#pragma unroll
        for (int hh = 0; hh < 2; ++hh) { const v4u w = xs[64 * hh];
            const f32x4 a = {__builtin_bit_cast(float, w.x << 16), __builtin_bit_cast(float, w.x & 0xffff0000u), __builtin_bit_cast(float, w.y << 16), __builtin_bit_cast(float, w.y & 0xffff0000u)};
            const f32x4 c = {__builtin_bit_cast(float, w.z << 16), __builtin_bit_cast(float, w.z & 0xffff0000u), __builtin_bit_cast(float, w.w << 16), __builtin_bit_cast(float, w.w & 0xffff0000u)};
            xr[128 * hh] = a * rstd * gv[2 * hh]; xr[128 * hh + 1] = c * rstd * gv[2 * hh + 1]; } }
}
#ifndef PH_END
#define PH_END 99
#endif
struct Args { Inputs in; float* out; unsigned char* ws; RopeFreq rf; };
__global__ void __launch_bounds__(NWAVES * 64, 2) trunk_fwd(Args args) {
    extern __shared__ __attribute__((aligned(16))) unsigned char lds[];
    Frame F;
    F.lds = (LAS unsigned char*)lds;
    F.MISC = (volatile LAS unsigned*)(F.lds + MISC_OFF);
    F.G = gridDim.x; { const int bx = blockIdx.x; F.vcu = (F.G % 8 == 0) ? (bx % 8) * (F.G / 8) + bx / 8 : bx; }
    F.ws = args.ws; F.ctl = (gu32*)(args.ws + WS_CTL);
    const Inputs& I = args.in; unsigned char* ws = args.ws; float* out = args.out;
    for (int u = threadIdx.x; u < (LDS_BYTES - LDSCTL_OFF) / 4; u += NWAVES * 64) ((LAS unsigned*)(F.lds + LDSCTL_OFF))[u] = 0u;
    __syncthreads();
    XcdBarrier bar = xcd_barrier_post((unsigned*)(F.ctl + CW_BAR), F.MISC + 8);
#define GRID_BAR() xcd_barrier(bar)
#define ON(k) ((k) < PH_END)
#ifndef DUP
#define DUP -1
#endif
#define NREP(k) (((k) == DUP) ? 2 : 1)
#ifndef WGM_OTHER
#define WGM_OTHER 4
#endif
#ifndef TPROBE
#define TPROBE -1
#endif
    bf16* HB = (bf16*)(ws + WS_HB); float* SSQ = (float*)(ws + WS_SSQ); bf16* HID = (bf16*)(ws + WS_HID);
    if (ON(0)) for (int rep = 0; rep < NREP(0); ++rep) p0_prologue(F, I, args.rf);
    GRID_BAR();
#define FFN_PHASES(f, XB, k0) do { \
    if (ON(k0) && DUP == 300 + (f)) { pg8::Gemm g{HB, (const bf16*)(ws + WS_WGU) + (size_t)(f) * 5632 * DM, MROWS, 5632, DM, DM}; pg8::StaticOrder S; S.init(MROWS, 5632, F.G, (int)blockIdx.x); pg8::EpiNull E{}; pg8::gemm_phase<pg8::EpiNull, pg8::StaticOrder, true, true>(F.lds + RING_OFF, g, S, E); } \
    if (ON(k0) && DUP == 400 + (f)) { pg8::Gemm g{HID, (const bf16*)(ws + WS_WD) + (size_t)(f) * DM * FF, MROWS, DM, FF, FF}; pg8::StaticOrder S; S.init(MROWS, DM, F.G, (int)blockIdx.x, WGM_OTHER); pg8::EpiNull E{}; pg8::gemm_phase<pg8::EpiNull, pg8::StaticOrder, true, true>(F.lds + RING_OFF, g, S, E); } \
    if (ON(k0)) for (int rep = 0; rep < NREP(100 + (f)); ++rep) { pg8::Gemm g{HB, (const bf16*)(ws + WS_WGU) + (size_t)(f) * 5632 * DM, MROWS, 5632, DM, DM}; pg8::StaticOrder S; S.init(MROWS, 5632, F.G, (int)blockIdx.x); \
        pg8::EpiGateUp E{HID, SSQ, FF}; pg8::gemm_phase<pg8::EpiGateUp, pg8::StaticOrder, true, true>(F.lds + RING_OFF, g, S, E); } \
    GRID_BAR(); \
    if (ON(k0)) for (int rep = 0; rep < NREP(200 + (f)); ++rep) { pg8::Gemm g{HID, (const bf16*)(ws + WS_WD) + (size_t)(f) * DM * FF, MROWS, DM, FF, FF}; pg8::StaticOrder S; S.init(MROWS, DM, F.G, (int)blockIdx.x, WGM_OTHER); \
        pg8::EpiResidT<XB> E{I.x, HB, SSQ, 0.5f}; \
        if (DUP == 500 && (f) == 0) { pg8::EpiTwice<pg8::EpiResidT<XB>> E2{E}; pg8::gemm_phase<pg8::EpiTwice<pg8::EpiResidT<XB>>, pg8::StaticOrder, true, true>(F.lds + RING_OFF, g, S, E2); } \
        else pg8::gemm_phase<pg8::EpiResidT<XB>, pg8::StaticOrder, true, true>(F.lds + RING_OFF, g, S, E); } \
    GRID_BAR(); } while (0)

    FFN_PHASES(0, true, 1);
    {
        bf16* U0 = (bf16*)(ws + WS_U0); bf16* QM = (bf16*)(ws + WS_QM); bf16* KF = (bf16*)(ws + WS_KF); bf16* VM = (bf16*)(ws + WS_VM); bf16* O0 = (bf16*)(ws + WS_O0);
        bf16* KD = (bf16*)out; bf16* QA = KD + (size_t)MROWS * 256; bf16* QI = QA + (size_t)MROWS * 256;
        float* SSQQ = (float*)(ws + WS_SSQQ); float* SSQKV = (float*)(ws + WS_SSQKV); float* KR = (float*)(ws + WS_KR); float* GA = (float*)(ws + WS_GA); float* DEC = (float*)(ws + WS_DEC);
        const float* ROPE0 = (const float*)(ws + WS_ROPE0);
        if (ON(2)) for (int rep = 0; rep < NREP(2); ++rep) { pg8::Gemm g{HB, (const bf16*)(ws + WS_WIN0), MROWS, HYN, DM, DM}; pg8::StaticOrder S; S.init(MROWS, HYN, F.G, (int)blockIdx.x, WGM_OTHER);
            pg8::EpiHyIn E{U0, SSQ, SSQQ, SSQKV, KR, GA}; pg8::gemm_phase<pg8::EpiHyIn, pg8::StaticOrder, true, true>(F.lds + RING_OFF, g, S, E); }
        GRID_BAR();
        if (ON(3)) for (int rep = 0; rep < NREP(3); ++rep) {
            for (int r2 = 0; r2 < NREP(31); ++r2) for (int hm = (int)blockIdx.x; hm < MROWS / 128; hm += F.G) mla_up_unit(F, hm, U0, (const bf16*)(ws + WS_WUQ), (const bf16*)(ws + WS_WUKV), SSQQ, SSQKV, ROPE0, 0.10206207261596577f * LOG2E, QM, KF, VM);
            for (int r2 = 0; r2 < NREP(33); ++r2) krot_pass(F, KR, ROPE0, KF);
            for (int r2 = 0; r2 < NREP(34); ++r2) gla_pre(F, U0, GA, I.w_a2, I.b_a, KD, QA, QI, DEC);
        }
        GRID_BAR();
        if (ON(4)) for (int rep = 0; rep < NREP(4); ++rep) {
            if (blockIdx.x < 32) for (int r2 = 0; r2 < NREP(41); ++r2) gla_unit(F, (int)blockIdx.x >> 2, (int)blockIdx.x & 3, U0, KD, QA, QI, DEC, I.gla_norm, O0);
            { const int xg = (int)blockIdx.x & 7;
              for (int r2 = 0; r2 < NREP(42); ++r2) for (;;) { const int i = wq_next(F, CW_Q0 + 64 * xg + 1024 * rep + 2048 * r2); if (i >= 128) break; const int pr = 8 * xg + (i & 7); mla_attn_unit(F, pr >> 3, pr & 7, 15 - (i >> 3), QM, KF, VM, O0); } }
        }
        GRID_BAR();
        if (ON(5)) { pg8::Gemm g{O0, (const bf16*)(ws + WS_WOUT0), MROWS, DM, DM, DM}; pg8::StaticOrder S; S.init(MROWS, DM, F.G, (int)blockIdx.x, WGM_OTHER);
            pg8::EpiResidT<false> E{I.x, HB, SSQ, 1.0f}; pg8::gemm_phase<pg8::EpiResidT<false>, pg8::StaticOrder, true, true>(F.lds + RING_OFF, g, S, E); }
        GRID_BAR();
    }
    FFN_PHASES(1, false, 6);
    FFN_PHASES(2, false, 7);
    {
        bf16* QN = (bf16*)(ws + WS_QN); bf16* KV6 = (bf16*)(ws + WS_KV6); bf16* O1 = (bf16*)(ws + WS_O1); float* GT = (float*)(ws + WS_GT);
        bf16* KCMP = (bf16*)(ws + WS_KCMP); bf16* VCMP = (bf16*)(ws + WS_VCMP); const float* ROPE1 = (const float*)(ws + WS_ROPE1);
        if (ON(8)) for (int rep = 0; rep < NREP(8); ++rep) { pg8::Gemm g{HB, (const bf16*)(ws + WS_WIN1), MROWS, NSAN, DM, DM}; pg8::StaticOrder S; S.init(MROWS, NSAN, F.G, (int)blockIdx.x, WGM_OTHER);
            pg8::EpiNsaIn E{QN, KV6, SSQ, ROPE1, 0.125f * LOG2E}; pg8::gemm_phase<pg8::EpiNsaIn, pg8::StaticOrder, true, true>(F.lds + RING_OFF, g, S, E);
            for (int r2 = 0; r2 < NREP(81); ++r2) for (int hm = (int)blockIdx.x; hm < MROWS / 128; hm += F.G) nsa_gates_unit(F, hm, HB, (const bf16*)(ws + WS_WGT), SSQ, GT); }
        GRID_BAR();
        if (ON(9)) for (int rep = 0; rep < NREP(9); ++rep) { for (int u = (int)blockIdx.x; u < 512; u += F.G) compress_unit(F, u, KV6, (const bf16*)(ws + WS_CW1), (const bf16*)(ws + WS_CW2), (const float*)(ws + WS_BIAS1), ROPE1, KCMP, VCMP); }
        GRID_BAR();
        if (ON(10)) for (int rep = 0; rep < NREP(10); ++rep) {
            const int xg = (int)blockIdx.x & 7;
            for (;;) { const int i = wq_next(F, CW_Q1 + 64 * xg + 1024 * rep); if (i >= 256) break; const int pr = 4 * xg + (i & 3), qb = 63 - (i >> 2);
                if (DUP == 110) nsa_unit<1>(F, pr >> 2, pr & 3, qb, QN, KV6, KCMP, VCMP, GT, O1);
                nsa_unit<0>(F, pr >> 2, pr & 3, qb, QN, KV6, KCMP, VCMP, GT, O1); } }
        GRID_BAR();
        if (ON(11)) { pg8::Gemm g{O1, (const bf16*)(ws + WS_WOUT1), MROWS, DM, DM, DM}; pg8::StaticOrder S; S.init(MROWS, DM, F.G, (int)blockIdx.x, WGM_OTHER);
            pg8::EpiResidT<false> E{I.x, HB, SSQ, 1.0f}; pg8::gemm_phase<pg8::EpiResidT<false>, pg8::StaticOrder, true, true>(F.lds + RING_OFF, g, S, E); }
        GRID_BAR();
    }
    FFN_PHASES(3, false, 12);
    final_norm(F, HB, out, SSQ, I.final_norm);
    if (blockIdx.x == 0 && threadIdx.x == 0) { if (__hip_atomic_load((unsigned*)(F.ctl + CW_BAR) + XB_TMO, RLX_AGENT) != 0u) { VM_WAIT(); out[0] = __builtin_nanf(""); } }
#undef ON
#undef GRID_BAR
}

extern "C" void kernel_launch(void* const* d_in, const int* in_sizes, int n_in, void* d_out, int out_size, void* d_ws, size_t ws_size, hipStream_t stream) {
    static int grid = 0;
    if (grid == 0) {
        if (n_in != 25 || in_sizes[0] != MROWS * DM || out_size != MROWS * DM || ws_size < WS_END) { fprintf(stderr, "kernel_launch: unexpected shapes (n_in %d, in0 %d, out %d, ws %zu); nothing launched\n", n_in, n_in > 0 ? in_sizes[0] : -1, out_size, ws_size); grid = -1; return; }
        int dev = 0, cus = 0, per_cu = 0;
        if (hipGetDevice(&dev) != hipSuccess || hipDeviceGetAttribute(&cus, hipDeviceAttributeMultiprocessorCount, dev) != hipSuccess) { grid = -1; return; }
        if (hipFuncSetAttribute((const void*)trunk_fwd, hipFuncAttributeMaxDynamicSharedMemorySize, LDS_BYTES) != hipSuccess) { fprintf(stderr, "kernel_launch: hipFuncSetAttribute failed\n"); grid = -1; return; }
        if (hipOccupancyMaxActiveBlocksPerMultiprocessor(&per_cu, (const void*)trunk_fwd, NWAVES * 64, LDS_BYTES) != hipSuccess || per_cu < 1) { fprintf(stderr, "kernel_launch: occupancy query reports %d workgroups per CU\n", per_cu); }
        (void)hipGetLastError();
        grid = cus;
    }
    if (grid < 0) return;
    if (hipMemsetAsync((char*)d_ws + WS_CTL, 0, CTL_ZERO_BYTES, stream) != hipSuccess) return;
    Args a{};
    const void** ip = (const void**)&a.in;
    for (int i = 0; i < 25; ++i) ip[i] = d_in[i];
    a.out = (float*)d_out; a.ws = (unsigned char*)d_ws;
    for (int j = 0; j < 16; ++j) a.rf.f16[j] = (double)powf(10000.0f, -(float)j * (2.0f / 32.0f));
    for (int j = 0; j < 32; ++j) a.rf.f32[j] = (double)powf(10000.0f, -(float)j * (2.0f / 64.0f));
    hipLaunchKernelGGL(trunk_fwd, dim3(grid), dim3(NWAVES * 64), LDS_BYTES, stream, a);
}
```

```cpp
#include <hip/hip_runtime.h>
#include <cstdio>
#include <cstdint>
#include <cmath>
namespace pg8 {
#define PG8_LAS __attribute__((address_space(3)))
typedef unsigned short bf16_t;
typedef short bf16x8 __attribute__((ext_vector_type(8)));
typedef float f32x4 __attribute__((ext_vector_type(4)));
typedef unsigned u32x4 __attribute__((ext_vector_type(4)));
constexpr int BM = 256, BK = 64, HALF = 128, HTB = HALF * BK * 2  , STAGE_BYTES = 8 * HTB, NXCD = 8, WGM = 4;

__host__ __device__ __forceinline__ int lds_byte(int r, int c) { const int st = (r >> 4) * 2 + (c >> 5), rr = r & 15, cc = c & 31, ob = rr * 64 + cc * 2; return st * 1024 + (ob ^ (((ob >> 9) & 1) << 5)); }
__host__ __device__ __forceinline__ void stage_rc(int b, int& R, int& C) { const int st = b / 1024, sb = b % 1024, swz = sb ^ (((sb >> 9) & 1) << 5); R = (st >> 1) * 16 + swz / 64; C = (st & 1) * 32 + (swz % 64) / 2; }
__host__ __device__ __forceinline__ int perm32(int rho) { const int n = rho >> 4, i = rho & 15; return 8 * (i >> 2) + 4 * n + (i & 3); }

struct Unit { int pm, pn; };
struct Gemm { const bf16_t* A; const bf16_t* Bt; int M, N, K, lda; };

struct StaticOrder {
    int nM, nN, nwg, G, c, wgm;
    __host__ __device__ void init(int M, int N, int G_, int c_, int wgm_ = WGM) { nM = M / BM; nN = N / BM; nwg = nM * nN; G = G_; c = c_; wgm = wgm_; }
    __host__ __device__ bool next(int i, Unit& u) const {
        const long L = (long)i * G + c; if (L >= nwg) return false;
        int wgid = (int)L; { const int q = nwg / NXCD, r = nwg % NXCD, xcd = wgid % NXCD, off = wgid / NXCD; wgid = (xcd < r ? xcd * (q + 1) : r * (q + 1) + (xcd - r) * q) + off; }
        const int nig = wgm * nN, gid = wgid / nig, fm = gid * wgm, gsz = (nM - fm) < wgm ? (nM - fm) : wgm;
        u.pm = fm + ((wgid % nig) % gsz); u.pn = (wgid % nig) / gsz; return true;
    }
    __device__ __forceinline__ void a_ready(const Unit&) const {}
    __device__ __forceinline__ void done(const Unit&) const {}
};

typedef float f32x2_t __attribute__((ext_vector_type(2))); typedef __bf16 bf16x2_t __attribute__((ext_vector_type(2)));
__device__ __forceinline__ unsigned cvtpk(float lo, float hi) { f32x2_t v = {lo, hi}; bf16x2_t b = __builtin_convertvector(v, bf16x2_t); return __builtin_bit_cast(unsigned, b); }
__device__ __forceinline__ u32x4 pack8(const f32x4 a, const f32x4 b) { u32x4 w; w.x = cvtpk(a[0], a[1]); w.y = cvtpk(a[2], a[3]); w.z = cvtpk(b[0], b[1]); w.w = cvtpk(b[2], b[3]); return w; }
__device__ __forceinline__ float silu_f(float x) { return x * __builtin_amdgcn_rcpf(1.0f + __builtin_amdgcn_exp2f(-1.4426950408889634f * x)); }
__device__ __forceinline__ float sigmoid_f(float x) { return __builtin_amdgcn_rcpf(1.0f + __builtin_amdgcn_exp2f(-1.4426950408889634f * x)); }
constexpr float NORM_EPS = 1e-6f;
template <int NP> __device__ __forceinline__ void row_rstd8(float (&rs)[2][4], const float* ssq, int row0, int fq, float inv_n) {
#pragma unroll
    for (int ai = 0; ai < 2; ++ai)
#pragma unroll
        for (int m = 0; m < 4; ++m) { const int row = row0 + ai * HALF + m * 16; float s;
            if (NP == 16) { const f32x4 p = *(const f32x4*)(ssq + (size_t)row * 16 + 4 * fq); s = (p[0] + p[1]) + (p[2] + p[3]); } else { s = ssq[(size_t)row * 4 + fq]; }
            s += __shfl_xor(s, 16); s += __shfl_xor(s, 32); rs[ai][m] = __builtin_amdgcn_rsqf(s * inv_n + NORM_EPS); }
}
__device__ __forceinline__ float sq8(const f32x4 a, const f32x4 b) { return ((a[0] * a[0] + a[1] * a[1]) + (a[2] * a[2] + a[3] * a[3])) + ((b[0] * b[0] + b[1] * b[1]) + (b[2] * b[2] + b[3] * b[3])); }

__device__ __forceinline__ void epi_ids(int& wr, int& wc, int& fr, int& fq) { int t = threadIdx.x; asm volatile("" : "+v"(t)); const int wid = __builtin_amdgcn_readfirstlane(t >> 6); wr = wid >> 2; wc = wid & 3; fr = t & 15; fq = (t >> 4) & 3; }
struct EpiGateUp {
    static constexpr bool PERM = true, AFTER_DRAIN = false;
    bf16_t* H; const float* ssq; int ldh;
    __device__ __forceinline__ void operator()(const f32x4 (&acc)[2][2][4][2], const Unit& u, int wr_, int wc_, int fr_, int fq_) const {
        int wr, wc, fr, fq; epi_ids(wr, wc, fr, fq);
        const int row0 = u.pm * BM + wr * 64 + fr, col = u.pn * HALF + wc * 32 + 8 * fq;
        float rs[2][4]; row_rstd8<16>(rs, ssq, row0, fq, 1.0f / 1024.0f);
#pragma unroll
        for (int ai = 0; ai < 2; ++ai)
#pragma unroll
            for (int m = 0; m < 4; ++m) { const float r = rs[ai][m], rr = r * r, rn = r * -1.4426950408889634f; f32x4 h0, h1;
                const f32x4 g0 = acc[ai][0][m][0], g1 = acc[ai][0][m][1], p0 = (g0 * acc[ai][1][m][0]) * rr, p1 = (g1 * acc[ai][1][m][1]) * rr, e0 = g0 * rn, e1 = g1 * rn;
#pragma unroll
                for (int e = 0; e < 4; ++e) { h0[e] = p0[e] * __builtin_amdgcn_rcpf(1.0f + __builtin_amdgcn_exp2f(e0[e])); h1[e] = p1[e] * __builtin_amdgcn_rcpf(1.0f + __builtin_amdgcn_exp2f(e1[e])); }
                *(u32x4*)(H + (size_t)(row0 + ai * HALF + m * 16) * ldh + col) = pack8(h0, h1); }
    }
};
struct EpiNull {
    static constexpr bool PERM = true, AFTER_DRAIN = false;
    __device__ __forceinline__ void operator()(const f32x4 (&acc)[2][2][4][2], const Unit& u, int, int, int, int) const {
#pragma unroll
        for (int ai = 0; ai < 2; ++ai)
#pragma unroll
            for (int bj = 0; bj < 2; ++bj) asm volatile("" :: "v"(acc[ai][bj][0][0]), "v"(acc[ai][bj][0][1]), "v"(acc[ai][bj][1][0]), "v"(acc[ai][bj][1][1]), "v"(acc[ai][bj][2][0]), "v"(acc[ai][bj][2][1]), "v"(acc[ai][bj][3][0]), "v"(acc[ai][bj][3][1]));
    }
};
template <bool XBASE> struct EpiResidT {
    static constexpr bool PERM = true, AFTER_DRAIN = false;
    const float* xbase; bf16_t* hb; float* ssq; float alpha;
    __device__ __forceinline__ void operator()(const f32x4 (&acc)[2][2][4][2], const Unit& u, int wr_, int wc_, int fr_, int fq_) const {
        int wr, wc, fr, fq; epi_ids(wr, wc, fr, fq);
        const int row0 = u.pm * BM + wr * 64 + fr, col = u.pn * BM + wc * 32 + 8 * fq;
        if (XBASE) {
#pragma unroll
            for (int ai = 0; ai < 2; ++ai) { f32x4 bx[4][2][2];
#pragma unroll
                for (int m = 0; m < 4; ++m)
#pragma unroll
                    for (int bj = 0; bj < 2; ++bj) { const size_t off = (size_t)(row0 + ai * HALF + m * 16) * 1024 + col + bj * HALF; bx[m][bj][0] = *(const f32x4*)(xbase + off); bx[m][bj][1] = *(const f32x4*)(xbase + off + 4); }
#pragma unroll
                for (int m = 0; m < 4; ++m) { const size_t off = (size_t)(row0 + ai * HALF + m * 16) * 1024 + col; float s = 0.f;
#pragma unroll
                    for (int bj = 0; bj < 2; ++bj) { const f32x4 v0 = bx[m][bj][0] + alpha * acc[ai][bj][m][0], v1 = bx[m][bj][1] + alpha * acc[ai][bj][m][1]; *(u32x4*)(hb + off + bj * HALF) = pack8(v0, v1); s += sq8(v0, v1); }
                    s += __shfl_xor(s, 16); s += __shfl_xor(s, 32);
                    if (fq == 0) ssq[(size_t)(row0 + ai * HALF + m * 16) * 16 + u.pn * 4 + wc] = s; }
                asm volatile("" ::: "memory"); }
        } else {
            u32x4 bw[2][4][2];
#pragma unroll
            for (int ai = 0; ai < 2; ++ai)
#pragma unroll
                for (int m = 0; m < 4; ++m)
#pragma unroll
                    for (int bj = 0; bj < 2; ++bj) bw[ai][m][bj] = *(const u32x4*)(hb + (size_t)(row0 + ai * HALF + m * 16) * 1024 + col + bj * HALF);
#pragma unroll
            for (int ai = 0; ai < 2; ++ai)
#pragma unroll
                for (int m = 0; m < 4; ++m) { const size_t off = (size_t)(row0 + ai * HALF + m * 16) * 1024 + col; float s = 0.f;
#pragma unroll
                    for (int bj = 0; bj < 2; ++bj) { const u32x4 w = bw[ai][m][bj];
                        const f32x4 b0 = {__builtin_bit_cast(float, w.x << 16), __builtin_bit_cast(float, w.x & 0xffff0000u), __builtin_bit_cast(float, w.y << 16), __builtin_bit_cast(float, w.y & 0xffff0000u)};
                        const f32x4 b1 = {__builtin_bit_cast(float, w.z << 16), __builtin_bit_cast(float, w.z & 0xffff0000u), __builtin_bit_cast(float, w.w << 16), __builtin_bit_cast(float, w.w & 0xffff0000u)};
                        const f32x4 v0 = b0 + alpha * acc[ai][bj][m][0], v1 = b1 + alpha * acc[ai][bj][m][1]; *(u32x4*)(hb + off + bj * HALF) = pack8(v0, v1); s += sq8(v0, v1); }
                    s += __shfl_xor(s, 16); s += __shfl_xor(s, 32);
                    if (fq == 0) ssq[(size_t)(row0 + ai * HALF + m * 16) * 16 + u.pn * 4 + wc] = s; }
        }
    }
};
template <class E0> struct EpiTwice {
    static constexpr bool PERM = E0::PERM, AFTER_DRAIN = false; E0 e;
    __device__ __forceinline__ void operator()(const f32x4 (&acc)[2][2][4][2], const Unit& u, int a, int b, int c, int d) const { e(acc, u, a, b, c, d); asm volatile("" ::: "memory"); e(acc, u, a, b, c, d); }
};
struct EpiHyIn {
    static constexpr bool PERM = true, AFTER_DRAIN = false;
    bf16_t* U; const float* ssq; float* ssqq; float* ssqkv; float* kr; float* ga;
    __device__ __forceinline__ void operator()(const f32x4 (&acc)[2][2][4][2], const Unit& u, int wr_, int wc_, int fr_, int fq_) const {
        int wr, wc, fr, fq; epi_ids(wr, wc, fr, fq);
        const int row0 = u.pm * BM + wr * 64 + fr, col = u.pn * BM + wc * 32 + 8 * fq;
        float rs[2][4]; row_rstd8<16>(rs, ssq, row0, fq, 1.0f / 1024.0f);
#pragma unroll
        for (int ai = 0; ai < 2; ++ai)
#pragma unroll
            for (int m = 0; m < 4; ++m) { const int row = row0 + ai * HALF + m * 16; const float r = rs[ai][m];
                const f32x4 a0 = acc[ai][0][m][0] * r, a1 = acc[ai][0][m][1] * r, b0 = acc[ai][1][m][0] * r, b1 = acc[ai][1][m][1] * r;
                bf16_t* up = U + (size_t)row * 2048 + col;
                if (u.pn == 0) { *(u32x4*)up = pack8(a0, a1); *(u32x4*)(up + HALF) = pack8(b0, b1);
                    float s = sq8(a0, a1) + sq8(b0, b1); s += __shfl_xor(s, 16); s += __shfl_xor(s, 32); if (fq == 0) ssqq[(size_t)row * 4 + wc] = s; }
                else if (u.pn == 1) { *(u32x4*)up = pack8(a0, a1);
                    float s = sq8(a0, a1); s += __shfl_xor(s, 16); s += __shfl_xor(s, 32); if (fq == 0) ssqkv[(size_t)row * 4 + wc] = s;
                    if (wc == 0) { *(f32x4*)(kr + (size_t)row * 32 + 8 * fq) = b0; *(f32x4*)(kr + (size_t)row * 32 + 8 * fq + 4) = b1; }
                    else if (wc == 1 && fq < 2) { *(f32x4*)(ga + (size_t)row * 16 + 8 * fq) = b0; *(f32x4*)(ga + (size_t)row * 16 + 8 * fq + 4) = b1; } }
                else { *(u32x4*)up = pack8(a0, a1); *(u32x4*)(up + HALF) = pack8(b0, b1); } }
    }
};
struct EpiQup {
    static constexpr bool PERM = true, AFTER_DRAIN = false;
    bf16_t* QM; const float* ssqq; const float* rope; float c2;
    __device__ __forceinline__ void operator()(const f32x4 (&acc)[2][2][4][2], const Unit& u, int wr_, int wc_, int fr_, int fq_) const {
        int wr, wc, fr, fq; epi_ids(wr, wc, fr, fq);
        const int row0 = u.pm * BM + wr * 64 + fr;
        float rs[2][4]; row_rstd8<4>(rs, ssqq, row0, fq, 1.0f / 256.0f);
#pragma unroll
        for (int ai = 0; ai < 2; ++ai)
#pragma unroll
            for (int m = 0; m < 4; ++m) { const int row = row0 + ai * HALF + m * 16; const float r = rs[ai][m] * c2;
                const f32x4 a0 = acc[ai][0][m][0] * r, a1 = acc[ai][0][m][1] * r, b0 = acc[ai][1][m][0] * r, b1 = acc[ai][1][m][1] * r;
                bf16_t* qp = QM + (size_t)row * 768;
                if (u.pn < 2) { const int c0 = u.pn * BM + wc * 32 + 8 * fq, c1 = c0 + HALF;
                    *(u32x4*)(qp + (c0 >> 6) * 96 + (c0 & 63)) = pack8(a0, a1); *(u32x4*)(qp + (c1 >> 6) * 96 + (c1 & 63)) = pack8(b0, b1); }
                else { const int j0 = wc * 32 + 8 * fq, h = j0 >> 4, i0 = j0 & 15; const f32x4* cs = (const f32x4*)(rope + ((size_t)row * 16 + i0) * 2);
                    const f32x4 t0 = cs[0], t1 = cs[1], t2 = cs[2], t3 = cs[3];
                    const f32x4 cA = {t0[0], t0[2], t1[0], t1[2]}, sA = {t0[1], t0[3], t1[1], t1[3]}, cB = {t2[0], t2[2], t3[0], t3[2]}, sB = {t2[1], t2[3], t3[1], t3[3]};
                    const f32x4 y10 = a0 * cA - b0 * sA, y11 = a1 * cB - b1 * sB, y20 = b0 * cA + a0 * sA, y21 = b1 * cB + a1 * sB;
                    *(u32x4*)(qp + h * 96 + 64 + i0) = pack8(y10, y11); *(u32x4*)(qp + h * 96 + 80 + i0) = pack8(y20, y21); } }
    }
};
struct EpiKVup {
    static constexpr bool PERM = true, AFTER_DRAIN = false;
    bf16_t* KF; bf16_t* VM; const float* ssqkv;
    __device__ __forceinline__ void operator()(const f32x4 (&acc)[2][2][4][2], const Unit& u, int wr_, int wc_, int fr_, int fq_) const {
        int wr, wc, fr, fq; epi_ids(wr, wc, fr, fq);
        const int row0 = u.pm * BM + wr * 64 + fr, w = wc * 32 + 8 * fq;
        float rs[2][4]; row_rstd8<4>(rs, ssqkv, row0, fq, 1.0f / 128.0f);
#pragma unroll
        for (int ai = 0; ai < 2; ++ai)
#pragma unroll
            for (int m = 0; m < 4; ++m) { const int row = row0 + ai * HALF + m * 16; const float r = rs[ai][m];
#pragma unroll
                for (int bj = 0; bj < 2; ++bj) { const int h = 2 * u.pn + bj; const u32x4 v = pack8(acc[ai][bj][m][0] * r, acc[ai][bj][m][1] * r);
                    if (wc < 2) *(u32x4*)(KF + (size_t)row * 768 + h * 96 + w) = v; else *(u32x4*)(VM + (size_t)row * 512 + h * 64 + (w - 64)) = v; } }
    }
};
struct EpiNsaIn {
    static constexpr bool PERM = true, AFTER_DRAIN = false;
    bf16_t* QN; bf16_t* KV6;
    const float* ssq; const float* rope; float c2;
    __device__ __forceinline__ void operator()(const f32x4 (&acc)[2][2][4][2], const Unit& u, int wr_, int wc_, int fr_, int fq_) const {
        int wr, wc, fr, fq; epi_ids(wr, wc, fr, fq);
        const int row0 = u.pm * BM + wr * 64 + fr;
        float rs[2][4]; row_rstd8<16>(rs, ssq, row0, fq, 1.0f / 1024.0f);
        const bool is_rope = (u.pn < 4) || u.pn == 6 || u.pn == 8;
#pragma unroll
        for (int ai = 0; ai < 2; ++ai)
#pragma unroll
            for (int m = 0; m < 4; ++m) { const int row = row0 + ai * HALF + m * 16; const float r = rs[ai][m] * (u.pn < 4 ? c2 : 1.0f);
                const f32x4 a0 = acc[ai][0][m][0] * r, a1 = acc[ai][0][m][1] * r, b0 = acc[ai][1][m][0] * r, b1 = acc[ai][1][m][1] * r;
                if (is_rope) { const int i0 = 8 * fq; const f32x4* cs = (const f32x4*)(rope + ((size_t)row * 32 + i0) * 2);
                    const f32x4 t0 = cs[0], t1 = cs[1], t2 = cs[2], t3 = cs[3];
                    const f32x4 cA = {t0[0], t0[2], t1[0], t1[2]}, sA = {t0[1], t0[3], t1[1], t1[3]}, cB = {t2[0], t2[2], t3[0], t3[2]}, sB = {t2[1], t2[3], t3[1], t3[3]};
                    const f32x4 y10 = a0 * cA - b0 * sA, y11 = a1 * cB - b1 * sB, y20 = b0 * cA + a0 * sA, y21 = b1 * cB + a1 * sB;
                    bf16_t* dst = (u.pn < 4) ? QN + (size_t)row * 1024 + (4 * u.pn + wc) * 64 : KV6 + (size_t)(u.pn - 4) * ((size_t)32768 * 256) + (size_t)row * 256 + wc * 64;
                    *(u32x4*)(dst + i0) = pack8(y10, y11); *(u32x4*)(dst + 32 + i0) = pack8(y20, y21); }
                else { bf16_t* dst = KV6 + (size_t)(u.pn - 4) * ((size_t)32768 * 256) + (size_t)row * 256 + wc * 32 + 8 * fq;
                    *(u32x4*)dst = pack8(a0, a1); *(u32x4*)(dst + HALF) = pack8(b0, b1); } }
    }
};

template <class Epi, class Sched, bool ALIGN_EPI = false, bool SP2 = false>
__device__ __forceinline__ void gemm_phase(PG8_LAS unsigned char* lds, const Gemm g, const Sched& S, const Epi& E) {
    int tid_ = threadIdx.x; asm volatile("" : "+v"(tid_));
    const int tid = tid_, wid = __builtin_amdgcn_readfirstlane(tid >> 6), lane = tid & 63, wr = wid >> 2, wc = wid & 3, fr = lane & 15, fq = lane >> 4;
    const int K = g.K, nt = K / BK;
    unsigned voffA[2], voffB[2];
#pragma unroll
    for (int i = 0; i < 2; ++i) { int R, C; stage_rc(tid * 16 + i * 8192, R, C); const int Rb = Epi::PERM ? ((R & ~31) + perm32(R & 31)) : R;
        voffA[i] = (unsigned)(R * g.lda + C) * 2u; voffB[i] = (unsigned)(Rb * K + C) * 2u; }
    const size_t kstep = (size_t)(BK * 2);
    const size_t hstepA = (size_t)HALF * g.lda * 2, hstepB = (size_t)HALF * K * 2;
    const size_t tstepA = 2 * hstepA, tstepB = 2 * hstepB;
    const unsigned ldsw = (unsigned)wid * 1024u;
    const int aoff = lds_byte(wr * 64 + fr, fq * 8), boff = lds_byte(wc * 32 + fr, fq * 8);
#define PG8_SA(b, h) (((b) * 2 + (h)) * HTB)
#define PG8_SB(b, h) ((4 + (b) * 2 + (h)) * HTB)
#define PG8_STAGE(bufoff, gbase, voff) do { _Pragma("unroll") for (int _i = 0; _i < 2; ++_i) \
        __builtin_amdgcn_global_load_lds((const unsigned*)((const char*)(gbase) + (voff)[_i]), (PG8_LAS unsigned*)(lds + (bufoff) + ldsw + _i * 8192), 16, 0, 0); } while (0)
#define PG8_LDA(dst, b, h) do { _Pragma("unroll") for (int m = 0; m < 4; ++m) _Pragma("unroll") for (int k = 0; k < 2; ++k) dst[m][k] = *(const PG8_LAS bf16x8*)(lds + PG8_SA(b, h) + aoff + m * 2048 + k * 1024); } while (0)
#define PG8_LDB(dst, b, h) do { _Pragma("unroll") for (int n = 0; n < 2; ++n) _Pragma("unroll") for (int k = 0; k < 2; ++k) dst[n][k] = *(const PG8_LAS bf16x8*)(lds + PG8_SB(b, h) + boff + n * 2048 + k * 1024); } while (0)
#define PG8_MMA(ai, bj, At, Bt) do { __builtin_amdgcn_s_setprio(1); _Pragma("unroll") for (int m = 0; m < 4; ++m) _Pragma("unroll") for (int n = 0; n < 2; ++n) _Pragma("unroll") for (int k = 0; k < 2; ++k) \
        acc[ai][bj][m][n] = __builtin_amdgcn_mfma_f32_16x16x32_bf16(Bt[n][k], At[m][k], acc[ai][bj][m][n], 0, 0, 0); __builtin_amdgcn_s_setprio(0); } while (0)
#define PG8_WAIT_V(n) asm volatile("s_waitcnt vmcnt(" #n ")" ::: "memory")
#define PG8_WAIT_L(n) asm volatile("s_waitcnt lgkmcnt(" #n ")" ::: "memory")
#define PG8_BAR __builtin_amdgcn_s_barrier()
#define PG8_SCHED __builtin_amdgcn_sched_barrier(0)
    Unit cur, nxt; int ui = 0;
    if (!S.next(0, cur)) return;
    f32x4 acc[2][2][4][2];
#pragma unroll
    for (int a = 0; a < 2; ++a)
#pragma unroll
        for (int b = 0; b < 2; ++b)
#pragma unroll
            for (int m = 0; m < 4; ++m)
#pragma unroll
                for (int n = 0; n < 2; ++n) acc[a][b][m][n] = (f32x4){0.f, 0.f, 0.f, 0.f};
    bf16x8 At[4][2], B0[2][2], B1[2][2];
    const char* cA = (const char*)g.A + (size_t)cur.pm * tstepA; const char* cB = (const char*)g.Bt + (size_t)cur.pn * tstepB;
    S.a_ready(cur);
    if constexpr (SP2) {
        PG8_STAGE(PG8_SB(0, 0), cB, voffB); PG8_STAGE(PG8_SB(0, 1), cB + hstepB, voffB); PG8_STAGE(PG8_SA(0, 0), cA, voffA); PG8_STAGE(PG8_SA(0, 1), cA + hstepA, voffA);
        if (wr == 1) PG8_BAR;
        PG8_WAIT_V(2); PG8_BAR;
        PG8_STAGE(PG8_SB(1, 0), cB + kstep, voffB); PG8_STAGE(PG8_SA(1, 0), cA + kstep, voffA); PG8_STAGE(PG8_SB(1, 1), cB + hstepB + kstep, voffB);
        PG8_WAIT_V(6); PG8_BAR;
    } else {
        PG8_STAGE(PG8_SB(0, 0), cB, voffB); PG8_STAGE(PG8_SA(0, 0), cA, voffA); PG8_STAGE(PG8_SB(0, 1), cB + hstepB, voffB); PG8_STAGE(PG8_SA(0, 1), cA + hstepA, voffA);
        if (wr == 1) PG8_BAR;
        PG8_WAIT_V(4); PG8_BAR;
        PG8_STAGE(PG8_SB(1, 0), cB + kstep, voffB); PG8_STAGE(PG8_SA(1, 0), cA + kstep, voffA); PG8_STAGE(PG8_SB(1, 1), cB + hstepB + kstep, voffB);
        PG8_WAIT_V(6); PG8_BAR;
    }
    for (;;) {
        const bool has_next = S.next(ui + 1, nxt);
        const char* nA = has_next ? (const char*)g.A + (size_t)nxt.pm * tstepA : cA; const char* nB = has_next ? (const char*)g.Bt + (size_t)nxt.pn * tstepB : cB;
        for (int t = 0; t < nt; t += 2) {
            const bool last = (t == nt - 2);
            const char* a1 = cA + (size_t)(t + 1) * kstep;
            const char* a2 = last ? nA : cA + (size_t)(t + 2) * kstep; const char* b2 = last ? nB : cB + (size_t)(t + 2) * kstep;
            const char* a3 = a2 + kstep; const char* b3 = b2 + kstep;
            if (last && has_next) S.a_ready(nxt);
            if constexpr (SP2) {
            PG8_LDB(B0, 0, 0); PG8_LDB(B1, 0, 1); PG8_SCHED; PG8_LDA(At, 0, 0); PG8_STAGE(PG8_SA(1, 1), a1 + hstepA, voffA);
            PG8_WAIT_V(8); PG8_WAIT_L(0); PG8_BAR; PG8_MMA(0, 0, At, B0); PG8_MMA(0, 1, At, B1); PG8_BAR; PG8_SCHED;
            PG8_LDA(At, 0, 1); PG8_STAGE(PG8_SB(0, 0), b2, voffB); PG8_STAGE(PG8_SB(0, 1), b2 + hstepB, voffB); PG8_STAGE(PG8_SA(0, 0), a2, voffA);
            PG8_WAIT_V(8); PG8_WAIT_L(0); PG8_BAR; PG8_MMA(1, 0, At, B0); PG8_MMA(1, 1, At, B1); PG8_BAR; PG8_SCHED;
            PG8_LDB(B0, 1, 0); PG8_LDB(B1, 1, 1); PG8_SCHED; PG8_LDA(At, 1, 0); PG8_STAGE(PG8_SA(0, 1), a2 + hstepA, voffA);
            PG8_WAIT_V(8); PG8_WAIT_L(0); PG8_BAR; PG8_MMA(0, 0, At, B0); PG8_MMA(0, 1, At, B1); PG8_BAR; PG8_SCHED;
            PG8_LDA(At, 1, 1); PG8_STAGE(PG8_SB(1, 0), b3, voffB); PG8_STAGE(PG8_SB(1, 1), b3 + hstepB, voffB); PG8_STAGE(PG8_SA(1, 0), a3, voffA);
            PG8_WAIT_V(8); PG8_WAIT_L(0); PG8_BAR; PG8_MMA(1, 0, At, B0); PG8_MMA(1, 1, At, B1); PG8_BAR; PG8_SCHED;
            } else {
            PG8_LDB(B0, 0, 0); PG8_SCHED; PG8_LDA(At, 0, 0); PG8_STAGE(PG8_SA(1, 1), a1 + hstepA, voffA);
            PG8_WAIT_L(8); PG8_BAR; PG8_WAIT_L(0); PG8_MMA(0, 0, At, B0); PG8_BAR; PG8_SCHED;
            PG8_LDB(B1, 0, 1); PG8_STAGE(PG8_SB(0, 0), b2, voffB);
            PG8_BAR; PG8_WAIT_L(0); PG8_MMA(0, 1, At, B1); PG8_BAR;
            PG8_LDA(At, 0, 1); PG8_STAGE(PG8_SA(0, 0), a2, voffA);
            PG8_BAR; PG8_WAIT_L(0); PG8_MMA(1, 0, At, B0); PG8_BAR; PG8_SCHED;
            PG8_STAGE(PG8_SB(0, 1), b2 + hstepB, voffB);
            PG8_WAIT_V(6); PG8_BAR; PG8_MMA(1, 1, At, B1); PG8_BAR;
            PG8_LDB(B0, 1, 0); PG8_SCHED; PG8_LDA(At, 1, 0); PG8_STAGE(PG8_SA(0, 1), a2 + hstepA, voffA);
            PG8_WAIT_L(8); PG8_BAR; PG8_WAIT_L(0); PG8_MMA(0, 0, At, B0); PG8_BAR; PG8_SCHED;
            PG8_LDB(B1, 1, 1); PG8_STAGE(PG8_SB(1, 0), b3, voffB);
            PG8_BAR; PG8_WAIT_L(0); PG8_MMA(0, 1, At, B1); PG8_BAR;
            PG8_LDA(At, 1, 1); PG8_STAGE(PG8_SA(1, 0), a3, voffA);
            PG8_BAR; PG8_WAIT_L(0); PG8_MMA(1, 0, At, B0); PG8_BAR; PG8_SCHED;
            PG8_STAGE(PG8_SB(1, 1), b3 + hstepB, voffB);
            PG8_WAIT_V(6); PG8_BAR; PG8_MMA(1, 1, At, B1); PG8_BAR;
            }
        }
        if constexpr (ALIGN_EPI) { if (wr == 0) PG8_BAR; }
        if constexpr (!Epi::AFTER_DRAIN) { E(acc, cur, wr, wc, fr, fq); S.done(cur); }
        if (!has_next) break;
#pragma unroll
        for (int a = 0; a < 2; ++a)
#pragma unroll
            for (int b = 0; b < 2; ++b)
#pragma unroll
                for (int m = 0; m < 4; ++m)
#pragma unroll
                    for (int n = 0; n < 2; ++n) acc[a][b][m][n] = (f32x4){0.f, 0.f, 0.f, 0.f};
        cur = nxt; cA = nA; cB = nB; ++ui;
        if constexpr (ALIGN_EPI) { if (wr == 1) PG8_BAR; }
    }
    PG8_WAIT_V(0);
    if constexpr (!ALIGN_EPI) { if (wr == 0) PG8_BAR; }
    PG8_BAR;
    if constexpr (Epi::AFTER_DRAIN) { E.fused(acc, cur, wr, wc, fr, fq, lds, wid, lane); S.done(cur); }
#undef PG8_SA
#undef PG8_SB
#undef PG8_STAGE
#undef PG8_LDA
#undef PG8_LDB
#undef PG8_MMA
#undef PG8_WAIT_V
#undef PG8_WAIT_L
#undef PG8_BAR
#undef PG8_SCHED
}
}
namespace fa {
#define FA_LAS __attribute__((address_space(3)))
typedef unsigned short bf16_t;
typedef short bf16x8 __attribute__((ext_vector_type(8)));
typedef short s16x4 __attribute__((ext_vector_type(4)));
typedef float f32x16 __attribute__((ext_vector_type(16)));
typedef float f32x4 __attribute__((ext_vector_type(4)));
typedef unsigned u32x4 __attribute__((ext_vector_type(4)));
typedef short v4i16_t __attribute__((ext_vector_type(4)));
typedef FA_LAS const char* lds_cptr;
typedef FA_LAS char* lds_ptr;
#define FA_MFMA(a, b, c) __builtin_amdgcn_mfma_f32_32x32x16_bf16(a, b, c, 0, 0, 0)
#define FA_WAIT_BAR(N) asm volatile("s_waitcnt vmcnt(" #N ") lgkmcnt(0)\n\ts_barrier" ::: "memory")
__device__ __forceinline__ int crow(int r, int hi) { return (r & 3) + 8 * (r >> 2) + 4 * hi; }
__device__ __forceinline__ unsigned cvtpk(float lo, float hi) { return pg8::cvtpk(lo, hi); }
__device__ __forceinline__ void glds16(const void* g, unsigned lds_base) {
    unsigned sv; asm volatile("s_mov_b32 %0, m0\n\ts_mov_b32 m0, %2\n\ts_nop 0\n\tglobal_load_lds_dwordx4 %1, off\n\ts_mov_b32 m0, %0" : "=&s"(sv) : "v"(g), "s"(lds_base) : "memory"); }
__device__ __forceinline__ s16x4 vtr(lds_cptr p) { return __builtin_bit_cast(s16x4, __builtin_amdgcn_ds_read_tr16_b64_v4i16((FA_LAS v4i16_t*)p)); }
__device__ __forceinline__ unsigned lds_addr(lds_cptr p) { return (unsigned)(uintptr_t)p; }
#define FA_MX3(a, b, c) __builtin_fmaxf(__builtin_fmaxf((a), (b)), (c))
__device__ __forceinline__ float swap_max(float m) { auto rr = __builtin_amdgcn_permlane32_swap(__float_as_uint(m), __float_as_uint(m), false, false); return __builtin_fmaxf(__uint_as_float(rr[0]), __uint_as_float(rr[1])); }
__device__ __forceinline__ float swap_sum(float m) { auto rr = __builtin_amdgcn_permlane32_swap(__float_as_uint(m), __float_as_uint(m), false, false); return __uint_as_float(rr[0]) + __uint_as_float(rr[1]); }
__device__ __forceinline__ float rowmax(const f32x16& p0, const f32x16& p1) {
    float a = FA_MX3(p0[0], p0[1], p1[0]), b = FA_MX3(p0[2], p0[3], p1[1]); a = FA_MX3(a, p1[2], p1[3]);
#pragma unroll
    for (int r = 4; r < 16; r += 4) { a = FA_MX3(a, p0[r], p0[r + 1]); b = FA_MX3(b, p0[r + 2], p0[r + 3]); a = FA_MX3(a, p1[r], p1[r + 1]); b = FA_MX3(b, p1[r + 2], p1[r + 3]); }
    return swap_max(__builtin_fmaxf(a, b)); }

template <int DK> __device__ __forceinline__ void dma_k(const bf16_t* ksrc, int kpitch, unsigned kslot, int wid, int lane) {
    glds16(ksrc + (size_t)lane * kpitch + wid * 8, (unsigned)__builtin_amdgcn_readfirstlane(kslot + wid * 1024));
    if (DK > 64) { const int c2 = (wid < DK / 8 - 8) ? wid + 8 : wid;
        glds16(ksrc + (size_t)lane * kpitch + c2 * 8, (unsigned)__builtin_amdgcn_readfirstlane(kslot + c2 * 1024)); }
}
__device__ __forceinline__ void dma_v(const bf16_t* vsrc, int vpitch, unsigned vslot, int wid, int lane) {
    glds16(vsrc + (size_t)(16 * (wid & 3) + (lane >> 2)) * vpitch + (wid >> 2) * 32 + (lane & 3) * 8, (unsigned)__builtin_amdgcn_readfirstlane(vslot + wid * 1024));
}
struct Run { float mref, l; f32x16 o0, o1, negm; bool started; };
__device__ __forceinline__ void run_init(Run& R) { R.mref = 0.f; R.l = 0.f; R.o0 = f32x16{}; R.o1 = f32x16{}; R.negm = f32x16{}; R.started = false; }
constexpr float FA_THR = 8.0f;
template <int DK> __device__ __forceinline__ void qkt(f32x16& p0, f32x16& p1, lds_cptr kslot, const bf16x8* qr, const f32x16& negm, int r32, int hi) {
    const lds_cptr kb = kslot + hi * 1024 + r32 * 16;
    bf16x8 kf[DK / 8];
#pragma unroll
    for (int d0 = 0; d0 < DK / 16; ++d0) { kf[2 * d0] = *(const FA_LAS bf16x8*)(kb + d0 * 2048); kf[2 * d0 + 1] = *(const FA_LAS bf16x8*)(kb + d0 * 2048 + 512); }
    __builtin_amdgcn_sched_barrier(0);
#pragma unroll
    for (int d0 = 0; d0 < DK / 16; ++d0) {
        if (d0 == 0) { p0 = FA_MFMA(kf[0], qr[0], negm); p1 = FA_MFMA(kf[1], qr[0], negm); } else { p0 = FA_MFMA(kf[2 * d0], qr[d0], p0); p1 = FA_MFMA(kf[2 * d0 + 1], qr[d0], p1); } }
}
__device__ __forceinline__ void mask_range(f32x16& p0, f32x16& p1, int kidx0, int klo, int khi, int hi) {
#pragma unroll
    for (int r = 0; r < 16; ++r) { const int k0 = kidx0 + (r & 3) + 8 * (r >> 2) + 4 * hi, k1 = k0 + 32;
        if (k0 < klo || k0 > khi) p0[r] = -INFINITY; if (k1 < klo || k1 > khi) p1[r] = -INFINITY; }
}
__device__ __forceinline__ void softmax_step(Run& R, f32x16& p0, f32x16& p1, FA_LAS float* wsf, int r32, int hi, bool rowok = true) {
    const bool first = !R.started; R.started = true;
    float rm = rowmax(p0, p1); rm = rowok ? rm : -INFINITY;
    if (first || __any(rm > FA_THR)) { const float dl = first ? __builtin_fmaxf(rm, -64.f) : __builtin_fmaxf(rm, 0.f); R.mref += dl;
#pragma unroll
        for (int r = 0; r < 16; ++r) { p0[r] -= dl; p1[r] -= dl; R.negm[r] = -R.mref; }
        if (!first) { const float f = __builtin_amdgcn_exp2f(-dl); R.l *= f; if (hi == 0) wsf[r32] = f;
            asm volatile("s_waitcnt lgkmcnt(0)" ::: "memory");
#pragma unroll
            for (int r = 0; r < 16; ++r) { const float fr_ = wsf[crow(r, hi)]; R.o0[r] *= fr_; R.o1[r] *= fr_; }
            asm volatile("s_waitcnt lgkmcnt(0)" ::: "memory"); } }
    float s0 = 0.f, s1 = 0.f, s2 = 0.f, s3 = 0.f;
#pragma unroll
    for (int r = 0; r < 16; r += 2) { p0[r] = __builtin_amdgcn_exp2f(p0[r]); p0[r + 1] = __builtin_amdgcn_exp2f(p0[r + 1]); p1[r] = __builtin_amdgcn_exp2f(p1[r]); p1[r + 1] = __builtin_amdgcn_exp2f(p1[r + 1]);
        s0 += p0[r]; s1 += p0[r + 1]; s2 += p1[r]; s3 += p1[r + 1]; }
    const float st = (s0 + s1) + (s2 + s3); R.l += rowok ? st : 0.f;
}
__device__ __forceinline__ void pack_p(u32x4 (&pw)[4], const f32x16& p0, const f32x16& p1) {
    pw[0] = (u32x4){cvtpk(p0[0], p0[1]), cvtpk(p0[2], p0[3]), cvtpk(p0[4], p0[5]), cvtpk(p0[6], p0[7])};
    pw[1] = (u32x4){cvtpk(p0[8], p0[9]), cvtpk(p0[10], p0[11]), cvtpk(p0[12], p0[13]), cvtpk(p0[14], p0[15])};
    pw[2] = (u32x4){cvtpk(p1[0], p1[1]), cvtpk(p1[2], p1[3]), cvtpk(p1[4], p1[5]), cvtpk(p1[6], p1[7])};
    pw[3] = (u32x4){cvtpk(p1[8], p1[9]), cvtpk(p1[10], p1[11]), cvtpk(p1[12], p1[13]), cvtpk(p1[14], p1[15])};
}
__device__ __forceinline__ void pv_pw(f32x16& o0, f32x16& o1, const u32x4 (&pw)[4], lds_cptr vslot, int lane, int hi) {
    const lds_cptr vp = vslot + ((lane >> 4) & 1) * 32 + (lane & 3) * 8 + (4 * hi + ((lane & 15) >> 2)) * 64;
    s16x4 vl0[4], vh0[4], vl1[4], vh1[4];
#pragma unroll
    for (int ks = 0; ks < 4; ++ks) { vl0[ks] = vtr(vp + ks * 1024); vh0[ks] = vtr(vp + ks * 1024 + 512); vl1[ks] = vtr(vp + 4096 + ks * 1024); vh1[ks] = vtr(vp + 4096 + ks * 1024 + 512); }
    __builtin_amdgcn_sched_barrier(0);
#pragma unroll
    for (int ks = 0; ks < 4; ++ks) { const bf16x8 pa = __builtin_bit_cast(bf16x8, pw[ks]);
        o0 = FA_MFMA(pa, ((bf16x8){vl0[ks][0], vl0[ks][1], vl0[ks][2], vl0[ks][3], vh0[ks][0], vh0[ks][1], vh0[ks][2], vh0[ks][3]}), o0);
        o1 = FA_MFMA(pa, ((bf16x8){vl1[ks][0], vl1[ks][1], vl1[ks][2], vl1[ks][3], vh1[ks][0], vh1[ks][1], vh1[ks][2], vh1[ks][3]}), o1); }
}
__device__ __forceinline__ void pv(f32x16& o0, f32x16& o1, const f32x16& p0, const f32x16& p1, lds_cptr vslot, int lane, int hi, bool rowok = true) {
    u32x4 pw[4];
    pw[0] = (u32x4){cvtpk(p0[0], p0[1]), cvtpk(p0[2], p0[3]), cvtpk(p0[4], p0[5]), cvtpk(p0[6], p0[7])};
    pw[1] = (u32x4){cvtpk(p0[8], p0[9]), cvtpk(p0[10], p0[11]), cvtpk(p0[12], p0[13]), cvtpk(p0[14], p0[15])};
    pw[2] = (u32x4){cvtpk(p1[0], p1[1]), cvtpk(p1[2], p1[3]), cvtpk(p1[4], p1[5]), cvtpk(p1[6], p1[7])};
    pw[3] = (u32x4){cvtpk(p1[8], p1[9]), cvtpk(p1[10], p1[11]), cvtpk(p1[12], p1[13]), cvtpk(p1[14], p1[15])};
#pragma unroll
    for (int k = 0; k < 4; ++k) { pw[k].x = rowok ? pw[k].x : 0u; pw[k].y = rowok ? pw[k].y : 0u; pw[k].z = rowok ? pw[k].z : 0u; pw[k].w = rowok ? pw[k].w : 0u; }
    const lds_cptr vp = vslot + ((lane >> 4) & 1) * 32 + (lane & 3) * 8 + (4 * hi + ((lane & 15) >> 2)) * 64;
#pragma unroll
    for (int ks = 0; ks < 4; ++ks) {
        const s16x4 l0 = vtr(vp + ks * 1024), h0 = vtr(vp + ks * 1024 + 512), l1 = vtr(vp + 4096 + ks * 1024), h1 = vtr(vp + 4096 + ks * 1024 + 512);
        const bf16x8 pa = __builtin_bit_cast(bf16x8, pw[ks]);
        o0 = FA_MFMA(pa, ((bf16x8){l0[0], l0[1], l0[2], l0[3], h0[0], h0[1], h0[2], h0[3]}), o0);
        o1 = FA_MFMA(pa, ((bf16x8){l1[0], l1[1], l1[2], l1[3], h1[0], h1[1], h1[2], h1[3]}), o1); }
}
__device__ __forceinline__ void run_finish(Run& R, float (&rli)[16], FA_LAS float* wsf, int r32, int hi) {
    const float lt = swap_sum(R.l);
    asm volatile("s_waitcnt lgkmcnt(0)" ::: "memory");
    if (hi == 0) wsf[32 + r32] = lt;
    asm volatile("s_waitcnt lgkmcnt(0)" ::: "memory");
#pragma unroll
    for (int r = 0; r < 16; ++r) rli[r] = 1.0f / __builtin_fmaxf(wsf[32 + crow(r, hi)], 1e-30f);
    asm volatile("s_waitcnt lgkmcnt(0)" ::: "memory");
}
}
constexpr int NWAVES = 8;
constexpr int BATCH = 8, SEQ = 4096, MROWS = BATCH * SEQ, DM = 1024, FF = 2816;
constexpr int HYN = 2048, NSAN = 2560;
constexpr float LOG2E = 1.4426950408889634f;
constexpr size_t MiB = 1u << 20;
constexpr size_t WS_CTL = 0, CTL_ZERO_BYTES = 1 * MiB;
constexpr size_t WS_WGU = 2 * MiB;
constexpr size_t WS_WD = 46 * MiB;
constexpr size_t WS_WIN0 = 68 * MiB;
constexpr size_t WS_WUQ = 72 * MiB;
constexpr size_t WS_WUKV = 72 * MiB + 512 * 1024;
constexpr size_t WS_WOUT0 = 73 * MiB;
constexpr size_t WS_WIN1 = 75 * MiB;
constexpr size_t WS_WOUT1 = 81 * MiB;
constexpr size_t WS_CW1 = 83 * MiB;
constexpr size_t WS_WGT = 80 * MiB + 512 * 1024;
constexpr size_t WS_CW2 = 80 * MiB + 768 * 1024;
constexpr size_t WS_ROPE0 = 84 * MiB;
constexpr size_t WS_ROPE1 = 88 * MiB;
constexpr size_t WS_SSQ = 96 * MiB;
constexpr size_t WS_SSQQ = 98 * MiB;
constexpr size_t WS_SSQKV = 98 * MiB + 512 * 1024;
constexpr size_t WS_KR = 99 * MiB;
constexpr size_t WS_GA = 103 * MiB;
constexpr size_t WS_BIAS1 = 105 * MiB;
constexpr size_t WS_GT = 106 * MiB;
constexpr size_t WS_DEC = 112 * MiB;
constexpr size_t WS_KCMP = 113 * MiB, WS_VCMP = 114 * MiB;
constexpr size_t WS_HB = 116 * MiB;
constexpr size_t WS_BIG = 180 * MiB;
constexpr size_t WS_HID = WS_BIG;
constexpr size_t WS_U0 = WS_BIG;
constexpr size_t WS_QM = 308 * MiB;
constexpr size_t WS_KF = 356 * MiB;
constexpr size_t WS_VM = 404 * MiB;
constexpr size_t WS_O0 = 436 * MiB;
constexpr size_t WS_QN = WS_BIG;
constexpr size_t WS_KV6 = 244 * MiB;
constexpr size_t WS_O1 = 340 * MiB;
constexpr size_t WS_END = 500 * MiB;
constexpr int CW_TMO = 0;
constexpr int CW_BAR = 4096;
constexpr int CW_Q0 = 8192, CW_Q1 = 8192 + 4096;
constexpr int RING_OFF = 0, RING_BYTES = 151552;
constexpr int LDSCTL_OFF = RING_BYTES, MISC_OFF = LDSCTL_OFF + 320;
constexpr int LDS_BYTES = 155648;
static_assert(MISC_OFF + 128 <= LDS_BYTES, "LDS map");

#define GAS __attribute__((address_space(1)))
#define LAS __attribute__((address_space(3)))
typedef unsigned short bf16;
typedef unsigned v4u __attribute__((ext_vector_type(4)));
typedef float f32x4 __attribute__((ext_vector_type(4)));
typedef float f32x2 __attribute__((ext_vector_type(2)));
typedef float f32x16 __attribute__((ext_vector_type(16)));
typedef short bf16x8 __attribute__((ext_vector_type(8)));
typedef GAS unsigned gu32;
#define RLX_AGENT __ATOMIC_RELAXED, __HIP_MEMORY_SCOPE_AGENT
#define LDS_WAIT() asm volatile("s_waitcnt lgkmcnt(0)" ::: "memory")
#define VM_WAIT() asm volatile("s_waitcnt vmcnt(0)" ::: "memory")
__device__ __forceinline__ unsigned f2bf(float f) { unsigned u = __builtin_bit_cast(unsigned, f); return (u + 0x7fffu + ((u >> 16) & 1u)) >> 16; }
__device__ __forceinline__ unsigned pk2(float lo, float hi) { return f2bf(lo) | (f2bf(hi) << 16); }
__device__ __forceinline__ float bf2f(unsigned short b) { return __builtin_bit_cast(float, (unsigned)b << 16); }

#define XB_TMO      128
#define XB_XCNT(j)  (256  + 64 * (j))
#define XB_XSUB(j)  (1280 + 64 * (j))
#define XB_XGEN(j)  (2304 + 64 * (j))
#define XB_TOP      3328
#define XB_TOPGEN   3392
#define XCD_BAR_WORDS 3456
#define XB_SPIN_CAP (1u << 18)
__device__ __forceinline__ unsigned xb_ld(unsigned* p)              { return __hip_atomic_load(p, __ATOMIC_RELAXED, __HIP_MEMORY_SCOPE_AGENT); }
__device__ __forceinline__ unsigned xb_add(unsigned* p, unsigned v) { return __hip_atomic_fetch_add(p, v, __ATOMIC_RELAXED, __HIP_MEMORY_SCOPE_AGENT); }
__device__ __forceinline__ unsigned xb_xcc_id() { return (unsigned)__builtin_amdgcn_s_getreg((3 << 11) | 20) & 0xFu; }
#define XB_SPIN(cond, bar) do { unsigned _sp = 0; while (cond) { __builtin_amdgcn_s_sleep(1); \
    if ((++_sp & 255u) == 0u) { if (xb_ld(&(bar)[XB_TMO])) break; if (_sp > XB_SPIN_CAP) { atomicAdd(&(bar)[XB_TMO], 1u); break; } } } } while (0)
struct XcdBarrier { unsigned* bar; unsigned x; volatile LAS unsigned* st; };
__device__ __forceinline__ XcdBarrier xcd_barrier_post(unsigned* bar, volatile LAS unsigned* st) {
    XcdBarrier b; b.bar = bar; b.x = xb_xcc_id(); b.st = st;
    if (threadIdx.x == 0) (void)xb_add(&bar[XB_XCNT(b.x)], 1u);
    return b;
}
__device__ __forceinline__ void xcd_barrier_complete(unsigned* bar, unsigned x, unsigned& nloc, unsigned& nx) {
    const unsigned G = gridDim.x * gridDim.y * gridDim.z;
    unsigned sum, cnt, mine, sp = 0u;
    for (;;) {
        sum = 0u; cnt = 0u; mine = 0u;
#pragma unroll
        for (unsigned j = 0; j < 16; ++j) { const unsigned c = xb_ld(&bar[XB_XCNT(j)]); sum += c; cnt += (c > 0u) ? 1u : 0u; mine = (j == x) ? c : mine; }
        if (sum == G) break;
        __builtin_amdgcn_s_sleep(1);
        if ((++sp & 255u) == 0u) { if (xb_ld(&bar[XB_TMO])) break; if (sp > XB_SPIN_CAP) { atomicAdd(&bar[XB_TMO], 1u); break; } }
    }
    nloc = mine > 0u ? mine : 1u; nx = cnt > 0u ? cnt : 1u;
}
__device__ __forceinline__ void xcd_barrier(const XcdBarrier& b) {
    asm volatile("s_waitcnt vmcnt(0)" ::: "memory");
    __syncthreads();
    if (threadIdx.x == 0) {
        unsigned* bar = b.bar;
        __builtin_amdgcn_s_waitcnt(0);
        unsigned nloc = b.st[0], nx = b.st[1];
        if (nloc == 0u) { xcd_barrier_complete(bar, b.x, nloc, nx); b.st[0] = nloc; b.st[1] = nx; }
        const unsigned old = xb_add(&bar[XB_XSUB(b.x)], 1u);
        const unsigned gen = old / nloc;
        if (old + 1u == (gen + 1u) * nloc) {
            __builtin_amdgcn_fence(__ATOMIC_RELEASE, "agent");
            asm volatile("s_waitcnt vmcnt(0)" ::: "memory");
            const unsigned og = xb_add(&bar[XB_TOP], 1u);
            const unsigned tg = og / nx;
            if (og + 1u == (tg + 1u) * nx) xb_add(&bar[XB_TOPGEN], 1u);
            else XB_SPIN(xb_ld(&bar[XB_TOPGEN]) == tg, bar);
            __builtin_amdgcn_fence(__ATOMIC_ACQUIRE, "agent");
            xb_add(&bar[XB_XGEN(b.x)], 1u);
            asm volatile("s_waitcnt vmcnt(0)" ::: "memory");
        } else {
            XB_SPIN(xb_ld(&bar[XB_XGEN(b.x)]) == gen, bar);
            __builtin_amdgcn_fence(__ATOMIC_ACQUIRE, "agent");
            asm volatile("s_waitcnt vmcnt(0)" ::: "memory");
        }
    }
    __syncthreads();
}

struct Frame {
    LAS unsigned char* lds;
    volatile LAS unsigned* MISC;
    gu32* ctl;
    int vcu, G;
    unsigned char* ws;
};
__device__ __forceinline__ int opaque_tid() { int t = threadIdx.x; asm volatile("" : "+v"(t)); return t; }
__device__ __forceinline__ float wave_sum(float v) {
#pragma unroll
    for (int o = 1; o < 64; o <<= 1) v += __shfl_xor(v, o);
    return v;
}
__device__ __forceinline__ int wq_next(Frame& F, int word) {
    if (threadIdx.x == 0) F.MISC[0] = __hip_atomic_fetch_add((unsigned*)(F.ctl + word), 1u, __ATOMIC_RELAXED, __HIP_MEMORY_SCOPE_AGENT);
    __syncthreads(); const int v = (int)F.MISC[0]; __syncthreads(); return v;
}
struct Inputs {
    const float* x; const int* pos; const float* ffn_norm; const float* w_gate; const float* w_up; const float* w_down; const float* mix_norm;
    const float* hy_w_in; const float* q_norm; const float* w_uq; const float* kv_norm; const float* w_ukv; const float* w_a2; const float* b_a; const float* gla_norm; const float* hy_w_out;
    const float* nsa_w_in; const float* pos_k; const float* pos_v; const float* ck_w1; const float* ck_w2; const float* cv_w1; const float* cv_w2; const float* nsa_w_out; const float* final_norm;
};
struct ColSrc { const float* p; int ldn; };
__device__ __forceinline__ ColSrc map_gateup(const float* wg, const float* wu, int n) { const int T = n >> 8, j = n & 255; ColSrc c; c.ldn = FF; c.p = (j < 128) ? wg + T * 128 + j : wu + T * 128 + (j - 128); return c; }
__device__ __forceinline__ ColSrc map_ident(const float* w, int ldn, int n) { ColSrc c; c.ldn = ldn; c.p = w + n; return c; }
__device__ __forceinline__ ColSrc map_hyin(const float* w, int n) {
    ColSrc c; c.ldn = 1968; int s;
    if (n < 256) s = n; else if (n < 384) s = n; else if (n < 416) s = 384 + (n - 384); else if (n < 432) s = 1440 + (n - 416); else if (n < 512) s = -1;
    else if (n < 1024) s = 416 + (n - 512); else if (n < 1536) s = 928 + (n - 1024); else s = 1456 + (n - 1536);
    c.p = (s < 0) ? nullptr : w + s; return c; }
__device__ __forceinline__ ColSrc map_wuq(const float* w, int n) {
    ColSrc c; c.ldn = 768; int s;
    if (n < 512) s = (n >> 6) * 96 + (n & 63); else if (n < 640) { const int j = n - 512; s = (j >> 4) * 96 + 64 + (j & 15); } else { const int j = n - 640; s = (j >> 4) * 96 + 80 + (j & 15); }
    c.p = w + s; return c; }
__device__ __forceinline__ ColSrc map_nsain(const float* w, int n) {
    ColSrc c; c.ldn = 2608; const int T = n >> 8, j = n & 255; int s;
    if (T < 4) { const int hh = (j & 127) >> 5, i = j & 31; s = (4 * T + hh) * 64 + (j >> 7) * 32 + i; }
    else if (T == 6 || T == 8) { const int g = (j & 127) >> 5, i = j & 31; s = 1024 + (T - 4) * 256 + g * 64 + (j >> 7) * 32 + i; }
    else s = 1024 + (T - 4) * 256 + j;
    c.p = (s < 0) ? nullptr : w + s; return c; }
__device__ __forceinline__ ColSrc map_gates(const float* w, int n) { ColSrc c; c.ldn = 2608; c.p = (n < 48) ? w + 2560 + n : nullptr; return c; }
template <class Map> __device__ __forceinline__ void p0_item(const Map& mp, int K, bf16* WT, const float* gain, LAS float* scr, int kb, int nb, int lane) {
    const int k0 = 64 * kb, n0 = 64 * nb; const ColSrc cs = mp(n0 + lane);
    float v[64];
#pragma unroll
    for (int i = 0; i < 64; ++i) v[i] = cs.p ? cs.p[(size_t)(k0 + i) * cs.ldn] : 0.f;
#pragma unroll
    for (int i = 0; i < 64; ++i) scr[i * 65 + lane] = gain ? v[i] * gain[k0 + i] : v[i];
    LDS_WAIT(); asm volatile("" ::: "memory");
    const int c = lane & 7;
#pragma unroll
    for (int j = 0; j < 8; ++j) { const int n = (lane >> 3) + 8 * j; const LAS float* s = scr + (8 * c) * 65 + n;
        v4u o; o.x = pk2(s[0 * 65], s[1 * 65]); o.y = pk2(s[2 * 65], s[3 * 65]); o.z = pk2(s[4 * 65], s[5 * 65]); o.w = pk2(s[6 * 65], s[7 * 65]);
        *(GAS v4u*)(WT + (size_t)(n0 + n) * K + k0 + 8 * c) = o; }
    LDS_WAIT(); asm volatile("" ::: "memory");
}
__device__ __forceinline__ void sincos_d(double x, float& sn, float& cs) {
    const double k = rint(x * 0.63661977236758134308); double r = fma(-k, 1.57079632679489655800, x); r = fma(-k, 6.12323399573676603587e-17, r);
    const double r2 = r * r;
    double s = -7.6471637318198164759e-13; s = s * r2 + 1.6059043836821614599e-10; s = s * r2 - 2.5052108385441718775e-08; s = s * r2 + 2.7557319223985890653e-06; s = s * r2 - 1.9841269841269841270e-04; s = s * r2 + 8.3333333333333333333e-03; s = s * r2 - 1.6666666666666666667e-01; s = r + r * r2 * s;
    double c = 4.7794773323873852974e-14; c = c * r2 - 1.1470745597729724714e-11; c = c * r2 + 2.0876756987868098979e-09; c = c * r2 - 2.7557319223985890653e-07; c = c * r2 + 2.4801587301587301587e-05; c = c * r2 - 1.3888888888888888889e-03; c = c * r2 + 4.1666666666666666667e-02; c = c * r2 - 0.5; c = 1.0 + r2 * c;
    const int q = ((int)k) & 3; const double ss = (q == 0) ? s : (q == 1) ? c : (q == 2) ? -s : -c, cc = (q == 0) ? c : (q == 1) ? -s : (q == 2) ? -c : s;
    sn = (float)ss; cs = (float)cc;
}
struct RopeFreq { double f16[16]; double f32[32]; };
__device__ __forceinline__ void p0_prologue(Frame& F, const Inputs& I, const RopeFreq& RF) {
    const int tid = opaque_tid(), lane = tid & 63, wave = __builtin_amdgcn_readfirstlane(tid >> 6);
    LAS float* scr = (LAS float*)(F.lds + RING_OFF + wave * 16896);
    const int gw = F.vcu * NWAVES + wave, NGW = F.G * NWAVES;
    unsigned char* ws = F.ws;
    constexpr int I_GU = 16 * 88, I_DN = 44 * 16, I_IN0 = 16 * 32, I_UQ = 16 * 24, I_UKV = 8 * 32, I_OUT = 16 * 16, I_IN1 = 16 * 40, I_CW = 32 * 4, I_GT = 64, I_CW2 = 32;
    constexpr int NITEMS = 4 * I_GU + 4 * I_DN + I_IN0 + I_UQ + I_UKV + I_OUT + I_IN1 + I_OUT + 2 * I_CW + I_GT + I_CW2;
    for (int it = gw; it < NITEMS; it += NGW) {
        int r = it;
        if (r < 4 * I_GU) { const int f = r / I_GU; r -= f * I_GU; const float* wg = I.w_gate + (size_t)f * DM * FF; const float* wu = I.w_up + (size_t)f * DM * FF;
            auto mp = [&](int n) { return map_gateup(wg, wu, n); }; p0_item(mp, DM, (bf16*)(ws + WS_WGU) + (size_t)f * 5632 * DM, I.ffn_norm + f * DM, scr, r / 88, r % 88, lane); continue; } r -= 4 * I_GU;
        if (r < 4 * I_DN) { const int f = r / I_DN; r -= f * I_DN; const float* w = I.w_down + (size_t)f * FF * DM;
            auto mp = [&](int n) { return map_ident(w, DM, n); }; p0_item(mp, FF, (bf16*)(ws + WS_WD) + (size_t)f * DM * FF, nullptr, scr, r / 16, r % 16, lane); continue; } r -= 4 * I_DN;
        if (r < I_IN0) { auto mp = [&](int n) { return map_hyin(I.hy_w_in, n); }; p0_item(mp, DM, (bf16*)(ws + WS_WIN0), I.mix_norm, scr, r / 32, r % 32, lane); continue; } r -= I_IN0;
        if (r < I_UQ) { const int ks = r / 24, nblk = r % 24, r32 = lane & 31, hi = lane >> 5;
            const int col = (nblk < 16) ? ((32 * nblk + r32) >> 6) * 96 + ((32 * nblk + r32) & 63) : (2 * ((nblk - 16) & 3) + (r32 >> 4)) * 96 + (nblk < 20 ? 64 : 80) + (r32 & 15);
            float v[8];
#pragma unroll
            for (int j = 0; j < 8; ++j) { const int k = 16 * ks + 8 * hi + j; v[j] = I.w_uq[(size_t)k * 768 + col] * I.q_norm[k]; }
            v4u o; o.x = pk2(v[0], v[1]); o.y = pk2(v[2], v[3]); o.z = pk2(v[4], v[5]); o.w = pk2(v[6], v[7]); *(v4u*)((bf16*)(ws + WS_WUQ) + (size_t)r * 512 + lane * 8) = o; continue; } r -= I_UQ;
        if (r < I_UKV) { const int ks = r / 32, nblk = r % 32, r32 = lane & 31, hi = lane >> 5;
            float v[8];
#pragma unroll
            for (int j = 0; j < 8; ++j) { const int k = 16 * ks + 8 * hi + j; v[j] = I.w_ukv[(size_t)k * 1024 + 32 * nblk + r32] * I.kv_norm[k]; }
            v4u o; o.x = pk2(v[0], v[1]); o.y = pk2(v[2], v[3]); o.z = pk2(v[4], v[5]); o.w = pk2(v[6], v[7]); *(v4u*)((bf16*)(ws + WS_WUKV) + (size_t)r * 512 + lane * 8) = o; continue; } r -= I_UKV;
        if (r < I_OUT) { auto mp = [&](int n) { return map_ident(I.hy_w_out, DM, n); }; p0_item(mp, DM, (bf16*)(ws + WS_WOUT0), nullptr, scr, r / 16, r % 16, lane); continue; } r -= I_OUT;
        if (r < I_IN1) { auto mp = [&](int n) { return map_nsain(I.nsa_w_in, n); }; p0_item(mp, DM, (bf16*)(ws + WS_WIN1), I.mix_norm + DM, scr, r / 40, r % 40, lane); continue; } r -= I_IN1;
        if (r < I_OUT) { auto mp = [&](int n) { return map_ident(I.nsa_w_out, DM, n); }; p0_item(mp, DM, (bf16*)(ws + WS_WOUT1), nullptr, scr, r / 16, r % 16, lane); continue; } r -= I_OUT;
        if (r < 2 * I_CW) { const int kv = r / I_CW; r -= kv * I_CW; const float* w = kv ? I.cv_w1 : I.ck_w1;
            const int r32 = lane & 31, hi = lane >> 5; const float* wp = w + (size_t)(r * 16 + 8 * hi) * 128 + r32; bf16* dst = (bf16*)(ws + WS_CW1) + (size_t)kv * 262144 + (size_t)r * 2048 + lane * 8;
            float v[4][8];
#pragma unroll
            for (int q = 0; q < 4; ++q)
#pragma unroll
                for (int j = 0; j < 8; ++j) v[q][j] = wp[(size_t)j * 128 + 32 * q];
#pragma unroll
            for (int q = 0; q < 4; ++q) { v4u o; o.x = pk2(v[q][0], v[q][1]); o.y = pk2(v[q][2], v[q][3]); o.z = pk2(v[q][4], v[q][5]); o.w = pk2(v[q][6], v[q][7]); *(v4u*)(dst + q * 512) = o; }
            continue; } r -= 2 * I_CW;
        if (r >= I_GT) { r -= I_GT; const int kv = r >> 4, ks = (r >> 1) & 7, nblk = r & 1, r32 = lane & 31, hi = lane >> 5; const float* w2 = kv ? I.cv_w2 : I.ck_w2;
            float v[8];
#pragma unroll
            for (int j = 0; j < 8; ++j) v[j] = w2[(size_t)(16 * ks + 8 * hi + j) * 64 + 32 * nblk + r32];
            v4u o; o.x = pk2(v[0], v[1]); o.y = pk2(v[2], v[3]); o.z = pk2(v[4], v[5]); o.w = pk2(v[6], v[7]); *(v4u*)((bf16*)(ws + WS_CW2) + (size_t)r * 512 + lane * 8) = o; continue; }
        { const int r32 = lane & 31, hi = lane >> 5; const float* gm = I.mix_norm + DM;
            bf16* dst = (bf16*)(ws + WS_WGT) + (size_t)r * 1024 + lane * 8;
#pragma unroll
            for (int q = 0; q < 2; ++q) { float v[8]; const int n = 32 * q + r32;
#pragma unroll
                for (int j = 0; j < 8; ++j) { const int k = 16 * r + 8 * hi + j; v[j] = (n < 48) ? I.nsa_w_in[(size_t)k * 2608 + 2560 + n] * gm[k] : 0.f; }
                v4u o; o.x = pk2(v[0], v[1]); o.y = pk2(v[2], v[3]); o.z = pk2(v[4], v[5]); o.w = pk2(v[6], v[7]); *(v4u*)(dst + q * 512) = o; } }
    }
    bf16* hb = (bf16*)(ws + WS_HB); float* ssq = (float*)(ws + WS_SSQ);
    for (int m0 = 4 * gw; m0 < MROWS; m0 += 4 * NGW) {
        f32x4 v[4][4];
#pragma unroll
        for (int q = 0; q < 4; ++q) { const GAS f32x4* xr = (const GAS f32x4*)(I.x + (size_t)(m0 + q) * DM) + lane;
#pragma unroll
            for (int j = 0; j < 4; ++j) v[q][j] = xr[64 * j]; }
#pragma unroll
        for (int q = 0; q < 4; ++q) { float s = 0.f;
#pragma unroll
            for (int j = 0; j < 4; ++j) s += (v[q][j][0] * v[q][j][0] + v[q][j][1] * v[q][j][1]) + (v[q][j][2] * v[q][j][2] + v[q][j][3] * v[q][j][3]);
            s = wave_sum(s);
            GAS unsigned long long* o8 = (GAS unsigned long long*)(hb + (size_t)(m0 + q) * DM) + lane;
#pragma unroll
            for (int j = 0; j < 4; ++j) o8[64 * j] = (unsigned long long)pk2(v[q][j][0], v[q][j][1]) | ((unsigned long long)pk2(v[q][j][2], v[q][j][3]) << 32);
            if (lane < 16) ssq[(size_t)(m0 + q) * 16 + lane] = (lane == 0) ? s : 0.f; }
    }
    { const int gt = (F.vcu * NWAVES + wave) * 64 + lane, NGT = NGW * 64;
      f32x2* r0 = (f32x2*)(ws + WS_ROPE0); f32x2* r1 = (f32x2*)(ws + WS_ROPE1);
      for (int e = gt; e < MROWS * 48; e += NGT) { const int row = e / 48, j = e % 48; const double p = (double)I.pos[row];
          float sn, cs; if (j < 16) { sincos_d(p * RF.f16[j], sn, cs); r0[(size_t)row * 16 + j] = (f32x2){cs, sn}; } else { sincos_d(p * RF.f32[j - 16], sn, cs); r1[(size_t)row * 32 + (j - 16)] = (f32x2){cs, sn}; } } }
    for (int o = gw; o < 256; o += NGW) { const int kv = o >> 7, j = o & 127; const float* w = kv ? I.cv_w1 : I.ck_w1; const float* pe = kv ? I.pos_v : I.pos_k; float s = 0.f;
#pragma unroll
        for (int t = 0; t < 32; ++t) s += pe[lane + 64 * t] * w[(size_t)(lane + 64 * t) * 128 + j];
        s = wave_sum(s); if (lane == 0) ((float*)(ws + WS_BIAS1))[o] = s; }
}
constexpr int ML_NS = 5, ML_K = 0, ML_KSLOT = 12288, ML_V = ML_NS * ML_KSLOT, ML_VSLOT = 8192, ML_WS = ML_V + ML_NS * ML_VSLOT, ML_OST = ML_WS + 8 * 512, ML_END = ML_OST + 8 * 4096;
constexpr int NS_K = 0, NS_KSLOT = 8192, NS_V = 3 * NS_KSLOT, NS_VSLOT = 8192, NS_WS = NS_V + 4 * NS_VSLOT, NS_IMP = NS_WS + 8 * 512, NS_CK = NS_IMP + 16384, NS_CV = NS_CK + 32768, NS_END = NS_CV + 32768;
constexpr int AT_END = NS_END > ML_END ? NS_END : ML_END;
static_assert(AT_END <= RING_BYTES, "attention LDS map");
template <class RowPtr> __device__ __forceinline__ void store_o_tile(const f32x16& o0, const f32x16& o1, LAS unsigned char* stage, int lane, const RowPtr& rowptr) {
    const int r32 = lane & 31, hi = lane >> 5; LAS unsigned short* stg = (LAS unsigned short*)stage;
#pragma unroll
    for (int r = 0; r < 16; ++r) { const int orow = fa::crow(r, hi); stg[orow * 64 + r32] = (unsigned short)f2bf(o0[r]); stg[orow * 64 + 32 + r32] = (unsigned short)f2bf(o1[r]); }
    LDS_WAIT();
#pragma unroll
    for (int i = 0; i < 4; ++i) { const int row = i * 8 + (lane >> 3), ch = lane & 7; const v4u v = *(const LAS v4u*)(stg + row * 64 + ch * 8); *(v4u*)(rowptr(row) + ch * 8) = v; }
    LDS_WAIT();
}
__device__ __forceinline__ void mla_attn_unit(Frame& F, int b, int h, int qb, const bf16* QM, const bf16* KF, const bf16* VM, bf16* O0) {
    const int tid = opaque_tid(), lane = tid & 63, r32 = lane & 31, hi = lane >> 5, wid = __builtin_amdgcn_readfirstlane(tid >> 6);
    const size_t rowbase = (size_t)b * SEQ; const int q0 = qb * 256, NT = (q0 + 256) / 64;
    const fa::lds_cptr L = (fa::lds_cptr)(F.lds + RING_OFF); const unsigned l0 = fa::lds_addr(L);
    LAS float* wsf = (LAS float*)(F.lds + RING_OFF + ML_WS) + wid * 128;
    const bf16* Qw = QM + (rowbase + q0 + wid * 32 + r32) * 768 + h * 96;
    fa::bf16x8 qr[6];
#pragma unroll
    for (int d0 = 0; d0 < 6; ++d0) qr[d0] = *(const fa::bf16x8*)(Qw + d0 * 16 + hi * 8);
    __builtin_amdgcn_s_waitcnt(0x0F70);
    const bf16* Kh = KF + (size_t)(b * 8 + h) * SEQ * 96; const bf16* Vh = VM + (size_t)(b * 8 + h) * SEQ * 64;
    const int qpos = q0 + wid * 32 + r32, wq_lo = q0 + wid * 32, my_last = (wq_lo + 31) >> 6;
    const bool g1 = wid >= 4;
    fa::Run R; fa::run_init(R);
    auto dma_tile = [&](int t, int slot) { fa::dma_k<96>(Kh + (size_t)t * 64 * 96, 96, l0 + ML_K + slot * ML_KSLOT, wid, lane); fa::dma_v(Vh + (size_t)t * 64 * 64, 64, l0 + ML_V + slot * ML_VSLOT, wid, lane); };
    dma_tile(0, 0); dma_tile(1, 1); dma_tile(2, 2);
    if (g1) FA_WAIT_BAR(6);
    FA_WAIT_BAR(6);
    fa::u32x4 pw[4] = {}; fa::f32x16 p0 = fa::f32x16{}, p1 = fa::f32x16{};
    int sc = 0, sp = 0, sn = 3;
    for (int t = 0; t < NT; ++t) {
        if (t + 3 < NT) dma_tile(t + 3, sn);
        __builtin_amdgcn_s_setprio(1);
        if (t > 0 && t - 1 <= my_last) fa::pv_pw(R.o0, R.o1, pw, L + ML_V + sp * ML_VSLOT, lane, hi);
        if (t <= my_last) fa::qkt<96>(p0, p1, L + ML_K + sc * ML_KSLOT, qr, R.negm, r32, hi);
        __builtin_amdgcn_s_setprio(0);
        if (t + 3 < NT) FA_WAIT_BAR(6); else if (t + 2 < NT) FA_WAIT_BAR(3); else FA_WAIT_BAR(0);
        __builtin_amdgcn_sched_barrier(0);
        if (t <= my_last) {
            if (t * 64 + 63 > wq_lo) { asm volatile("; causal band (a real branch)"); fa::mask_range(p0, p1, t * 64, 0, qpos, hi); }
            fa::softmax_step(R, p0, p1, wsf, r32, hi);
            fa::pack_p(pw, p0, p1); }
        asm volatile("s_waitcnt lgkmcnt(0)\n\ts_barrier" ::: "memory");
        __builtin_amdgcn_sched_barrier(0);
        sp = sc; sc = (sc == ML_NS - 1) ? 0 : sc + 1; sn = (sn == ML_NS - 1) ? 0 : sn + 1;
    }
    if (NT - 1 <= my_last) fa::pv_pw(R.o0, R.o1, pw, L + ML_V + sp * ML_VSLOT, lane, hi);
    if (!g1) asm volatile("s_waitcnt lgkmcnt(0)\n\ts_barrier" ::: "memory");
    float rli[16]; fa::run_finish(R, rli, wsf, r32, hi);
#pragma unroll
    for (int r = 0; r < 16; ++r) { R.o0[r] *= rli[r]; R.o1[r] *= rli[r]; }
    bf16* Ow = O0 + (rowbase + q0 + wid * 32) * 1024 + h * 64;
    store_o_tile(R.o0, R.o1, F.lds + RING_OFF + ML_OST + wid * 4096, lane, [&](int rr) { return Ow + (size_t)rr * 1024; });
    FA_WAIT_BAR(0);
}
constexpr int UP_AQ = 0, UP_AKV = 65536, UP_RS = UP_AKV + 32768, UP_STG = UP_RS + 1024, UP_END = UP_STG + 8 * 4096;
static_assert(UP_END <= RING_BYTES, "up-projection LDS map");
__device__ __forceinline__ void mla_up_unit(Frame& F, int hm, const bf16* U0, const bf16* WUQF, const bf16* WUKVF, const float* ssqq, const float* ssqkv, const float* rope, float c2, bf16* QM, bf16* KF, bf16* VM) {
    const int tid = opaque_tid(), lane = tid & 63, r32 = lane & 31, hi = lane >> 5, wid = __builtin_amdgcn_readfirstlane(tid >> 6);
    const int rb = wid & 3, hf = wid >> 2, row0 = hm * 128, rot = (int)(blockIdx.x >> 3);
    const fa::lds_cptr L = (fa::lds_cptr)(F.lds + RING_OFF); const unsigned l0 = fa::lds_addr(L);
    LAS float* rsl = (LAS float*)(F.lds + RING_OFF + UP_RS); LAS unsigned short* stg = (LAS unsigned short*)(F.lds + RING_OFF + UP_STG + wid * 4096);
    if (tid < 256) { const int row = tid & 127; const f32x4 p = *(const f32x4*)((tid < 128 ? ssqq : ssqkv) + (size_t)(row0 + row) * 4); const float sm = (p[0] + p[1]) + (p[2] + p[3]);
        rsl[tid] = (tid < 128) ? __builtin_amdgcn_rsqf(sm * (1.0f / 256.0f) + pg8::NORM_EPS) * c2 : __builtin_amdgcn_rsqf(sm * (1.0f / 128.0f) + pg8::NORM_EPS); }
    __builtin_amdgcn_s_waitcnt(0x0F70);
#pragma unroll
    for (int q = 0; q < 8; ++q) { const int i = 8 * wid + q, p = 64 * i + lane, row = p >> 5, slot = p & 31, ch = slot ^ (row & 7);
        fa::glds16(U0 + (size_t)(row0 + row) * 2048 + ch * 8, (unsigned)__builtin_amdgcn_readfirstlane(l0 + UP_AQ + i * 1024)); }
#pragma unroll
    for (int q = 0; q < 4; ++q) { const int i = 4 * wid + q, p = 64 * i + lane, row = p >> 4, slot = p & 15, ch = slot ^ (row & 7);
        fa::glds16(U0 + (size_t)(row0 + row) * 2048 + 256 + ch * 8, (unsigned)__builtin_amdgcn_readfirstlane(l0 + UP_AKV + i * 1024)); }
    FA_WAIT_BAR(0);
    const int arow = 32 * rb + r32;
    auto put32 = [&](const fa::f32x16& v, int ncols, int coff) {
#pragma unroll
        for (int r = 0; r < 16; ++r) stg[fa::crow(r, hi) * ncols + coff] = (unsigned short)f2bf(v[r]); };
    { fa::bf16x8 af[16];
#pragma unroll
      for (int ks = 0; ks < 16; ++ks) af[ks] = *(const FA_LAS fa::bf16x8*)(L + UP_AQ + arow * 512 + (((2 * ks + hi) ^ (arow & 7)) * 16));
      float rsq[16];
#pragma unroll
      for (int r = 0; r < 16; ++r) rsq[r] = rsl[32 * rb + fa::crow(r, hi)];
      const bf16* wf = WUQF + lane * 8;
      const int nplain = hf ? 4 : 12;
      for (int t = 0; t < nplain; ++t) { const int tr = (t + rot) % nplain, nblk = hf ? 12 + tr : tr; fa::f32x16 acc = fa::f32x16{};
#pragma unroll
          for (int ks = 0; ks < 16; ++ks) acc = FA_MFMA(af[ks], *(const fa::bf16x8*)(wf + (size_t)(ks * 24 + nblk) * 512), acc);
#pragma unroll
          for (int r = 0; r < 16; ++r) acc[r] *= rsq[r];
          put32(acc, 32, r32); LDS_WAIT();
          bf16* dstb = QM + (size_t)(row0 + 32 * rb) * 768 + (nblk >> 1) * 96 + 32 * (nblk & 1);
#pragma unroll
          for (int it = 0; it < 2; ++it) { const int idx = it * 64 + lane, row = idx >> 2, ch = idx & 3; *(v4u*)(dstb + (size_t)row * 768 + ch * 8) = *(const LAS v4u*)(stg + row * 32 + ch * 8); }
          LDS_WAIT(); }
      if (hf) for (int jj = 0; jj < 4; ++jj) { const int j = (jj + rot) & 3; fa::f32x16 a1 = fa::f32x16{}, a2 = fa::f32x16{};
#pragma unroll
          for (int ks = 0; ks < 16; ++ks) { a1 = FA_MFMA(af[ks], *(const fa::bf16x8*)(wf + (size_t)(ks * 24 + 16 + j) * 512), a1); a2 = FA_MFMA(af[ks], *(const fa::bf16x8*)(wf + (size_t)(ks * 24 + 20 + j) * 512), a2); }
          fa::f32x16 y1, y2;
#pragma unroll
          for (int r = 0; r < 16; ++r) { const f32x2 cs = *(const f32x2*)(rope + ((size_t)(row0 + 32 * rb + fa::crow(r, hi)) * 16 + (r32 & 15)) * 2); const float x1 = a1[r] * rsq[r], x2 = a2[r] * rsq[r];
              y1[r] = x1 * cs[0] - x2 * cs[1]; y2[r] = x2 * cs[0] + x1 * cs[1]; }
          const int co = (r32 >> 4) * 32 + (r32 & 15);
          put32(y1, 64, co); put32(y2, 64, co + 16); LDS_WAIT();
          bf16* dstb = QM + (size_t)(row0 + 32 * rb) * 768 + (2 * j) * 96 + 64;
#pragma unroll
          for (int it = 0; it < 4; ++it) { const int idx = it * 64 + lane, row = idx >> 3, ch = idx & 7; *(v4u*)(dstb + (size_t)row * 768 + (ch >> 2) * 96 + (ch & 3) * 8) = *(const LAS v4u*)(stg + row * 64 + ch * 8); }
          LDS_WAIT(); } }
    { fa::bf16x8 af[8];
#pragma unroll
      for (int ks = 0; ks < 8; ++ks) af[ks] = *(const FA_LAS fa::bf16x8*)(L + UP_AKV + arow * 256 + (((2 * ks + hi) ^ (arow & 7)) * 16));
      float rsk[16];
#pragma unroll
      for (int r = 0; r < 16; ++r) rsk[r] = rsl[128 + 32 * rb + fa::crow(r, hi)];
      const bf16* wf = WUKVF + lane * 8;
      for (int t = 0; t < 16; ++t) { const int nblk = 16 * hf + ((t + rot) & 15); fa::f32x16 acc = fa::f32x16{};
#pragma unroll
          for (int ks = 0; ks < 8; ++ks) acc = FA_MFMA(af[ks], *(const fa::bf16x8*)(wf + (size_t)(ks * 32 + nblk) * 512), acc);
#pragma unroll
          for (int r = 0; r < 16; ++r) acc[r] *= rsk[r];
          put32(acc, 32, r32); LDS_WAIT();
          const int head = nblk >> 2, part = nblk & 3;
          const int bb = row0 >> 12, s0 = (row0 & (SEQ - 1)) + 32 * rb;
          bf16* dstb = (part < 2) ? KF + ((size_t)(bb * 8 + head) * SEQ + s0) * 96 + 32 * part : VM + ((size_t)(bb * 8 + head) * SEQ + s0) * 64 + 32 * (part - 2);
          const int pitch = (part < 2) ? 96 : 64;
#pragma unroll
          for (int it = 0; it < 2; ++it) { const int idx = it * 64 + lane, row = idx >> 2, ch = idx & 3; *(v4u*)(dstb + (size_t)row * pitch + ch * 8) = *(const LAS v4u*)(stg + row * 32 + ch * 8); }
          LDS_WAIT(); } }
    asm volatile("s_waitcnt lgkmcnt(0)\n\ts_barrier" ::: "memory");
}
__device__ __forceinline__ void krot_pass(Frame& F, const float* KR, const float* rope, bf16* KF) {
    const int tid = opaque_tid(); const int gt = (F.vcu * NWAVES + __builtin_amdgcn_readfirstlane(tid >> 6)) * 64 + (tid & 63), NGT = F.G * NWAVES * 64;
    for (int e = gt; e < MROWS * 8; e += NGT) { const int row = e >> 3, h = e & 7; const f32x4* kr = (const f32x4*)(KR + (size_t)row * 32); const f32x4* cs = (const f32x4*)(rope + (size_t)row * 32);
        float x[32], c[16], s[16];
#pragma unroll
        for (int i = 0; i < 8; ++i) { const f32x4 v = kr[i]; x[4 * i] = v[0]; x[4 * i + 1] = v[1]; x[4 * i + 2] = v[2]; x[4 * i + 3] = v[3]; const f32x4 t = cs[i]; c[2 * i] = t[0]; s[2 * i] = t[1]; c[2 * i + 1] = t[2]; s[2 * i + 1] = t[3]; }
        v4u o[4];
#pragma unroll
        for (int i = 0; i < 16; i += 2) { const float y0 = x[i] * c[i] - x[16 + i] * s[i], y1 = x[i + 1] * c[i + 1] - x[17 + i] * s[i + 1]; o[i >> 3][(i >> 1) & 3] = pk2(y0, y1); }
#pragma unroll
        for (int i = 0; i < 16; i += 2) { const float y0 = x[16 + i] * c[i] + x[i] * s[i], y1 = x[17 + i] * c[i + 1] + x[i + 1] * s[i + 1]; o[2 + (i >> 3)][(i >> 1) & 3] = pk2(y0, y1); }
        v4u* dst = (v4u*)(KF + ((size_t)((row >> 12) * 8 + h) * SEQ + (row & (SEQ - 1))) * 96 + 64);
#pragma unroll
        for (int i = 0; i < 4; ++i) dst[i] = o[i]; }
}
__device__ __forceinline__ void gla_pre(Frame& F, const bf16* U0, const float* GA, const float* w_a2, const float* b_a, bf16* KD, bf16* QA, bf16* QI, float* DEC) {
    const int tid = opaque_tid(); const int gw = F.vcu * NWAVES + __builtin_amdgcn_readfirstlane(tid >> 6), NGW = F.G * NWAVES, lane = tid & 63;
    for (int u = gw; u < BATCH * 64 * 4; u += NGW) { const int h = u & 3, bn = u >> 2; const size_t tok = (size_t)bn * 64 + lane;
        float wv[16];
#pragma unroll
        for (int j = 0; j < 16; ++j) wv[j] = w_a2[j * 256 + h * 64 + lane];
        const float bav = b_a[h * 64 + lane];
        float ha[16];
#pragma unroll
        for (int i = 0; i < 4; ++i) { const f32x4 v = *(const f32x4*)(GA + tok * 16 + 4 * i); ha[4 * i] = v[0]; ha[4 * i + 1] = v[1]; ha[4 * i + 2] = v[2]; ha[4 * i + 3] = v[3]; }
        const bf16* qp = U0 + tok * 2048 + 512 + h * 64; const bf16* kp = U0 + tok * 2048 + 768 + h * 64;
        for (int dg = 0; dg < 8; ++dg) { const v4u q8 = *(const v4u*)(qp + dg * 8), k8 = *(const v4u*)(kp + dg * 8); float okd[8], oqa[8], oqi[8];
#pragma unroll
            for (int e = 0; e < 8; ++e) { const int dl_ = dg * 8 + e, d = h * 64 + dl_; float g = __builtin_bit_cast(float, __builtin_amdgcn_readlane(__builtin_bit_cast(int, bav), dl_));
#pragma unroll
                for (int j = 0; j < 16; ++j) g += ha[j] * __builtin_bit_cast(float, __builtin_amdgcn_readlane(__builtin_bit_cast(int, wv[j]), dl_));
                const float la = (__builtin_fminf(g, 0.f) - __logf(1.0f + __expf(-__builtin_fabsf(g)))) * (1.0f / 16.0f);
                float bc = la;
#pragma unroll
                for (int off = 1; off < 64; off <<= 1) { const float t = __shfl_up(bc, off); if (lane >= off) bc += t; }
                const float bl = __shfl(bc, 63);
                const unsigned qw = q8[e >> 1], kw = k8[e >> 1]; const float qv = bf2f((unsigned short)((e & 1) ? (qw >> 16) : (qw & 0xffffu))) * 0.125f, kv = bf2f((unsigned short)((e & 1) ? (kw >> 16) : (kw & 0xffffu)));
                okd[e] = kv * __expf(bl - bc); oqa[e] = qv * __expf(bc - bl); oqi[e] = qv * __expf(bc);
                if (lane == 0) DEC[(size_t)bn * 256 + d] = __expf(bl); }
            v4u w; w.x = pk2(okd[0], okd[1]); w.y = pk2(okd[2], okd[3]); w.z = pk2(okd[4], okd[5]); w.w = pk2(okd[6], okd[7]); *(v4u*)(KD + tok * 256 + h * 64 + dg * 8) = w;
            w.x = pk2(oqa[0], oqa[1]); w.y = pk2(oqa[2], oqa[3]); w.z = pk2(oqa[4], oqa[5]); w.w = pk2(oqa[6], oqa[7]); *(v4u*)(QA + tok * 256 + h * 64 + dg * 8) = w;
            w.x = pk2(oqi[0], oqi[1]); w.y = pk2(oqi[2], oqi[3]); w.z = pk2(oqi[4], oqi[5]); w.w = pk2(oqi[6], oqi[7]); *(v4u*)(QI + tok * 256 + h * 64 + dg * 8) = w; } }
}
constexpr int GL_SET = 49152, GL_KDK = 0, GL_KDV = 8192, GL_QA = 16384, GL_QI = 24576, GL_VV = 32768, GL_S = 2 * GL_SET, GL_OB = GL_S + 16384, GL_OBP = 132, GL_END = GL_OB + 64 * GL_OBP * 4;
static_assert(GL_END <= RING_BYTES, "GLA LDS map");
__device__ __forceinline__ void gla_unit(Frame& F, int b, int h, const bf16* U0, const bf16* KD, const bf16* QA, const bf16* QI, const float* DEC, const float* gnorm, bf16* O0) {
    const int tid = opaque_tid(), lane = tid & 63, r32 = lane & 31, hi = lane >> 5, wid = __builtin_amdgcn_readfirstlane(tid >> 6);
    const int ib = wid & 1, vb = wid >> 1;
    const fa::lds_cptr L = (fa::lds_cptr)(F.lds + RING_OFF); const unsigned l0 = fa::lds_addr(L);
    const size_t tokb = (size_t)b * SEQ;
    const int trn = ((lane >> 4) & 1) * 32 + (lane & 3) * 8 + (8 * hi + ((lane & 15) >> 2)) * 64;
    const int trp = ((lane >> 4) & 1) * 32 + (lane & 3) * 8 + (4 * hi + ((lane & 15) >> 2)) * 64;
    auto dma_chunk = [&](int n, int s) { const size_t t0 = tokb + (size_t)n * 64; const unsigned base = l0 + s * GL_SET;
        fa::glds16(KD + (t0 + lane) * 256 + h * 64 + wid * 8, (unsigned)__builtin_amdgcn_readfirstlane(base + GL_KDK + wid * 1024));
        fa::glds16(QA + (t0 + lane) * 256 + h * 64 + wid * 8, (unsigned)__builtin_amdgcn_readfirstlane(base + GL_QA + wid * 1024));
        fa::glds16(QI + (t0 + lane) * 256 + h * 64 + wid * 8, (unsigned)__builtin_amdgcn_readfirstlane(base + GL_QI + wid * 1024));
        fa::glds16(KD + (t0 + 16 * (wid & 3) + (lane >> 2)) * 256 + h * 64 + (wid >> 2) * 32 + (lane & 3) * 8, (unsigned)__builtin_amdgcn_readfirstlane(base + GL_KDV + wid * 1024));
#pragma unroll
        for (int k = 0; k < 2; ++k) { const int p = wid + 8 * k; fa::glds16(U0 + (t0 + 16 * (p & 3) + (lane >> 2)) * 2048 + 1024 + h * 128 + (p >> 2) * 32 + (lane & 3) * 8, (unsigned)__builtin_amdgcn_readfirstlane(base + GL_VV + p * 1024)); } };
    fa::f32x16 st = fa::f32x16{};
    const int fi = tid >> 3, fs = tid & 7; float gn[16];
#pragma unroll
    for (int e = 0; e < 16; ++e) gn[e] = gnorm[fs * 16 + e];
    float dec[16]; v4u rr0, rr1;
    auto load_side = [&](int n) { const float* dp = DEC + ((size_t)b * 64 + n) * 256 + h * 64 + 32 * ib;
#pragma unroll
        for (int r = 0; r < 16; ++r) dec[r] = dp[fa::crow(r, hi)];
        const v4u* rp = (const v4u*)(U0 + (tokb + (size_t)n * 64 + fi) * 2048 + 1536 + h * 128 + fs * 16); rr0 = rp[0]; rr1 = rp[1]; };
    dma_chunk(0, 0); load_side(0);
    for (int n = 0; n < 64; ++n) { const int s = n & 1; const fa::lds_cptr IM = L + s * GL_SET;
        { LAS unsigned short* sp = (LAS unsigned short*)(F.lds + RING_OFF + GL_S) + vb * 2048 + r32;
#pragma unroll
          for (int r = 0; r < 16; ++r) sp[(32 * ib + fa::crow(r, hi)) * 32] = (unsigned short)f2bf(st[r]); }
        float decc[16]; v4u rc0 = rr0, rc1 = rr1;
#pragma unroll
        for (int r = 0; r < 16; ++r) decc[r] = dec[r];
        FA_WAIT_BAR(2);
        if (n + 1 < 64) { dma_chunk(n + 1, s ^ 1); load_side(n + 1); }
        fa::f32x16 p0 = fa::f32x16{}, p1 = fa::f32x16{};
        { const fa::lds_cptr kb = IM + GL_KDK + hi * 1024 + r32 * 16; const fa::lds_cptr qb_ = IM + GL_QA + hi * 1024 + (32 * ib + r32) * 16;
#pragma unroll
          for (int d0 = 0; d0 < 4; ++d0) { const fa::bf16x8 a0 = *(const FA_LAS fa::bf16x8*)(kb + d0 * 2048), a1 = *(const FA_LAS fa::bf16x8*)(kb + d0 * 2048 + 512), q = *(const FA_LAS fa::bf16x8*)(qb_ + d0 * 2048);
              p0 = FA_MFMA(a0, q, p0); p1 = FA_MFMA(a1, q, p1); } }
        { const int i = 32 * ib + r32;
#pragma unroll
          for (int r = 0; r < 16; ++r) { const int j0 = fa::crow(r, hi); if (j0 > i) p0[r] = 0.f; if (j0 + 32 > i) p1[r] = 0.f; } }
        fa::f32x16 o = fa::f32x16{};
        { fa::u32x4 pw[4];
          pw[0] = (fa::u32x4){fa::cvtpk(p0[0], p0[1]), fa::cvtpk(p0[2], p0[3]), fa::cvtpk(p0[4], p0[5]), fa::cvtpk(p0[6], p0[7])};
          pw[1] = (fa::u32x4){fa::cvtpk(p0[8], p0[9]), fa::cvtpk(p0[10], p0[11]), fa::cvtpk(p0[12], p0[13]), fa::cvtpk(p0[14], p0[15])};
          pw[2] = (fa::u32x4){fa::cvtpk(p1[0], p1[1]), fa::cvtpk(p1[2], p1[3]), fa::cvtpk(p1[4], p1[5]), fa::cvtpk(p1[6], p1[7])};
          pw[3] = (fa::u32x4){fa::cvtpk(p1[8], p1[9]), fa::cvtpk(p1[10], p1[11]), fa::cvtpk(p1[12], p1[13]), fa::cvtpk(p1[14], p1[15])};
          const fa::lds_cptr vp = IM + GL_VV + vb * 4096 + trp;
#pragma unroll
          for (int ks = 0; ks < 4; ++ks) { const fa::s16x4 lo = fa::vtr(vp + ks * 1024), hh = fa::vtr(vp + ks * 1024 + 512);
              o = FA_MFMA(__builtin_bit_cast(fa::bf16x8, pw[ks]), ((fa::bf16x8){lo[0], lo[1], lo[2], lo[3], hh[0], hh[1], hh[2], hh[3]}), o); } }
        { const fa::lds_cptr qi = IM + GL_QI + hi * 1024 + (32 * ib + r32) * 16; const fa::lds_cptr sp = L + GL_S + vb * 4096 + trn;
#pragma unroll
          for (int d0 = 0; d0 < 4; ++d0) { const fa::bf16x8 a = *(const FA_LAS fa::bf16x8*)(qi + d0 * 2048); const fa::s16x4 lo = fa::vtr(sp + d0 * 1024), hh = fa::vtr(sp + d0 * 1024 + 256);
              o = FA_MFMA(a, ((fa::bf16x8){lo[0], lo[1], lo[2], lo[3], hh[0], hh[1], hh[2], hh[3]}), o); } }
        { LAS float* ob = (LAS float*)(F.lds + RING_OFF + GL_OB) + 32 * vb + r32;
#pragma unroll
          for (int r = 0; r < 16; ++r) ob[(32 * ib + fa::crow(r, hi)) * GL_OBP] = o[r]; }
#pragma unroll
        for (int r = 0; r < 16; ++r) st[r] *= decc[r];
        { const fa::lds_cptr ap = IM + GL_KDV + ib * 4096 + trn; const fa::lds_cptr bp = IM + GL_VV + vb * 4096 + trn;
#pragma unroll
          for (int ks = 0; ks < 4; ++ks) { const fa::s16x4 al = fa::vtr(ap + ks * 1024), ah = fa::vtr(ap + ks * 1024 + 256), bl = fa::vtr(bp + ks * 1024), bh = fa::vtr(bp + ks * 1024 + 256);
              st = FA_MFMA(((fa::bf16x8){al[0], al[1], al[2], al[3], ah[0], ah[1], ah[2], ah[3]}), ((fa::bf16x8){bl[0], bl[1], bl[2], bl[3], bh[0], bh[1], bh[2], bh[3]}), st); } }
        asm volatile("s_waitcnt lgkmcnt(0)\n\ts_barrier" ::: "memory");
        { const LAS f32x4* op = (const LAS f32x4*)((LAS float*)(F.lds + RING_OFF + GL_OB) + fi * GL_OBP + fs * 16); float x[16]; float ss = 0.f;
#pragma unroll
          for (int q = 0; q < 4; ++q) { const f32x4 v = op[q]; x[4 * q] = v[0]; x[4 * q + 1] = v[1]; x[4 * q + 2] = v[2]; x[4 * q + 3] = v[3]; ss += (v[0] * v[0] + v[1] * v[1]) + (v[2] * v[2] + v[3] * v[3]); }
          ss += __shfl_xor(ss, 1); ss += __shfl_xor(ss, 2); ss += __shfl_xor(ss, 4);
          const float rstd = 1.0f / sqrtf(ss * (1.0f / 128.0f) + pg8::NORM_EPS); float y[16];
#pragma unroll
          for (int e = 0; e < 16; ++e) { const unsigned w = (e < 8) ? rc0[e >> 1] : rc1[(e - 8) >> 1]; const float rv = bf2f((unsigned short)((e & 1) ? (w >> 16) : (w & 0xffffu))); y[e] = x[e] * rstd * gn[e] * pg8::silu_f(rv); }
          v4u w0, w1; w0.x = pk2(y[0], y[1]); w0.y = pk2(y[2], y[3]); w0.z = pk2(y[4], y[5]); w0.w = pk2(y[6], y[7]); w1.x = pk2(y[8], y[9]); w1.y = pk2(y[10], y[11]); w1.z = pk2(y[12], y[13]); w1.w = pk2(y[14], y[15]);
          v4u* dst = (v4u*)(O0 + (tokb + (size_t)n * 64 + fi) * 1024 + 512 + h * 128 + fs * 16); dst[0] = w0; dst[1] = w1; }
    }
    FA_WAIT_BAR(0);
}
namespace np {
using fa::bf16x8; using fa::s16x4; using fa::f32x16; using fa::u32x4; using fa::lds_cptr; using fa::crow;
#define NP_SBAR() __builtin_amdgcn_sched_barrier(0)
#define NP_WAIT_BAR(N) asm volatile("s_waitcnt vmcnt(" #N ") lgkmcnt(0)\n\ts_barrier" ::: "memory")
#define NP_PIN(x) asm volatile("" : "+v"(x))
#define NP_MX3(a, b, c) __builtin_fmaxf(__builtin_fmaxf((a), (b)), (c))
#define NP_MFMA(a, b, c) __builtin_amdgcn_mfma_f32_32x32x16_bf16(a, b, c, 0, 0, 0)
__device__ __forceinline__ void kload8(bf16x8* kf, lds_cptr kp) {
    kf[0] = *(const FA_LAS bf16x8*)(kp);        kf[1] = *(const FA_LAS bf16x8*)(kp + 512);  kf[2] = *(const FA_LAS bf16x8*)(kp + 2048); kf[3] = *(const FA_LAS bf16x8*)(kp + 2560);
    kf[4] = *(const FA_LAS bf16x8*)(kp + 4096); kf[5] = *(const FA_LAS bf16x8*)(kp + 4608); kf[6] = *(const FA_LAS bf16x8*)(kp + 6144); kf[7] = *(const FA_LAS bf16x8*)(kp + 6656);
}
__device__ __forceinline__ void kload2(bf16x8* kf, lds_cptr kp, int j) { kf[2 * j] = *(const FA_LAS bf16x8*)(kp + j * 2048); kf[2 * j + 1] = *(const FA_LAS bf16x8*)(kp + j * 2048 + 512); }
}
struct NsaTiles {
    const bf16* kSp; const bf16* vSp; unsigned kdst, vdst; int NS, wlo, NTOT, NT, cur; size_t KVB;
    __device__ __forceinline__ void init(const bf16* KV6, int b, int g, int cur_, unsigned lds0, int lane, int wid) {
        cur = cur_; NS = cur + 1; wlo = cur >= 8 ? cur - 8 : 0; NTOT = NS + (cur - wlo + 1); NT = (NTOT + 1) & ~1; if (NT < 4) NT = 4; KVB = (size_t)MROWS * 256;
        kSp = KV6 + 2 * KVB + (size_t)b * SEQ * 256 + g * 64 + (size_t)lane * 256 + wid * 8;
        vSp = KV6 + 3 * KVB + (size_t)b * SEQ * 256 + g * 64 + (size_t)(16 * (wid & 3) + (lane >> 2)) * 256 + (wid >> 2) * 32 + (lane & 3) * 8;
        kdst = lds0 + NS_K + wid * 1024; vdst = lds0 + NS_V + wid * 1024; }
    __device__ __forceinline__ size_t toff(int t) const { return (size_t)((t < NS) ? t : ((t < NTOT) ? wlo + (t - NS) : cur)) * (64 * 256) + ((t < NS) ? (size_t)0 : 2 * KVB); }
    __device__ __forceinline__ void dma_k(int t, int slot) const { fa::glds16(kSp + toff(t), (unsigned)__builtin_amdgcn_readfirstlane(kdst + slot)); }
    __device__ __forceinline__ void dma_v(int t, int slot) const { fa::glds16(vSp + toff(t), (unsigned)__builtin_amdgcn_readfirstlane(vdst + slot)); }
    __device__ __forceinline__ void prologue() const { dma_k(0, 0); dma_v(0, 0); dma_k(1, 8192); dma_k(2, 16384); dma_v(1, 8192); }
};
__device__ __forceinline__ void nsa_stream_pipe(Frame& F, const fa::bf16x8 (&qr)[4], const NsaTiles& TL, int tq, unsigned long long selmask,
                                                fa::f32x16& oc0, fa::f32x16& oc1, bf16* Ow, int lane, int wid) {
    using namespace np;
    const int r32 = lane & 31, hi = lane >> 5;
    const fa::lds_cptr L = (fa::lds_cptr)(F.lds + RING_OFF); const unsigned lds0 = fa::lds_addr(L);
    LAS float* wsf = (LAS float*)(F.lds + RING_OFF + NS_WS) + wid * 128;
    LAS float* OF = (LAS float*)(F.lds + RING_OFF + NS_CK + wid * 8192) + lane;
    constexpr int SLOTB = 8192;
    const int NS = TL.NS, wlo = TL.wlo, NTOT = TL.NTOT, NT = TL.NT, cur = TL.cur;
#define NP_DMA_K(t, slot) TL.dma_k((t), (slot))
#define NP_DMA_V(t, slot) TL.dma_v((t), (slot))
    const lds_cptr kp0 = L + NS_K + hi * 1024 + r32 * 16; const lds_cptr vp0 = L + NS_V + ((lane >> 4) & 1) * 32 + (lane & 3) * 8 + (4 * hi + ((lane & 15) >> 2)) * 64;
    bf16x8 kf[8];
    float mhat = 0.f, l_reg = 0.f; f32x16 o[2]; o[0] = f32x16{}; o[1] = f32x16{}; f32x16 negm = f32x16{}; NP_PIN(negm);
    bool resc = false;
#define NP_MASK(C0, C1, t) do { const int t_ = (t); const bool sel_ = t_ < NS; const int j_ = sel_ ? t_ : wlo + (t_ - NS); \
        const bool rowok_ = sel_ ? (((selmask >> j_) & 1ull) != 0ull) : (t_ < NTOT); \
        if (!__all(rowok_)) { asm volatile("; row mask (a real branch: the asm keeps hipcc from if-converting it into every step)"); _Pragma("unroll") for (int r = 0; r < 16; ++r) { C0[r] = rowok_ ? C0[r] : -INFINITY; C1[r] = rowok_ ? C1[r] : -INFINITY; } } \
        if (t_ < NTOT && (j_ == cur || (!sel_ && cur >= 8 && j_ == wlo))) { asm volatile("; key mask (a real branch)"); fa::mask_range(C0, C1, j_ * 64, sel_ ? 0 : tq - 511, tq, hi); } } while (0)
#define NP_RESC() do { if (resc) { asm volatile("s_waitcnt lgkmcnt(0)" ::: "memory"); \
        _Pragma("unroll") for (int d_ = 0; d_ < 2; ++d_) _Pragma("unroll") for (int r = 0; r < 16; ++r) o[d_][r] *= wsf[crow(r, hi)]; } } while (0)
#define NP_FOLD(gofs) do { const float lt_ = fa::swap_sum(l_reg); asm volatile("s_waitcnt lgkmcnt(0)" ::: "memory"); if (hi == 0) wsf[32 + r32] = lt_; asm volatile("s_waitcnt lgkmcnt(0)" ::: "memory"); \
        _Pragma("unroll") for (int r = 0; r < 16; ++r) { const float s_ = wsf[(gofs) + crow(r, hi)] / __builtin_fmaxf(wsf[32 + crow(r, hi)], 1e-30f); OF[64 * r] += s_ * o[0][r]; OF[64 * (16 + r)] += s_ * o[1][r]; } \
        asm volatile("s_waitcnt lgkmcnt(0)" ::: "memory"); o[0] = f32x16{}; o[1] = f32x16{}; l_reg = 0.f; } while (0)
    f32x16 pA0, pA1, pB0, pB1;
    int sl_cur = 0, sl_next = SLOTB;
    int vs_prev = 0, vs_cur = 0, vs_nn = 2 * SLOTB;
#define NP_ROT() do { sl_cur = sl_next; sl_next = (sl_next == 2 * SLOTB) ? 0 : sl_next + SLOTB; vs_prev = vs_cur; vs_cur = (vs_cur == 3 * SLOTB) ? 0 : vs_cur + SLOTB; vs_nn = (vs_nn == 3 * SLOTB) ? 0 : vs_nn + SLOTB; } while (0)
    NP_WAIT_BAR(4);
#pragma unroll
    for (int r = 0; r < 16; ++r) { OF[64 * r] = oc0[r]; OF[64 * (16 + r)] = oc1[r]; }
    { const lds_cptr kb = L + NS_K + hi * 1024 + r32 * 16;
#pragma unroll
      for (int d0 = 0; d0 < 4; ++d0) { const bf16x8 b0 = *(const FA_LAS bf16x8*)(kb + d0 * 2048), b1 = *(const FA_LAS bf16x8*)(kb + d0 * 2048 + 512);
          if (d0 == 0) { pA0 = NP_MFMA(b0, qr[0], negm); pA1 = NP_MFMA(b1, qr[0], negm); } else { pA0 = NP_MFMA(b0, qr[d0], pA0); pA1 = NP_MFMA(b1, qr[d0], pA1); } } }
    NP_MASK(pA0, pA1, 0);
    { const float rm = fa::rowmax(pA0, pA1); const float dl = __builtin_fmaxf(rm, -64.f); mhat += dl;
#pragma unroll
      for (int r = 0; r < 16; ++r) { pA0[r] -= dl; pA1[r] -= dl; negm[r] = -mhat; }
      NP_PIN(negm);
#pragma unroll
      for (int r = 0; r < 16; ++r) { pA0[r] = __builtin_amdgcn_exp2f(pA0[r]); pA1[r] = __builtin_amdgcn_exp2f(pA1[r]); } }
    NP_WAIT_BAR(0);
    NP_DMA_K(3, 0); NP_DMA_V(2, 2 * SLOTB);
    NP_ROT();
    kload8(kf, kp0 + sl_cur);
    NP_WAIT_BAR(2);
    s16x4 vlo[8], vhi[8]; u32x4 pw0, pw1, pw2, pw3;
#define NP_PKW(P, B) fa::cvtpk(P[B], P[B + 1])
#define NP_PAF(k) __builtin_bit_cast(bf16x8, pw##k)
#define NP_VFR(i) (bf16x8){vlo[i][0], vlo[i][1], vlo[i][2], vlo[i][3], vhi[i][0], vhi[i][1], vhi[i][2], vhi[i][3]}
#define NP_GAPA(MF, A0, A1, A2, A3, W0, W1, PW) do { MF; sacc += A0; sacc += A1; sacc += A2; sacc += A3; NP_PIN(sacc); W0; W1; NP_PIN(PW); NP_SBAR(); } while (0)
#define NP_EX(v) __builtin_amdgcn_exp2f(v)
#define NP_GAPB(MF, X, B) do { MF; X[B] = NP_EX(X[B]); X[B + 1] = NP_EX(X[B + 1]); X[B + 2] = NP_EX(X[B + 2]); X[B + 3] = NP_EX(X[B + 3]); NP_PIN(X); NP_SBAR(); } while (0)
#define NP_VRD(i) do { vlo[i] = fa::vtr(vp_ + (((i) >> 2) * 4096 + ((i) & 3) * 1024)); vhi[i] = fa::vtr(vp_ + (((i) >> 2) * 4096 + ((i) & 3) * 1024 + 512)); } while (0)
#define NP_KRD(G, j) do { if (G) { kload2(kf, kp0 + sl_next, j); NP_SBAR(); } } while (0)
#ifndef NSX
#define NSX 0
#endif
    f32x16 xd0 = f32x16{}, xd1 = f32x16{}; float xv = 1.0f;
#define NP_EXTRA() do { \
    if (NSX == 1) { _Pragma("unroll") for (int q_ = 0; q_ < 8; ++q_) { xd0 = NP_MFMA(kf[q_], qr[q_ & 3], xd0); xd1 = NP_MFMA(kf[q_], qr[(q_ + 1) & 3], xd1); } NP_PIN(xd0); NP_PIN(xd1); } \
    if (NSX == 2) { _Pragma("unroll") for (int q_ = 0; q_ < 64; ++q_) { xv = NP_EX(xv * 0.999f); NP_PIN(xv); } } \
    if (NSX == 3) { asm volatile("s_barrier" ::: "memory"); } \
    if (NSX == 4) { bf16x8 xk[8]; kload8(xk, kp0 + sl_cur); _Pragma("unroll") for (int q_ = 0; q_ < 8; ++q_) asm volatile("" :: "v"(xk[q_])); kload8(xk, kp0 + sl_next); _Pragma("unroll") for (int q_ = 0; q_ < 8; ++q_) asm volatile("" :: "v"(xk[q_])); kload8(xk, kp0); _Pragma("unroll") for (int q_ = 0; q_ < 8; ++q_) asm volatile("" :: "v"(xk[q_])); } \
    } while (0)
#define NP_STEP(C0, C1, P0, P1, t, GK, GV, GL) do { NP_SBAR(); \
    const lds_cptr vp_ = vp0 + vs_prev; \
    NP_VRD(0); NP_SBAR(); float sacc = (P0[0] + P0[1]); \
    NP_GAPA(C0 = NP_MFMA(kf[0], qr[0], negm), P0[2], P0[3], P0[4], P0[5],     pw0[0] = NP_PKW(P0, 0), pw0[1] = NP_PKW(P0, 2), pw0); \
    NP_VRD(4); NP_SBAR(); NP_GAPA(C1 = NP_MFMA(kf[1], qr[0], negm), P0[6], P0[7], P0[8], P0[9],     pw0[2] = NP_PKW(P0, 4), pw0[3] = NP_PKW(P0, 6), pw0); \
    NP_VRD(1); NP_SBAR(); NP_GAPA(C0 = NP_MFMA(kf[2], qr[1], C0),   P0[10], P0[11], P0[12], P0[13], pw1[0] = NP_PKW(P0, 8), pw1[1] = NP_PKW(P0, 10), pw1); \
    NP_VRD(5); NP_SBAR(); NP_GAPA(C1 = NP_MFMA(kf[3], qr[1], C1),   P0[14], P0[15], P1[0], P1[1],   pw1[2] = NP_PKW(P0, 12), pw1[3] = NP_PKW(P0, 14), pw1); \
    NP_VRD(2); NP_SBAR(); NP_GAPA(C0 = NP_MFMA(kf[4], qr[2], C0),   P1[2], P1[3], P1[4], P1[5],     pw2[0] = NP_PKW(P1, 0), pw2[1] = NP_PKW(P1, 2), pw2); \
    NP_VRD(6); NP_SBAR(); NP_GAPA(C1 = NP_MFMA(kf[5], qr[2], C1),   P1[6], P1[7], P1[8], P1[9],     pw2[2] = NP_PKW(P1, 4), pw2[3] = NP_PKW(P1, 6), pw2); \
    NP_VRD(3); NP_SBAR(); NP_GAPA(C0 = NP_MFMA(kf[6], qr[3], C0),   P1[10], P1[11], P1[12], P1[13], pw3[0] = NP_PKW(P1, 8), pw3[1] = NP_PKW(P1, 10), pw3); \
    NP_VRD(7); NP_SBAR(); NP_GAPA(C1 = NP_MFMA(kf[7], qr[3], C1),   P1[14], P1[15], 0.f, 0.f,       pw3[2] = NP_PKW(P1, 12), pw3[3] = NP_PKW(P1, 14), pw3); \
    l_reg += sacc; \
    if (GK) { NP_DMA_K((t) + 3, sl_cur); } if (GV) { NP_DMA_V((t) + 2, vs_nn); } \
    NP_MASK(C0, C1, t); \
    { float a = NP_MX3(C0[0], C0[1], C1[0]), b_ = NP_MX3(C0[2], C0[3], C1[1]); a = NP_MX3(a, C1[2], C1[3]); \
      _Pragma("unroll") for (int r = 4; r < 16; r += 4) { a = NP_MX3(a, C0[r], C0[r + 1]); b_ = NP_MX3(b_, C0[r + 2], C0[r + 3]); a = NP_MX3(a, C1[r], C1[r + 1]); b_ = NP_MX3(b_, C1[r + 2], C1[r + 3]); } \
      const float rm = fa::swap_max(__builtin_fmaxf(a, b_)); \
      resc = false; \
      if (__builtin_expect(__any(rm > fa::FA_THR), 0)) { const float dl = __builtin_fmaxf(rm, 0.f); mhat += dl; \
        _Pragma("unroll") for (int r = 0; r < 16; ++r) { C0[r] -= dl; C1[r] -= dl; } \
        _Pragma("unroll") for (int r = 0; r < 16; ++r) negm[r] = -mhat; NP_PIN(negm); \
        const float f = __builtin_amdgcn_exp2f(-dl); l_reg *= f; if (hi == 0) wsf[r32] = f; resc = true; } } \
    NP_SBAR(); \
    NP_GAPB(o[0] = NP_MFMA(NP_PAF(0), NP_VFR(0), o[0]), C0, 0); \
    NP_GAPB(o[1] = NP_MFMA(NP_PAF(0), NP_VFR(4), o[1]), C0, 4); \
    NP_KRD(GL, 0); NP_GAPB(o[0] = NP_MFMA(NP_PAF(1), NP_VFR(1), o[0]), C0, 8); \
    NP_KRD(GL, 1); NP_GAPB(o[1] = NP_MFMA(NP_PAF(1), NP_VFR(5), o[1]), C0, 12); \
    NP_KRD(GL, 2); NP_GAPB(o[0] = NP_MFMA(NP_PAF(2), NP_VFR(2), o[0]), C1, 0); \
    NP_KRD(GL, 3); NP_GAPB(o[1] = NP_MFMA(NP_PAF(2), NP_VFR(6), o[1]), C1, 4); \
    NP_GAPB(o[0] = NP_MFMA(NP_PAF(3), NP_VFR(3), o[0]), C1, 8); \
    NP_GAPB(o[1] = NP_MFMA(NP_PAF(3), NP_VFR(7), o[1]), C1, 12); \
    NP_EXTRA(); \
    } while (0)
#define NP_ENDW(tt) do { if ((tt) + 3 < NT) { NP_WAIT_BAR(3); } else if ((tt) + 2 < NT) { NP_WAIT_BAR(2); } else { NP_WAIT_BAR(0); } } while (0)
#define NP_HOOK(t) do { if ((t) == NS) NP_FOLD(96); } while (0)
    int t = 1;
    for (; t + 1 < NT; t += 2) {
        NP_STEP(pB0, pB1, pA0, pA1, t, (t + 3 < NT), (t + 2 < NT), (t + 1 < NT));         NP_ENDW(t);     NP_RESC(); NP_ROT(); NP_HOOK(t);
        NP_STEP(pA0, pA1, pB0, pB1, t + 1, (t + 4 < NT), (t + 3 < NT), (t + 2 < NT));     NP_ENDW(t + 1); NP_RESC(); NP_ROT(); NP_HOOK(t + 1);
    }
    NP_STEP(pB0, pB1, pA0, pA1, NT - 1, false, false, false); NP_RESC(); NP_HOOK(NT - 1);
    { float sacc = pB0[0] + pB0[1];
#pragma unroll
      for (int r = 2; r < 16; ++r) sacc += pB0[r];
#pragma unroll
      for (int r = 0; r < 16; ++r) sacc += pB1[r];
      l_reg += sacc; NP_SBAR();
      fa::pv(o[0], o[1], pB0, pB1, L + NS_V + vs_cur, lane, hi); }
    { const float lt_ = fa::swap_sum(l_reg); asm volatile("s_waitcnt lgkmcnt(0)" ::: "memory"); if (hi == 0) wsf[32 + r32] = lt_; asm volatile("s_waitcnt lgkmcnt(0)" ::: "memory");
#pragma unroll
      for (int r = 0; r < 16; ++r) { const float s_ = wsf[64 + crow(r, hi)] / __builtin_fmaxf(wsf[32 + crow(r, hi)], 1e-30f); o[0][r] = OF[64 * r] + s_ * o[0][r]; o[1][r] = OF[64 * (16 + r)] + s_ * o[1][r]; }
      asm volatile("s_waitcnt lgkmcnt(0)" ::: "memory"); }
    store_o_tile(o[0], o[1], F.lds + RING_OFF + NS_CK + wid * 8192, lane, [&](int rr) { return Ow + (size_t)(rr >> 2) * 1024 + (rr & 3) * 64; });
    asm volatile("s_waitcnt lgkmcnt(0)\n\ts_barrier" ::: "memory");
#undef NP_DMA_K
#undef NP_DMA_V
#undef NP_MASK
#undef NP_RESC
#undef NP_FOLD
#undef NP_ROT
#undef NP_PKW
#undef NP_PAF
#undef NP_VFR
#undef NP_GAPA
#undef NP_EX
#undef NP_GAPB
#undef NP_VRD
#undef NP_KRD
#undef NP_STEP
#undef NP_ENDW
#undef NP_EXTRA
#undef NP_HOOK
}
constexpr int GA_A = 0, GA_ASZ = 32768, GA_B = 2 * GA_ASZ, GA_BSZ = 16384, GA_WS = GA_B + 2 * GA_BSZ;
__device__ __forceinline__ void nsa_gates_unit(Frame& F, int hm, const bf16* HBp, const bf16* WGT, const float* ssq, float* GT) {
    const int tid = opaque_tid(), lane = tid & 63, r32 = lane & 31, hi = lane >> 5, wid = __builtin_amdgcn_readfirstlane(tid >> 6);
    const int rb = wid & 3, nb = wid >> 2, row0 = hm * 128; const fa::lds_cptr L = (fa::lds_cptr)(F.lds + RING_OFF); const unsigned l0 = fa::lds_addr(L);
    LAS float* wsf = (LAS float*)(F.lds + RING_OFF + GA_WS) + rb * 32;
    float rsown;
    { const f32x4* sp = (const f32x4*)(ssq + (size_t)(row0 + rb * 32 + r32) * 16); const f32x4 a = sp[0], b = sp[1], c = sp[2], d = sp[3];
      const float s = ((a[0] + a[1]) + (a[2] + a[3])) + ((b[0] + b[1]) + (b[2] + b[3])) + ((c[0] + c[1]) + (c[2] + c[3])) + ((d[0] + d[1]) + (d[2] + d[3]));
      rsown = __builtin_amdgcn_rsqf(s * (1.0f / 1024.0f) + pg8::NORM_EPS); }
    __builtin_amdgcn_s_waitcnt(0x0F70);
    if (nb == 0 && hi == 0) wsf[r32] = rsown;
    auto dma_chunk = [&](int kc, int buf) {
#pragma unroll
        for (int q = 0; q < 4; ++q) { const int i = 4 * wid + q, p = 64 * i + lane, row = p >> 4, slot = p & 15, ch = slot ^ (row & 7);
            fa::glds16(HBp + (size_t)(row0 + row) * 1024 + kc * 128 + ch * 8, (unsigned)__builtin_amdgcn_readfirstlane(l0 + GA_A + buf * GA_ASZ + i * 1024)); }
#pragma unroll
        for (int q = 0; q < 2; ++q) { const int i = 2 * wid + q; fa::glds16(WGT + (size_t)kc * 8192 + i * 512 + lane * 8, (unsigned)__builtin_amdgcn_readfirstlane(l0 + GA_B + buf * GA_BSZ + i * 1024)); } };
    fa::f32x16 acc = fa::f32x16{};
    const int rot = (int)(blockIdx.x >> 3);
    dma_chunk(rot & 7, 0); dma_chunk((rot + 1) & 7, 1);
    const int arow = 32 * rb + r32;
    for (int kc = 0; kc < 8; ++kc) { const int buf = kc & 1;
        if (kc + 1 < 8) FA_WAIT_BAR(6); else FA_WAIT_BAR(0);
        const fa::lds_cptr ab = L + GA_A + buf * GA_ASZ + arow * 256, bb = L + GA_B + buf * GA_BSZ + nb * 1024 + lane * 16;
#pragma unroll
        for (int s = 0; s < 8; ++s) { const fa::bf16x8 a = *(const FA_LAS fa::bf16x8*)(ab + (((2 * s + hi) ^ (arow & 7)) * 16)), b = *(const FA_LAS fa::bf16x8*)(bb + s * 2048);
            acc = FA_MFMA(a, b, acc); }
        asm volatile("s_waitcnt lgkmcnt(0)\n\ts_barrier" ::: "memory");
        if (kc + 2 < 8) dma_chunk((kc + 2 + rot) & 7, buf);
    }
#pragma unroll
    for (int r = 0; r < 16; ++r) { const int rr = fa::crow(r, hi); const float rs = wsf[rr]; const int col = 32 * nb + r32;
        if (col < 48) GT[(size_t)(row0 + 32 * rb + rr) * 48 + col] = pg8::sigmoid_f(acc[r] * rs); }
    asm volatile("s_waitcnt lgkmcnt(0)\n\ts_barrier" ::: "memory");
}
constexpr int CP_A = 0, CP_RED = 67584, CP_H1 = CP_RED + 65536, CP_END = CP_H1 + 16384;
static_assert(CP_END <= RING_BYTES, "compress LDS map");
__device__ __forceinline__ void compress_unit(Frame& F, int u, const bf16* KV6, const bf16* CW1, const bf16* CW2, const float* BIAS1, const float* rope, bf16* KCMP, bf16* VCMP) {
    const int tid = opaque_tid(), lane = tid & 63, r32 = lane & 31, hi = lane >> 5, wid = __builtin_amdgcn_readfirstlane(tid >> 6);
    const int nb = u & 7, g = (u >> 3) & 3, b = (u >> 5) & 7, kv = u >> 8;
    const fa::lds_cptr L = (fa::lds_cptr)(F.lds + RING_OFF); const unsigned l0 = fa::lds_addr(L);
    const bf16* src = KV6 + (size_t)kv * ((size_t)MROWS * 256) + (size_t)b * SEQ * 256 + g * 64;
    const bf16* w1f = CW1 + (size_t)kv * 262144 + lane * 8;
    const int tok0 = 512 * nb;
    for (int i = wid; i < 66; i += 8) { const int p = 64 * i + lane, row = p >> 3, slot = p & 7, ch = slot ^ ((row >> 4) & 7); int trow = tok0 + row; if (trow > SEQ - 1) trow = SEQ - 1;
        fa::glds16(src + (size_t)trow * 256 + ch * 8, (unsigned)__builtin_amdgcn_readfirstlane(l0 + CP_A + i * 1024)); }
    FA_WAIT_BAR(0);
    const int wk = wid & 3, nh = wid >> 2, crot = (int)(blockIdx.x >> 3) & 7;
    fa::f32x16 acc0 = fa::f32x16{}, acc1 = fa::f32x16{};
#pragma unroll 8
    for (int kk = 0; kk < 32; ++kk) { const int l = 8 * wk + (((kk >> 2) + crot) & 7), d0 = kk & 3, row = 16 * r32 + l, slot = (2 * d0 + hi) ^ ((row >> 4) & 7);
        const fa::bf16x8 a = *(const FA_LAS fa::bf16x8*)(L + CP_A + row * 128 + slot * 16);
        const fa::bf16x8 b0 = *(const fa::bf16x8*)(w1f + (size_t)((l * 4 + d0) * 4 + 2 * nh) * 512), b1 = *(const fa::bf16x8*)(w1f + (size_t)((l * 4 + d0) * 4 + 2 * nh + 1) * 512);
        acc0 = FA_MFMA(a, b0, acc0); acc1 = FA_MFMA(a, b1, acc1); }
    { LAS float* red = (LAS float*)(F.lds + RING_OFF + CP_RED) + wid * 2048 + r32;
#pragma unroll
      for (int r = 0; r < 16; ++r) { red[fa::crow(r, hi) * 64] = acc0[r]; red[fa::crow(r, hi) * 64 + 32] = acc1[r]; } }
    __syncthreads();
    { const int row = tid >> 4, c0 = (tid & 15) * 8, nhh = c0 >> 6; const LAS float* red = (const LAS float*)(F.lds + RING_OFF + CP_RED) + (nhh * 4 * 32 + row) * 64 + (c0 & 63);
      float s[8];
#pragma unroll
      for (int e = 0; e < 8; ++e) s[e] = BIAS1[kv * 128 + c0 + e];
#pragma unroll
      for (int w = 0; w < 4; ++w) { const f32x4 x0 = *(const LAS f32x4*)(red + w * 2048), x1 = *(const LAS f32x4*)(red + w * 2048 + 4); s[0] += x0[0]; s[1] += x0[1]; s[2] += x0[2]; s[3] += x0[3]; s[4] += x1[0]; s[5] += x1[1]; s[6] += x1[2]; s[7] += x1[3]; }
      { const int ch = (tid & 15) ^ (row & 15);
        v4u o; o.x = pk2(pg8::silu_f(s[0]), pg8::silu_f(s[1])); o.y = pk2(pg8::silu_f(s[2]), pg8::silu_f(s[3])); o.z = pk2(pg8::silu_f(s[4]), pg8::silu_f(s[5])); o.w = pk2(pg8::silu_f(s[6]), pg8::silu_f(s[7]));
        *(LAS v4u*)(F.lds + RING_OFF + CP_H1 + row * 256 + ch * 16) = o; } }
    __syncthreads();
    if (wid == 0) {
        const bf16* w2f = CW2 + (size_t)kv * 8192 + lane * 8; fa::f32x16 o1 = fa::f32x16{}, o2 = fa::f32x16{};
#pragma unroll
        for (int ks = 0; ks < 8; ++ks) { const fa::bf16x8 a = *(const FA_LAS fa::bf16x8*)(L + CP_H1 + r32 * 256 + (((2 * ks + hi) ^ (r32 & 15)) * 16));
            o1 = FA_MFMA(a, *(const fa::bf16x8*)(w2f + (size_t)(ks * 2) * 512), o1); o2 = FA_MFMA(a, *(const fa::bf16x8*)(w2f + (size_t)(ks * 2 + 1) * 512), o2); }
#pragma unroll
        for (int r = 0; r < 16; ++r) { const int nn = nb * 32 + fa::crow(r, hi); float x1 = o1[r], x2 = o2[r];
            if (kv == 0 && nn < 255) { const size_t prow = (size_t)b * SEQ + 16 * nn + 31; const f32x2 cs = *(const f32x2*)(rope + (prow * 32 + r32) * 2);
                const float y1 = x1 * cs[0] - x2 * cs[1], y2 = x2 * cs[0] + x1 * cs[1]; x1 = y1; x2 = y2; }
            if (nn >= 255) { x1 = 0.f; x2 = 0.f; }
            bf16* dst = (kv ? VCMP : KCMP) + (((size_t)b * 256 + nn) * 4 + g) * 64 + r32;
            dst[0] = (bf16)f2bf(x1); dst[32] = (bf16)f2bf(x2); } }
    __syncthreads();
}
template <int MODE> __device__ __forceinline__ void nsa_unit(Frame& F, int b, int g, int qb, const bf16* QN, const bf16* KV6, const bf16* KCMP, const bf16* VCMP, const float* GT, bf16* O1) {
    const int tid = opaque_tid(), lane = tid & 63, r32 = lane & 31, hi = lane >> 5, wid = __builtin_amdgcn_readfirstlane(tid >> 6);
    const fa::lds_cptr L = (fa::lds_cptr)(F.lds + RING_OFF); const unsigned l0 = fa::lds_addr(L);
    LAS float* wsf = (LAS float*)(F.lds + RING_OFF + NS_WS) + wid * 128;
    const int tl = 8 * wid + (r32 >> 2), hh = r32 & 3, head = 4 * g + hh, t = 64 * qb + tl, cur = qb;
    const size_t tok = (size_t)b * SEQ + t;
    fa::bf16x8 qr[4];
#pragma unroll
    for (int d0 = 0; d0 < 4; ++d0) qr[d0] = *(const fa::bf16x8*)(QN + tok * 1024 + head * 64 + d0 * 16 + hi * 8);
    const float g0own = GT[tok * 48 + head * 3], g1own = GT[tok * 48 + head * 3 + 1], g2own = GT[tok * 48 + head * 3 + 2];
    __builtin_amdgcn_s_waitcnt(0x0F70);
    if (hi == 0) { wsf[64 + r32] = g0own; wsf[96 + r32] = g1own; }
    const int NTC = ((4 * qb + 2) >> 6) + 1;
    const bf16* kc = KCMP + (size_t)b * 256 * 256 + g * 64; const bf16* vc = VCMP + (size_t)b * 256 * 256 + g * 64;
    for (int T = 0; T < NTC; ++T) { fa::dma_k<64>(kc + (size_t)T * 64 * 256, 256, l0 + NS_CK + T * 8192, wid, lane); fa::dma_v(vc + (size_t)T * 64 * 256, 256, l0 + NS_CV + T * 8192, wid, lane); }
    NsaTiles TL; TL.init(KV6, b, g, cur, l0, lane, wid); TL.prologue();
    const int khc = (t >= 31) ? ((t - 31) >> 4) : -1;
    FA_WAIT_BAR(5);
    const fa::f32x16 zero16 = fa::f32x16{};
    const int twlo = 64 * qb + 8 * wid, khc_lo = (twlo >= 31) ? ((twlo - 31) >> 4) : -1, khc_hi = (twlo + 7 >= 31) ? ((twlo + 7 - 31) >> 4) : -1;
    const int NTW = (khc_hi >> 6) + 1;
    float mc = -1e30f;
    for (int T = 0; T < NTW; ++T) { fa::f32x16 p0, p1; fa::qkt<64>(p0, p1, L + NS_CK + T * 8192, qr, zero16, r32, hi); if (T * 64 + 63 > khc_lo) { asm volatile("; cmp mask (a real branch)"); fa::mask_range(p0, p1, T * 64, 0, khc, hi); }
        mc = __builtin_fmaxf(mc, fa::rowmax(p0, p1)); }
    float lc = 0.f; fa::f32x16 oc0 = fa::f32x16{}, oc1 = fa::f32x16{};
    float ia[32], ic[32];
#pragma unroll
    for (int i = 0; i < 32; ++i) { ia[i] = 0.f; ic[i] = 0.f; }
#pragma unroll
    for (int T = 0; T < 4; ++T) if (T < NTW) { fa::f32x16 p0, p1; fa::qkt<64>(p0, p1, L + NS_CK + T * 8192, qr, zero16, r32, hi); if (T * 64 + 63 > khc_lo) { asm volatile("; cmp mask (a real branch)"); fa::mask_range(p0, p1, T * 64, 0, khc, hi); }
        float s0 = 0.f, s1 = 0.f;
#pragma unroll
        for (int r = 0; r < 16; ++r) { p0[r] = __builtin_amdgcn_exp2f(p0[r] - mc); p1[r] = __builtin_amdgcn_exp2f(p1[r] - mc); s0 += p0[r]; s1 += p1[r]; }
        lc += s0 + s1;
#pragma unroll
        for (int jj = 0; jj < 4; ++jj) { ia[T * 8 + jj] = (p0[4 * jj] + p0[4 * jj + 1]) + (p0[4 * jj + 2] + 0.5f * p0[4 * jj + 3]); ic[T * 8 + jj] = 0.5f * p0[4 * jj + 3];
            ia[T * 8 + 4 + jj] = (p1[4 * jj] + p1[4 * jj + 1]) + (p1[4 * jj + 2] + 0.5f * p1[4 * jj + 3]); ic[T * 8 + 4 + jj] = 0.5f * p1[4 * jj + 3]; }
        fa::pv(oc0, oc1, p0, p1, L + NS_CV + T * 8192, lane, hi); }
    lc = fa::swap_sum(lc);
    const float ilc = 1.0f / __builtin_fmaxf(lc, 1e-30f);
    LDS_WAIT(); if (hi == 0) wsf[32 + r32] = ilc; LDS_WAIT();
#pragma unroll
    for (int r = 0; r < 16; ++r) { const float f = wsf[32 + fa::crow(r, hi)]; oc0[r] *= f; oc1[r] *= f; }
    unsigned long long selmask;
    if (cur < 16) selmask = (2ull << cur) - 1ull;
    else {
        LAS int* impb = (LAS int*)(F.lds + RING_OFF + NS_IMP + wid * 2048) + (r32 >> 2) * 64;
#pragma unroll
        for (int i = 0; i < 32; ++i) { ia[i] *= ilc; ic[i] *= ilc;
            ia[i] += __builtin_bit_cast(float, __builtin_amdgcn_update_dpp(0, __builtin_bit_cast(int, ia[i]), 0xB1, 0xf, 0xf, true)); ia[i] += __builtin_bit_cast(float, __builtin_amdgcn_update_dpp(0, __builtin_bit_cast(int, ia[i]), 0x4E, 0xf, 0xf, true));
            ic[i] += __builtin_bit_cast(float, __builtin_amdgcn_update_dpp(0, __builtin_bit_cast(int, ic[i]), 0xB1, 0xf, 0xf, true)); ic[i] += __builtin_bit_cast(float, __builtin_amdgcn_update_dpp(0, __builtin_bit_cast(int, ic[i]), 0x4E, 0xf, 0xf, true)); }
#pragma unroll
        for (int i = 0; i < 32; ++i) { auto rr = __builtin_amdgcn_permlane32_swap(__float_as_uint(ic[i]), __float_as_uint(ic[i]), false, false); ic[i] = __uint_as_float(hi ? rr[0] : rr[1]); }
#pragma unroll
        for (int i = 0; i < 32; ++i) { const float add = hi ? ic[i] : (i > 0 ? ic[i > 0 ? i - 1 : 0] : 0.f); const int mb = 2 * i + hi; const float v = ia[i] + add;
            int key = (int)((__float_as_uint(v) & ~63u) | (unsigned)(63 - mb)); if (mb < 1 || mb > cur - 2) key = (int)0x80000000;
            if (hh == 0) impb[mb] = key; }
        LDS_WAIT();
        const int sub = hh * 2 + hi; int mine[8]; int cnt[8];
#pragma unroll
        for (int e = 0; e < 8; ++e) { mine[e] = impb[8 * sub + e]; cnt[e] = 0; }
        for (int q4 = 0; q4 < 16; ++q4) { const v4u v = *(const LAS v4u*)(impb + 4 * q4);
#pragma unroll
            for (int k = 0; k < 4; ++k) { const int ko = (int)v[k];
#pragma unroll
                for (int e = 0; e < 8; ++e) cnt[e] += (ko > mine[e]) ? 1 : 0; } }
        unsigned bits = 0u;
#pragma unroll
        for (int e = 0; e < 8; ++e) { const int mb = 8 * sub + e; const bool cand = (mb >= 1 && mb <= cur - 2); const bool forced = (mb == 0 || mb == cur || mb == cur - 1); if (forced || (cand && cnt[e] < 13)) bits |= 1u << e; }
        unsigned lo = (sub < 4) ? bits << (8 * sub) : 0u, hi32 = (sub >= 4) ? bits << (8 * (sub - 4)) : 0u;
        lo |= __shfl_xor(lo, 1); lo |= __shfl_xor(lo, 2); lo |= __shfl_xor(lo, 32); hi32 |= __shfl_xor(hi32, 1); hi32 |= __shfl_xor(hi32, 2); hi32 |= __shfl_xor(hi32, 32);
        selmask = ((unsigned long long)hi32 << 32) | lo;
        LDS_WAIT();
    }
#pragma unroll
    for (int r = 0; r < 16; ++r) { const float gc = wsf[64 + fa::crow(r, hi)]; oc0[r] *= gc; oc1[r] *= gc; }
    LDS_WAIT(); if (hi == 0) wsf[64 + r32] = g2own; LDS_WAIT();
    if (MODE == 1) { asm volatile("" :: "v"(oc0), "v"(oc1), "v"(selmask)); FA_WAIT_BAR(0); return; }
    bf16* Ow = O1 + ((size_t)b * SEQ + 64 * qb + 8 * wid) * 1024 + 4 * g * 64;
    nsa_stream_pipe(F, qr, TL, t, selmask, oc0, oc1, Ow, lane, wid);
}
__device__ __forceinline__ void final_norm(Frame& F, const bf16* src, float* out, const float* ssq, const float* gain) {
    const int tid = opaque_tid(), lane = tid & 63; const int gw = F.vcu * NWAVES + __builtin_amdgcn_readfirstlane(tid >> 6), NGW = F.G * NWAVES;
    f32x4 gv[4];
#pragma unroll
    for (int j = 0; j < 4; ++j) gv[j] = *((const f32x4*)gain + 2 * lane + 128 * (j >> 1) + (j & 1));
    for (int m = gw; m < MROWS; m += NGW) { float s = (lane < 16) ? ssq[(size_t)m * 16 + lane] : 0.f; s = wave_sum(s); const float rstd = 1.0f / sqrtf(s * (1.0f / 1024.0f) + pg8::NORM_EPS);
        const v4u* xs = (const v4u*)(src + (size_t)m * DM) + lane; f32x4* xr = (f32x4*)(out + (size_t)m * DM) + 2 * lane;
#pragma unroll
        for (int hh = 0; hh < 2; ++hh) { const v4u w = xs[64 * hh];
            const f32x4 a = {__builtin_bit_cast(float, w.x << 16), __builtin_bit_cast(float, w.x & 0xffff0000u), __builtin_bit_cast(float, w.y << 16), __builtin_bit_cast(float, w.y & 0xffff0000u)};
            const f32x4 c = {__builtin_bit_cast(float, w.z << 16), __builtin_bit_cast(float, w.z & 0xffff0000u), __builtin_bit_cast(float, w.w << 16), __builtin_bit_cast(float, w.w & 0xffff0000u)};
            xr[128 * hh] = a * rstd * gv[2 * hh]; xr[128 * hh + 1] = c * rstd * gv[2 * hh + 1]; } }
}
#ifndef PH_END
#define PH_END 99
#endif
struct Args { Inputs in; float* out; unsigned char* ws; RopeFreq rf; };
__global__ void __launch_bounds__(NWAVES * 64, 2) trunk_fwd(Args args) {
    extern __shared__ __attribute__((aligned(16))) unsigned char lds[];
    Frame F;
    F.lds = (LAS unsigned char*)lds;
    F.MISC = (volatile LAS unsigned*)(F.lds + MISC_OFF);
    F.G = gridDim.x; { const int bx = blockIdx.x; F.vcu = (F.G % 8 == 0) ? (bx % 8) * (F.G / 8) + bx / 8 : bx; }
    F.ws = args.ws; F.ctl = (gu32*)(args.ws + WS_CTL);
    const Inputs& I = args.in; unsigned char* ws = args.ws; float* out = args.out;
    for (int u = threadIdx.x; u < (LDS_BYTES - LDSCTL_OFF) / 4; u += NWAVES * 64) ((LAS unsigned*)(F.lds + LDSCTL_OFF))[u] = 0u;
    __syncthreads();
    XcdBarrier bar = xcd_barrier_post((unsigned*)(F.ctl + CW_BAR), F.MISC + 8);
#define GRID_BAR() xcd_barrier(bar)
#define ON(k) ((k) < PH_END)
#ifndef DUP
#define DUP -1
#endif
#define NREP(k) (((k) == DUP) ? 2 : 1)
#ifndef WGM_OTHER
#define WGM_OTHER 4
#endif
#ifndef TPROBE
#define TPROBE -1
#endif
    bf16* HB = (bf16*)(ws + WS_HB); float* SSQ = (float*)(ws + WS_SSQ); bf16* HID = (bf16*)(ws + WS_HID);
    if (ON(0)) for (int rep = 0; rep < NREP(0); ++rep) p0_prologue(F, I, args.rf);
    GRID_BAR();
#define FFN_PHASES(f, XB, k0) do { \
    if (ON(k0) && DUP == 300 + (f)) { pg8::Gemm g{HB, (const bf16*)(ws + WS_WGU) + (size_t)(f) * 5632 * DM, MROWS, 5632, DM, DM}; pg8::StaticOrder S; S.init(MROWS, 5632, F.G, (int)blockIdx.x); pg8::EpiNull E{}; pg8::gemm_phase<pg8::EpiNull, pg8::StaticOrder, true, true>(F.lds + RING_OFF, g, S, E); } \
    if (ON(k0) && DUP == 400 + (f)) { pg8::Gemm g{HID, (const bf16*)(ws + WS_WD) + (size_t)(f) * DM * FF, MROWS, DM, FF, FF}; pg8::StaticOrder S; S.init(MROWS, DM, F.G, (int)blockIdx.x, WGM_OTHER); pg8::EpiNull E{}; pg8::gemm_phase<pg8::EpiNull, pg8::StaticOrder, true, true>(F.lds + RING_OFF, g, S, E); } \
    if (ON(k0)) for (int rep = 0; rep < NREP(100 + (f)); ++rep) { pg8::Gemm g{HB, (const bf16*)(ws + WS_WGU) + (size_t)(f) * 5632 * DM, MROWS, 5632, DM, DM}; pg8::StaticOrder S; S.init(MROWS, 5632, F.G, (int)blockIdx.x); \
        pg8::EpiGateUp E{HID, SSQ, FF}; pg8::gemm_phase<pg8::EpiGateUp, pg8::StaticOrder, true, true>(F.lds + RING_OFF, g, S, E); } \
    GRID_BAR(); \
    if (ON(k0)) for (int rep = 0; rep < NREP(200 + (f)); ++rep) { pg8::Gemm g{HID, (const bf16*)(ws + WS_WD) + (size_t)(f) * DM * FF, MROWS, DM, FF, FF}; pg8::StaticOrder S; S.init(MROWS, DM, F.G, (int)blockIdx.x, WGM_OTHER); \
        pg8::EpiResidT<XB> E{I.x, HB, SSQ, 0.5f}; \
        if (DUP == 500 && (f) == 0) { pg8::EpiTwice<pg8::EpiResidT<XB>> E2{E}; pg8::gemm_phase<pg8::EpiTwice<pg8::EpiResidT<XB>>, pg8::StaticOrder, true, true>(F.lds + RING_OFF, g, S, E2); } \
        else pg8::gemm_phase<pg8::EpiResidT<XB>, pg8::StaticOrder, true, true>(F.lds + RING_OFF, g, S, E); } \
    GRID_BAR(); } while (0)

    FFN_PHASES(0, true, 1);
    {
        bf16* U0 = (bf16*)(ws + WS_U0); bf16* QM = (bf16*)(ws + WS_QM); bf16* KF = (bf16*)(ws + WS_KF); bf16* VM = (bf16*)(ws + WS_VM); bf16* O0 = (bf16*)(ws + WS_O0);
        bf16* KD = (bf16*)out; bf16* QA = KD + (size_t)MROWS * 256; bf16* QI = QA + (size_t)MROWS * 256;
        float* SSQQ = (float*)(ws + WS_SSQQ); float* SSQKV = (float*)(ws + WS_SSQKV); float* KR = (float*)(ws + WS_KR); float* GA = (float*)(ws + WS_GA); float* DEC = (float*)(ws + WS_DEC);
        const float* ROPE0 = (const float*)(ws + WS_ROPE0);
        if (ON(2)) for (int rep = 0; rep < NREP(2); ++rep) { pg8::Gemm g{HB, (const bf16*)(ws + WS_WIN0), MROWS, HYN, DM, DM}; pg8::StaticOrder S; S.init(MROWS, HYN, F.G, (int)blockIdx.x, WGM_OTHER);
            pg8::EpiHyIn E{U0, SSQ, SSQQ, SSQKV, KR, GA}; pg8::gemm_phase<pg8::EpiHyIn, pg8::StaticOrder, true, true>(F.lds + RING_OFF, g, S, E); }
        GRID_BAR();
        if (ON(3)) for (int rep = 0; rep < NREP(3); ++rep) {
            for (int r2 = 0; r2 < NREP(31); ++r2) for (int hm = (int)blockIdx.x; hm < MROWS / 128; hm += F.G) mla_up_unit(F, hm, U0, (const bf16*)(ws + WS_WUQ), (const bf16*)(ws + WS_WUKV), SSQQ, SSQKV, ROPE0, 0.10206207261596577f * LOG2E, QM, KF, VM);
            for (int r2 = 0; r2 < NREP(33); ++r2) krot_pass(F, KR, ROPE0, KF);
            for (int r2 = 0; r2 < NREP(34); ++r2) gla_pre(F, U0, GA, I.w_a2, I.b_a, KD, QA, QI, DEC);
        }
        GRID_BAR();
        if (ON(4)) for (int rep = 0; rep < NREP(4); ++rep) {
            if (blockIdx.x < 32) for (int r2 = 0; r2 < NREP(41); ++r2) gla_unit(F, (int)blockIdx.x >> 2, (int)blockIdx.x & 3, U0, KD, QA, QI, DEC, I.gla_norm, O0);
            { const int xg = (int)blockIdx.x & 7;
              for (int r2 = 0; r2 < NREP(42); ++r2) for (;;) { const int i = wq_next(F, CW_Q0 + 64 * xg + 1024 * rep + 2048 * r2); if (i >= 128) break; const int pr = 8 * xg + (i & 7); mla_attn_unit(F, pr >> 3, pr & 7, 15 - (i >> 3), QM, KF, VM, O0); } }
        }
        GRID_BAR();
        if (ON(5)) { pg8::Gemm g{O0, (const bf16*)(ws + WS_WOUT0), MROWS, DM, DM, DM}; pg8::StaticOrder S; S.init(MROWS, DM, F.G, (int)blockIdx.x, WGM_OTHER);
            pg8::EpiResidT<false> E{I.x, HB, SSQ, 1.0f}; pg8::gemm_phase<pg8::EpiResidT<false>, pg8::StaticOrder, true, true>(F.lds + RING_OFF, g, S, E); }
        GRID_BAR();
    }
    FFN_PHASES(1, false, 6);
    FFN_PHASES(2, false, 7);
    {
        bf16* QN = (bf16*)(ws + WS_QN); bf16* KV6 = (bf16*)(ws + WS_KV6); bf16* O1 = (bf16*)(ws + WS_O1); float* GT = (float*)(ws + WS_GT);
        bf16* KCMP = (bf16*)(ws + WS_KCMP); bf16* VCMP = (bf16*)(ws + WS_VCMP); const float* ROPE1 = (const float*)(ws + WS_ROPE1);
        if (ON(8)) for (int rep = 0; rep < NREP(8); ++rep) { pg8::Gemm g{HB, (const bf16*)(ws + WS_WIN1), MROWS, NSAN, DM, DM}; pg8::StaticOrder S; S.init(MROWS, NSAN, F.G, (int)blockIdx.x, WGM_OTHER);
            pg8::EpiNsaIn E{QN, KV6, SSQ, ROPE1, 0.125f * LOG2E}; pg8::gemm_phase<pg8::EpiNsaIn, pg8::StaticOrder, true, true>(F.lds + RING_OFF, g, S, E);
            for (int r2 = 0; r2 < NREP(81); ++r2) for (int hm = (int)blockIdx.x; hm < MROWS / 128; hm += F.G) nsa_gates_unit(F, hm, HB, (const bf16*)(ws + WS_WGT), SSQ, GT); }
        GRID_BAR();
        if (ON(9)) for (int rep = 0; rep < NREP(9); ++rep) { for (int u = (int)blockIdx.x; u < 512; u += F.G) compress_unit(F, u, KV6, (const bf16*)(ws + WS_CW1), (const bf16*)(ws + WS_CW2), (const float*)(ws + WS_BIAS1), ROPE1, KCMP, VCMP); }
        GRID_BAR();
        if (ON(10)) for (int rep = 0; rep < NREP(10); ++rep) {
            const int xg = (int)blockIdx.x & 7;
            for (;;) { const int i = wq_next(F, CW_Q1 + 64 * xg + 1024 * rep); if (i >= 256) break; const int pr = 4 * xg + (i & 3), qb = 63 - (i >> 2);
                if (DUP == 110) nsa_unit<1>(F, pr >> 2, pr & 3, qb, QN, KV6, KCMP, VCMP, GT, O1);
                nsa_unit<0>(F, pr >> 2, pr & 3, qb, QN, KV6, KCMP, VCMP, GT, O1); } }
        GRID_BAR();
        if (ON(11)) { pg8::Gemm g{O1, (const bf16*)(ws + WS_WOUT1), MROWS, DM, DM, DM}; pg8::StaticOrder S; S.init(MROWS, DM, F.G, (int)blockIdx.x, WGM_OTHER);
            pg8::EpiResidT<false> E{I.x, HB, SSQ, 1.0f}; pg8::gemm_phase<pg8::EpiResidT<false>, pg8::StaticOrder, true, true>(F.lds + RING_OFF, g, S, E); }
        GRID_BAR();
    }
    FFN_PHASES(3, false, 12);
    final_norm(F, HB, out, SSQ, I.final_norm);
    if (blockIdx.x == 0 && threadIdx.x == 0) { if (__hip_atomic_load((unsigned*)(F.ctl + CW_BAR) + XB_TMO, RLX_AGENT) != 0u) { VM_WAIT(); out[0] = __builtin_nanf(""); } }
#undef ON
#undef GRID_BAR
}

extern "C" void kernel_launch(void* const* d_in, const int* in_sizes, int n_in, void* d_out, int out_size, void* d_ws, size_t ws_size, hipStream_t stream) {
    static int grid = 0;
    if (grid == 0) {
        if (n_in != 25 || in_sizes[0] != MROWS * DM || out_size != MROWS * DM || ws_size < WS_END) { fprintf(stderr, "kernel_launch: unexpected shapes (n_in %d, in0 %d, out %d, ws %zu); nothing launched\n", n_in, n_in > 0 ? in_sizes[0] : -1, out_size, ws_size); grid = -1; return; }
        int dev = 0, cus = 0, per_cu = 0;
        if (hipGetDevice(&dev) != hipSuccess || hipDeviceGetAttribute(&cus, hipDeviceAttributeMultiprocessorCount, dev) != hipSuccess) { grid = -1; return; }
        if (hipFuncSetAttribute((const void*)trunk_fwd, hipFuncAttributeMaxDynamicSharedMemorySize, LDS_BYTES) != hipSuccess) { fprintf(stderr, "kernel_launch: hipFuncSetAttribute failed\n"); grid = -1; return; }
        if (hipOccupancyMaxActiveBlocksPerMultiprocessor(&per_cu, (const void*)trunk_fwd, NWAVES * 64, LDS_BYTES) != hipSuccess || per_cu < 1) { fprintf(stderr, "kernel_launch: occupancy query reports %d workgroups per CU\n", per_cu); }
        (void)hipGetLastError();
        grid = cus;
    }
    if (grid < 0) return;
    if (hipMemsetAsync((char*)d_ws + WS_CTL, 0, CTL_ZERO_BYTES, stream) != hipSuccess) return;
    Args a{};
    const void** ip = (const void**)&a.in;
    for (int i = 0; i < 25; ++i) ip[i] = d_in[i];
    a.out = (float*)d_out; a.ws = (unsigned char*)d_ws;
    for (int j = 0; j < 16; ++j) a.rf.f16[j] = (double)powf(10000.0f, -(float)j * (2.0f / 32.0f));
    for (int j = 0; j < 32; ++j) a.rf.f32[j] = (double)powf(10000.0f, -(float)j * (2.0f / 64.0f));
    hipLaunchKernelGGL(trunk_fwd, dim3(grid), dim3(NWAVES * 64), LDS_BYTES, stream, a);
}
```

```cpp
#include <hip/hip_runtime.h>
#include <cstdio>
#include <cstdint>
#include <cmath>
#ifndef TPK
#define TPK -1
#endif
namespace pg8 {
#define PG8_LAS __attribute__((address_space(3)))
typedef unsigned short bf16_t;
typedef short bf16x8 __attribute__((ext_vector_type(8)));
typedef float f32x4 __attribute__((ext_vector_type(4)));
typedef unsigned u32x4 __attribute__((ext_vector_type(4)));
constexpr int BM = 256, BK = 64, HALF = 128, HTB = HALF * BK * 2  , STAGE_BYTES = 8 * HTB, NXCD = 8, WGM = 4;

__host__ __device__ __forceinline__ int lds_byte(int r, int c) { const int st = (r >> 4) * 2 + (c >> 5), rr = r & 15, cc = c & 31, ob = rr * 64 + cc * 2; return st * 1024 + (ob ^ (((ob >> 9) & 1) << 5)); }
__host__ __device__ __forceinline__ void stage_rc(int b, int& R, int& C) { const int st = b / 1024, sb = b % 1024, swz = sb ^ (((sb >> 9) & 1) << 5); R = (st >> 1) * 16 + swz / 64; C = (st & 1) * 32 + (swz % 64) / 2; }
__host__ __device__ __forceinline__ int perm32(int rho) { const int n = rho >> 4, i = rho & 15; return 8 * (i >> 2) + 4 * n + (i & 3); }

struct Unit { int pm, pn; };
struct Gemm { const bf16_t* A; const bf16_t* Bt; int M, N, K, lda; };

struct StaticOrder {
    int nM, nN, nwg, G, c, wgm;
    __host__ __device__ void init(int M, int N, int G_, int c_, int wgm_ = WGM) { nM = M / BM; nN = N / BM; nwg = nM * nN; G = G_; c = c_; wgm = wgm_; }
    __host__ __device__ bool next(int i, Unit& u) const {
        const long L = (long)i * G + c; if (L >= nwg) return false;
        int wgid = (int)L; { const int q = nwg / NXCD, r = nwg % NXCD, xcd = wgid % NXCD, off = wgid / NXCD; wgid = (xcd < r ? xcd * (q + 1) : r * (q + 1) + (xcd - r) * q) + off; }
        const int nig = wgm * nN, gid = wgid / nig, fm = gid * wgm, gsz = (nM - fm) < wgm ? (nM - fm) : wgm;
        u.pm = fm + ((wgid % nig) % gsz); u.pn = (wgid % nig) / gsz; return true;
    }
    __device__ __forceinline__ void a_ready(const Unit&) const {}
    __device__ __forceinline__ void done(const Unit&) const {}
};

typedef float f32x2_t __attribute__((ext_vector_type(2))); typedef __bf16 bf16x2_t __attribute__((ext_vector_type(2)));
__device__ __forceinline__ unsigned cvtpk(float lo, float hi) { f32x2_t v = {lo, hi}; bf16x2_t b = __builtin_convertvector(v, bf16x2_t); return __builtin_bit_cast(unsigned, b); }
__device__ __forceinline__ u32x4 pack8(const f32x4 a, const f32x4 b) { u32x4 w; w.x = cvtpk(a[0], a[1]); w.y = cvtpk(a[2], a[3]); w.z = cvtpk(b[0], b[1]); w.w = cvtpk(b[2], b[3]); return w; }
__device__ __forceinline__ float silu_f(float x) { return x * __builtin_amdgcn_rcpf(1.0f + __builtin_amdgcn_exp2f(-1.4426950408889634f * x)); }
__device__ __forceinline__ float sigmoid_f(float x) { return __builtin_amdgcn_rcpf(1.0f + __builtin_amdgcn_exp2f(-1.4426950408889634f * x)); }
constexpr float NORM_EPS = 1e-6f;
template <int NP> __device__ __forceinline__ void row_rstd8(float (&rs)[2][4], const float* ssq, int row0, int fq, float inv_n) {
#pragma unroll
    for (int ai = 0; ai < 2; ++ai)
#pragma unroll
        for (int m = 0; m < 4; ++m) { const int row = row0 + ai * HALF + m * 16; float s;
            if (NP == 16) { const f32x4 p = *(const f32x4*)(ssq + (size_t)row * 16 + 4 * fq); s = (p[0] + p[1]) + (p[2] + p[3]); } else { s = ssq[(size_t)row * 4 + fq]; }
            s += __shfl_xor(s, 16); s += __shfl_xor(s, 32); rs[ai][m] = __builtin_amdgcn_rsqf(s * inv_n + NORM_EPS); }
}
__device__ __forceinline__ float sq8(const f32x4 a, const f32x4 b) { return ((a[0] * a[0] + a[1] * a[1]) + (a[2] * a[2] + a[3] * a[3])) + ((b[0] * b[0] + b[1] * b[1]) + (b[2] * b[2] + b[3] * b[3])); }

__device__ __forceinline__ void epi_ids(int& wr, int& wc, int& fr, int& fq) { int t = threadIdx.x; asm volatile("" : "+v"(t)); const int wid = __builtin_amdgcn_readfirstlane(t >> 6); wr = wid >> 2; wc = wid & 3; fr = t & 15; fq = (t >> 4) & 3; }
struct EpiGateUp {
    static constexpr bool PERM = true, AFTER_DRAIN = false;
    bf16_t* H; const float* ssq; int ldh;
    __device__ __forceinline__ void operator()(const f32x4 (&acc)[2][2][4][2], const Unit& u, int wr_, int wc_, int fr_, int fq_) const {
        int wr, wc, fr, fq; epi_ids(wr, wc, fr, fq);
        const int row0 = u.pm * BM + wr * 64 + fr, col = u.pn * HALF + wc * 32 + 8 * fq;
        float rs[2][4]; row_rstd8<16>(rs, ssq, row0, fq, 1.0f / 1024.0f);
#pragma unroll
        for (int ai = 0; ai < 2; ++ai)
#pragma unroll
            for (int m = 0; m < 4; ++m) { const float r = rs[ai][m], rr = r * r, rn = r * -1.4426950408889634f; f32x4 h0, h1;
                const f32x4 g0 = acc[ai][0][m][0], g1 = acc[ai][0][m][1], p0 = (g0 * acc[ai][1][m][0]) * rr, p1 = (g1 * acc[ai][1][m][1]) * rr, e0 = g0 * rn, e1 = g1 * rn;
#pragma unroll
                for (int e = 0; e < 4; ++e) { h0[e] = p0[e] * __builtin_amdgcn_rcpf(1.0f + __builtin_amdgcn_exp2f(e0[e])); h1[e] = p1[e] * __builtin_amdgcn_rcpf(1.0f + __builtin_amdgcn_exp2f(e1[e])); }
                *(u32x4*)(H + (size_t)(row0 + ai * HALF + m * 16) * ldh + col) = pack8(h0, h1); }
    }
};
struct EpiNull {
    static constexpr bool PERM = true, AFTER_DRAIN = false;
    __device__ __forceinline__ void operator()(const f32x4 (&acc)[2][2][4][2], const Unit& u, int, int, int, int) const {
#pragma unroll
        for (int ai = 0; ai < 2; ++ai)
#pragma unroll
            for (int bj = 0; bj < 2; ++bj) asm volatile("" :: "v"(acc[ai][bj][0][0]), "v"(acc[ai][bj][0][1]), "v"(acc[ai][bj][1][0]), "v"(acc[ai][bj][1][1]), "v"(acc[ai][bj][2][0]), "v"(acc[ai][bj][2][1]), "v"(acc[ai][bj][3][0]), "v"(acc[ai][bj][3][1]));
    }
};
template <bool XBASE> struct EpiResidT {
    static constexpr bool PERM = true, AFTER_DRAIN = false;
    const float* xbase; bf16_t* hb; float* ssq; float alpha;
    __device__ __forceinline__ void operator()(const f32x4 (&acc)[2][2][4][2], const Unit& u, int wr_, int wc_, int fr_, int fq_) const {
        int wr, wc, fr, fq; epi_ids(wr, wc, fr, fq);
        const int row0 = u.pm * BM + wr * 64 + fr, col = u.pn * BM + wc * 32 + 8 * fq;
        if (XBASE) {
#pragma unroll
            for (int ai = 0; ai < 2; ++ai) { f32x4 bx[4][2][2];
#pragma unroll
                for (int m = 0; m < 4; ++m)
#pragma unroll
                    for (int bj = 0; bj < 2; ++bj) { const size_t off = (size_t)(row0 + ai * HALF + m * 16) * 1024 + col + bj * HALF; bx[m][bj][0] = *(const f32x4*)(xbase + off); bx[m][bj][1] = *(const f32x4*)(xbase + off + 4); }
#pragma unroll
                for (int m = 0; m < 4; ++m) { const size_t off = (size_t)(row0 + ai * HALF + m * 16) * 1024 + col; float s = 0.f;
#pragma unroll
                    for (int bj = 0; bj < 2; ++bj) { const f32x4 v0 = bx[m][bj][0] + alpha * acc[ai][bj][m][0], v1 = bx[m][bj][1] + alpha * acc[ai][bj][m][1]; *(u32x4*)(hb + off + bj * HALF) = pack8(v0, v1); s += sq8(v0, v1); }
                    s += __shfl_xor(s, 16); s += __shfl_xor(s, 32);
                    if (fq == 0) ssq[(size_t)(row0 + ai * HALF + m * 16) * 16 + u.pn * 4 + wc] = s; }
                asm volatile("" ::: "memory"); }
        } else {
            u32x4 bw[2][4][2];
#pragma unroll
            for (int ai = 0; ai < 2; ++ai)
#pragma unroll
                for (int m = 0; m < 4; ++m)
#pragma unroll
                    for (int bj = 0; bj < 2; ++bj) bw[ai][m][bj] = *(const u32x4*)(hb + (size_t)(row0 + ai * HALF + m * 16) * 1024 + col + bj * HALF);
#pragma unroll
            for (int ai = 0; ai < 2; ++ai)
#pragma unroll
                for (int m = 0; m < 4; ++m) { const size_t off = (size_t)(row0 + ai * HALF + m * 16) * 1024 + col; float s = 0.f;
#pragma unroll
                    for (int bj = 0; bj < 2; ++bj) { const u32x4 w = bw[ai][m][bj];
                        const f32x4 b0 = {__builtin_bit_cast(float, w.x << 16), __builtin_bit_cast(float, w.x & 0xffff0000u), __builtin_bit_cast(float, w.y << 16), __builtin_bit_cast(float, w.y & 0xffff0000u)};
                        const f32x4 b1 = {__builtin_bit_cast(float, w.z << 16), __builtin_bit_cast(float, w.z & 0xffff0000u), __builtin_bit_cast(float, w.w << 16), __builtin_bit_cast(float, w.w & 0xffff0000u)};
                        const f32x4 v0 = b0 + alpha * acc[ai][bj][m][0], v1 = b1 + alpha * acc[ai][bj][m][1]; *(u32x4*)(hb + off + bj * HALF) = pack8(v0, v1); s += sq8(v0, v1); }
                    s += __shfl_xor(s, 16); s += __shfl_xor(s, 32);
                    if (fq == 0) ssq[(size_t)(row0 + ai * HALF + m * 16) * 16 + u.pn * 4 + wc] = s; }
        }
    }
};
template <class E0> struct EpiTwice {
    static constexpr bool PERM = E0::PERM, AFTER_DRAIN = false; E0 e;
    __device__ __forceinline__ void operator()(const f32x4 (&acc)[2][2][4][2], const Unit& u, int a, int b, int c, int d) const { e(acc, u, a, b, c, d); asm volatile("" ::: "memory"); e(acc, u, a, b, c, d); }
};
struct EpiHyIn {
    static constexpr bool PERM = true, AFTER_DRAIN = false;
    bf16_t* U; const float* ssq; float* ssqq; float* ssqkv; float* kr; float* ga;
    __device__ __forceinline__ void operator()(const f32x4 (&acc)[2][2][4][2], const Unit& u, int wr_, int wc_, int fr_, int fq_) const {
        int wr, wc, fr, fq; epi_ids(wr, wc, fr, fq);
        const int row0 = u.pm * BM + wr * 64 + fr, col = u.pn * BM + wc * 32 + 8 * fq;
        float rs[2][4]; row_rstd8<16>(rs, ssq, row0, fq, 1.0f / 1024.0f);
#pragma unroll
        for (int ai = 0; ai < 2; ++ai)
#pragma unroll
            for (int m = 0; m < 4; ++m) { const int row = row0 + ai * HALF + m * 16; const float r = rs[ai][m];
                const f32x4 a0 = acc[ai][0][m][0] * r, a1 = acc[ai][0][m][1] * r, b0 = acc[ai][1][m][0] * r, b1 = acc[ai][1][m][1] * r;
                bf16_t* up = U + (size_t)row * 2048 + col;
                if (u.pn == 0) { *(u32x4*)up = pack8(a0, a1); *(u32x4*)(up + HALF) = pack8(b0, b1);
                    float s = sq8(a0, a1) + sq8(b0, b1); s += __shfl_xor(s, 16); s += __shfl_xor(s, 32); if (fq == 0) ssqq[(size_t)row * 4 + wc] = s; }
                else if (u.pn == 1) { *(u32x4*)up = pack8(a0, a1);
                    float s = sq8(a0, a1); s += __shfl_xor(s, 16); s += __shfl_xor(s, 32); if (fq == 0) ssqkv[(size_t)row * 4 + wc] = s;
                    if (wc == 0) { *(f32x4*)(kr + (size_t)row * 32 + 8 * fq) = b0; *(f32x4*)(kr + (size_t)row * 32 + 8 * fq + 4) = b1; }
                    else if (wc == 1 && fq < 2) { *(f32x4*)(ga + (size_t)row * 16 + 8 * fq) = b0; *(f32x4*)(ga + (size_t)row * 16 + 8 * fq + 4) = b1; } }
                else { *(u32x4*)up = pack8(a0, a1); *(u32x4*)(up + HALF) = pack8(b0, b1); } }
    }
};
struct EpiQup {
    static constexpr bool PERM = true, AFTER_DRAIN = false;
    bf16_t* QM; const float* ssqq; const float* rope; float c2;
    __device__ __forceinline__ void operator()(const f32x4 (&acc)[2][2][4][2], const Unit& u, int wr_, int wc_, int fr_, int fq_) const {
        int wr, wc, fr, fq; epi_ids(wr, wc, fr, fq);
        const int row0 = u.pm * BM + wr * 64 + fr;
        float rs[2][4]; row_rstd8<4>(rs, ssqq, row0, fq, 1.0f / 256.0f);
#pragma unroll
        for (int ai = 0; ai < 2; ++ai)
#pragma unroll
            for (int m = 0; m < 4; ++m) { const int row = row0 + ai * HALF + m * 16; const float r = rs[ai][m] * c2;
                const f32x4 a0 = acc[ai][0][m][0] * r, a1 = acc[ai][0][m][1] * r, b0 = acc[ai][1][m][0] * r, b1 = acc[ai][1][m][1] * r;
                bf16_t* qp = QM + (size_t)row * 768;
                if (u.pn < 2) { const int c0 = u.pn * BM + wc * 32 + 8 * fq, c1 = c0 + HALF;
                    *(u32x4*)(qp + (c0 >> 6) * 96 + (c0 & 63)) = pack8(a0, a1); *(u32x4*)(qp + (c1 >> 6) * 96 + (c1 & 63)) = pack8(b0, b1); }
                else { const int j0 = wc * 32 + 8 * fq, h = j0 >> 4, i0 = j0 & 15; const f32x4* cs = (const f32x4*)(rope + ((size_t)row * 16 + i0) * 2);
                    const f32x4 t0 = cs[0], t1 = cs[1], t2 = cs[2], t3 = cs[3];
                    const f32x4 cA = {t0[0], t0[2], t1[0], t1[2]}, sA = {t0[1], t0[3], t1[1], t1[3]}, cB = {t2[0], t2[2], t3[0], t3[2]}, sB = {t2[1], t2[3], t3[1], t3[3]};
                    const f32x4 y10 = a0 * cA - b0 * sA, y11 = a1 * cB - b1 * sB, y20 = b0 * cA + a0 * sA, y21 = b1 * cB + a1 * sB;
                    *(u32x4*)(qp + h * 96 + 64 + i0) = pack8(y10, y11); *(u32x4*)(qp + h * 96 + 80 + i0) = pack8(y20, y21); } }
    }
};
struct EpiKVup {
    static constexpr bool PERM = true, AFTER_DRAIN = false;
    bf16_t* KF; bf16_t* VM; const float* ssqkv;
    __device__ __forceinline__ void operator()(const f32x4 (&acc)[2][2][4][2], const Unit& u, int wr_, int wc_, int fr_, int fq_) const {
        int wr, wc, fr, fq; epi_ids(wr, wc, fr, fq);
        const int row0 = u.pm * BM + wr * 64 + fr, w = wc * 32 + 8 * fq;
        float rs[2][4]; row_rstd8<4>(rs, ssqkv, row0, fq, 1.0f / 128.0f);
#pragma unroll
        for (int ai = 0; ai < 2; ++ai)
#pragma unroll
            for (int m = 0; m < 4; ++m) { const int row = row0 + ai * HALF + m * 16; const float r = rs[ai][m];
#pragma unroll
                for (int bj = 0; bj < 2; ++bj) { const int h = 2 * u.pn + bj; const u32x4 v = pack8(acc[ai][bj][m][0] * r, acc[ai][bj][m][1] * r);
                    if (wc < 2) *(u32x4*)(KF + (size_t)row * 768 + h * 96 + w) = v; else *(u32x4*)(VM + (size_t)row * 512 + h * 64 + (w - 64)) = v; } }
    }
};
struct EpiNsaIn {
    static constexpr bool PERM = true, AFTER_DRAIN = false;
    bf16_t* QN; bf16_t* KV6;
    const float* ssq; const float* rope; float c2;
    __device__ __forceinline__ void operator()(const f32x4 (&acc)[2][2][4][2], const Unit& u, int wr_, int wc_, int fr_, int fq_) const {
        int wr, wc, fr, fq; epi_ids(wr, wc, fr, fq);
        const int row0 = u.pm * BM + wr * 64 + fr;
        float rs[2][4]; row_rstd8<16>(rs, ssq, row0, fq, 1.0f / 1024.0f);
        const bool is_rope = (u.pn < 4) || u.pn == 6 || u.pn == 8;
        if (is_rope) {
#pragma unroll
            for (int ai = 0; ai < 2; ++ai) { const int i0 = 8 * fq; f32x4 t[4][4];
#pragma unroll
                for (int m = 0; m < 4; ++m) { const f32x4* cs = (const f32x4*)(rope + ((size_t)(row0 + ai * HALF + m * 16) * 32 + i0) * 2); t[m][0] = cs[0]; t[m][1] = cs[1]; t[m][2] = cs[2]; t[m][3] = cs[3]; }
#pragma unroll
                for (int m = 0; m < 4; ++m) { const int row = row0 + ai * HALF + m * 16; const float r = rs[ai][m] * (u.pn < 4 ? c2 : 1.0f);
                    const f32x4 a0 = acc[ai][0][m][0] * r, a1 = acc[ai][0][m][1] * r, b0 = acc[ai][1][m][0] * r, b1 = acc[ai][1][m][1] * r;
                    const f32x4 t0 = t[m][0], t1 = t[m][1], t2 = t[m][2], t3 = t[m][3];
                    const f32x4 cA = {t0[0], t0[2], t1[0], t1[2]}, sA = {t0[1], t0[3], t1[1], t1[3]}, cB = {t2[0], t2[2], t3[0], t3[2]}, sB = {t2[1], t2[3], t3[1], t3[3]};
                    const f32x4 y10 = a0 * cA - b0 * sA, y11 = a1 * cB - b1 * sB, y20 = b0 * cA + a0 * sA, y21 = b1 * cB + a1 * sB;
                    bf16_t* dst = (u.pn < 4) ? QN + (size_t)row * 1024 + (4 * u.pn + wc) * 64 : KV6 + (size_t)(u.pn - 4) * ((size_t)32768 * 256) + (size_t)row * 256 + wc * 64;
                    *(u32x4*)(dst + i0) = pack8(y10, y11); *(u32x4*)(dst + 32 + i0) = pack8(y20, y21); } }
        } else {
#pragma unroll
            for (int ai = 0; ai < 2; ++ai)
#pragma unroll
                for (int m = 0; m < 4; ++m) { const int row = row0 + ai * HALF + m * 16; const float r = rs[ai][m];
                    const f32x4 a0 = acc[ai][0][m][0] * r, a1 = acc[ai][0][m][1] * r, b0 = acc[ai][1][m][0] * r, b1 = acc[ai][1][m][1] * r;
                    bf16_t* dst = KV6 + (size_t)(u.pn - 4) * ((size_t)32768 * 256) + (size_t)row * 256 + wc * 32 + 8 * fq;
                    *(u32x4*)dst = pack8(a0, a1); *(u32x4*)(dst + HALF) = pack8(b0, b1); } }
    }
};

template <class Epi, class Sched, bool ALIGN_EPI = false, bool SP2 = false>
__device__ __forceinline__ void gemm_phase(PG8_LAS unsigned char* lds, const Gemm g, const Sched& S, const Epi& E) {
    int tid_ = threadIdx.x; asm volatile("" : "+v"(tid_));
    const int tid = tid_, wid = __builtin_amdgcn_readfirstlane(tid >> 6), lane = tid & 63, wr = wid >> 2, wc = wid & 3, fr = lane & 15, fq = lane >> 4;
    const int K = g.K, nt = K / BK;
    unsigned voffA[2], voffB[2];
#pragma unroll
    for (int i = 0; i < 2; ++i) { int R, C; stage_rc(tid * 16 + i * 8192, R, C); const int Rb = Epi::PERM ? ((R & ~31) + perm32(R & 31)) : R;
        voffA[i] = (unsigned)(R * g.lda + C) * 2u; voffB[i] = (unsigned)(Rb * K + C) * 2u; }
    const size_t kstep = (size_t)(BK * 2);
    const size_t hstepA = (size_t)HALF * g.lda * 2, hstepB = (size_t)HALF * K * 2;
    const size_t tstepA = 2 * hstepA, tstepB = 2 * hstepB;
    const unsigned ldsw = (unsigned)wid * 1024u;
    const int aoff = lds_byte(wr * 64 + fr, fq * 8), boff = lds_byte(wc * 32 + fr, fq * 8);
#define PG8_SA(b, h) (((b) * 2 + (h)) * HTB)
#define PG8_SB(b, h) ((4 + (b) * 2 + (h)) * HTB)
#define PG8_STAGE(bufoff, gbase, voff) do { _Pragma("unroll") for (int _i = 0; _i < 2; ++_i) \
        __builtin_amdgcn_global_load_lds((const unsigned*)((const char*)(gbase) + (voff)[_i]), (PG8_LAS unsigned*)(lds + (bufoff) + ldsw + _i * 8192), 16, 0, 0); } while (0)
#define PG8_LDA(dst, b, h) do { _Pragma("unroll") for (int m = 0; m < 4; ++m) _Pragma("unroll") for (int k = 0; k < 2; ++k) dst[m][k] = *(const PG8_LAS bf16x8*)(lds + PG8_SA(b, h) + aoff + m * 2048 + k * 1024); } while (0)
#define PG8_LDB(dst, b, h) do { _Pragma("unroll") for (int n = 0; n < 2; ++n) _Pragma("unroll") for (int k = 0; k < 2; ++k) dst[n][k] = *(const PG8_LAS bf16x8*)(lds + PG8_SB(b, h) + boff + n * 2048 + k * 1024); } while (0)
#define PG8_MMA(ai, bj, At, Bt) do { __builtin_amdgcn_s_setprio(1); _Pragma("unroll") for (int m = 0; m < 4; ++m) _Pragma("unroll") for (int n = 0; n < 2; ++n) _Pragma("unroll") for (int k = 0; k < 2; ++k) \
        acc[ai][bj][m][n] = __builtin_amdgcn_mfma_f32_16x16x32_bf16(Bt[n][k], At[m][k], acc[ai][bj][m][n], 0, 0, 0); __builtin_amdgcn_s_setprio(0); } while (0)
#define PG8_WAIT_V(n) asm volatile("s_waitcnt vmcnt(" #n ")" ::: "memory")
#define PG8_WAIT_L(n) asm volatile("s_waitcnt lgkmcnt(" #n ")" ::: "memory")
#define PG8_BAR __builtin_amdgcn_s_barrier()
#define PG8_SCHED __builtin_amdgcn_sched_barrier(0)
    Unit cur, nxt; int ui = 0;
    if (!S.next(0, cur)) return;
    f32x4 acc[2][2][4][2];
#pragma unroll
    for (int a = 0; a < 2; ++a)
#pragma unroll
        for (int b = 0; b < 2; ++b)
#pragma unroll
            for (int m = 0; m < 4; ++m)
#pragma unroll
                for (int n = 0; n < 2; ++n) acc[a][b][m][n] = (f32x4){0.f, 0.f, 0.f, 0.f};
    bf16x8 At[4][2], B0[2][2], B1[2][2];
    const char* cA = (const char*)g.A + (size_t)cur.pm * tstepA; const char* cB = (const char*)g.Bt + (size_t)cur.pn * tstepB;
    S.a_ready(cur);
    if constexpr (SP2) {
        PG8_STAGE(PG8_SB(0, 0), cB, voffB); PG8_STAGE(PG8_SB(0, 1), cB + hstepB, voffB); PG8_STAGE(PG8_SA(0, 0), cA, voffA); PG8_STAGE(PG8_SA(0, 1), cA + hstepA, voffA);
        if (wr == 1) PG8_BAR;
        PG8_WAIT_V(2); PG8_BAR;
        PG8_STAGE(PG8_SB(1, 0), cB + kstep, voffB); PG8_STAGE(PG8_SA(1, 0), cA + kstep, voffA); PG8_STAGE(PG8_SB(1, 1), cB + hstepB + kstep, voffB);
        PG8_WAIT_V(6); PG8_BAR;
    } else {
        PG8_STAGE(PG8_SB(0, 0), cB, voffB); PG8_STAGE(PG8_SA(0, 0), cA, voffA); PG8_STAGE(PG8_SB(0, 1), cB + hstepB, voffB); PG8_STAGE(PG8_SA(0, 1), cA + hstepA, voffA);
        if (wr == 1) PG8_BAR;
        PG8_WAIT_V(4); PG8_BAR;
        PG8_STAGE(PG8_SB(1, 0), cB + kstep, voffB); PG8_STAGE(PG8_SA(1, 0), cA + kstep, voffA); PG8_STAGE(PG8_SB(1, 1), cB + hstepB + kstep, voffB);
        PG8_WAIT_V(6); PG8_BAR;
    }
    for (;;) {
        const bool has_next = S.next(ui + 1, nxt);
        const char* nA = has_next ? (const char*)g.A + (size_t)nxt.pm * tstepA : cA; const char* nB = has_next ? (const char*)g.Bt + (size_t)nxt.pn * tstepB : cB;
        for (int t = 0; t < nt; t += 2) {
            const bool last = (t == nt - 2);
            const char* a1 = cA + (size_t)(t + 1) * kstep;
            const char* a2 = last ? nA : cA + (size_t)(t + 2) * kstep; const char* b2 = last ? nB : cB + (size_t)(t + 2) * kstep;
            const char* a3 = a2 + kstep; const char* b3 = b2 + kstep;
            if (last && has_next) S.a_ready(nxt);
            if constexpr (SP2) {
            PG8_LDB(B0, 0, 0); PG8_LDB(B1, 0, 1); PG8_SCHED; PG8_LDA(At, 0, 0); PG8_STAGE(PG8_SA(1, 1), a1 + hstepA, voffA);
            PG8_WAIT_V(8); PG8_WAIT_L(0); PG8_BAR; PG8_MMA(0, 0, At, B0); PG8_MMA(0, 1, At, B1); PG8_BAR; PG8_SCHED;
            PG8_LDA(At, 0, 1); PG8_STAGE(PG8_SB(0, 0), b2, voffB); PG8_STAGE(PG8_SB(0, 1), b2 + hstepB, voffB); PG8_STAGE(PG8_SA(0, 0), a2, voffA);
            PG8_WAIT_V(8); PG8_WAIT_L(0); PG8_BAR; PG8_MMA(1, 0, At, B0); PG8_MMA(1, 1, At, B1); PG8_BAR; PG8_SCHED;
            PG8_LDB(B0, 1, 0); PG8_LDB(B1, 1, 1); PG8_SCHED; PG8_LDA(At, 1, 0); PG8_STAGE(PG8_SA(0, 1), a2 + hstepA, voffA);
            PG8_WAIT_V(8); PG8_WAIT_L(0); PG8_BAR; PG8_MMA(0, 0, At, B0); PG8_MMA(0, 1, At, B1); PG8_BAR; PG8_SCHED;
            PG8_LDA(At, 1, 1); PG8_STAGE(PG8_SB(1, 0), b3, voffB); PG8_STAGE(PG8_SB(1, 1), b3 + hstepB, voffB); PG8_STAGE(PG8_SA(1, 0), a3, voffA);
            PG8_WAIT_V(8); PG8_WAIT_L(0); PG8_BAR; PG8_MMA(1, 0, At, B0); PG8_MMA(1, 1, At, B1); PG8_BAR; PG8_SCHED;
            } else {
            PG8_LDB(B0, 0, 0); PG8_SCHED; PG8_LDA(At, 0, 0); PG8_STAGE(PG8_SA(1, 1), a1 + hstepA, voffA);
            PG8_WAIT_L(8); PG8_BAR; PG8_WAIT_L(0); PG8_MMA(0, 0, At, B0); PG8_BAR; PG8_SCHED;
            PG8_LDB(B1, 0, 1); PG8_STAGE(PG8_SB(0, 0), b2, voffB);
            PG8_BAR; PG8_WAIT_L(0); PG8_MMA(0, 1, At, B1); PG8_BAR;
            PG8_LDA(At, 0, 1); PG8_STAGE(PG8_SA(0, 0), a2, voffA);
            PG8_BAR; PG8_WAIT_L(0); PG8_MMA(1, 0, At, B0); PG8_BAR; PG8_SCHED;
            PG8_STAGE(PG8_SB(0, 1), b2 + hstepB, voffB);
            PG8_WAIT_V(6); PG8_BAR; PG8_MMA(1, 1, At, B1); PG8_BAR;
            PG8_LDB(B0, 1, 0); PG8_SCHED; PG8_LDA(At, 1, 0); PG8_STAGE(PG8_SA(0, 1), a2 + hstepA, voffA);
            PG8_WAIT_L(8); PG8_BAR; PG8_WAIT_L(0); PG8_MMA(0, 0, At, B0); PG8_BAR; PG8_SCHED;
            PG8_LDB(B1, 1, 1); PG8_STAGE(PG8_SB(1, 0), b3, voffB);
            PG8_BAR; PG8_WAIT_L(0); PG8_MMA(0, 1, At, B1); PG8_BAR;
            PG8_LDA(At, 1, 1); PG8_STAGE(PG8_SA(1, 0), a3, voffA);
            PG8_BAR; PG8_WAIT_L(0); PG8_MMA(1, 0, At, B0); PG8_BAR; PG8_SCHED;
            PG8_STAGE(PG8_SB(1, 1), b3 + hstepB, voffB);
            PG8_WAIT_V(6); PG8_BAR; PG8_MMA(1, 1, At, B1); PG8_BAR;
            }
        }
        if constexpr (ALIGN_EPI) { if (wr == 0) PG8_BAR; }
        if constexpr (!Epi::AFTER_DRAIN) { E(acc, cur, wr, wc, fr, fq); S.done(cur); }
        if (!has_next) break;
#pragma unroll
        for (int a = 0; a < 2; ++a)
#pragma unroll
            for (int b = 0; b < 2; ++b)
#pragma unroll
                for (int m = 0; m < 4; ++m)
#pragma unroll
                    for (int n = 0; n < 2; ++n) acc[a][b][m][n] = (f32x4){0.f, 0.f, 0.f, 0.f};
        cur = nxt; cA = nA; cB = nB; ++ui;
        if constexpr (ALIGN_EPI) { if (wr == 1) PG8_BAR; }
    }
    PG8_WAIT_V(0);
    if constexpr (!ALIGN_EPI) { if (wr == 0) PG8_BAR; }
    PG8_BAR;
    if constexpr (Epi::AFTER_DRAIN) { E.fused(acc, cur, wr, wc, fr, fq, lds, wid, lane); S.done(cur); }
#undef PG8_SA
#undef PG8_SB
#undef PG8_STAGE
#undef PG8_LDA
#undef PG8_LDB
#undef PG8_MMA
#undef PG8_WAIT_V
#undef PG8_WAIT_L
#undef PG8_BAR
#undef PG8_SCHED
}
}
namespace fa {
#define FA_LAS __attribute__((address_space(3)))
typedef unsigned short bf16_t;
typedef short bf16x8 __attribute__((ext_vector_type(8)));
typedef short s16x4 __attribute__((ext_vector_type(4)));
typedef float f32x16 __attribute__((ext_vector_type(16)));
typedef float f32x4 __attribute__((ext_vector_type(4)));
typedef unsigned u32x4 __attribute__((ext_vector_type(4)));
typedef short v4i16_t __attribute__((ext_vector_type(4)));
typedef FA_LAS const char* lds_cptr;
typedef FA_LAS char* lds_ptr;
#define FA_MFMA(a, b, c) __builtin_amdgcn_mfma_f32_32x32x16_bf16(a, b, c, 0, 0, 0)
#define FA_WAIT_BAR(N) asm volatile("s_waitcnt vmcnt(" #N ") lgkmcnt(0)\n\ts_barrier" ::: "memory")
__device__ __forceinline__ int crow(int r, int hi) { return (r & 3) + 8 * (r >> 2) + 4 * hi; }
__device__ __forceinline__ unsigned cvtpk(float lo, float hi) { return pg8::cvtpk(lo, hi); }
__device__ __forceinline__ void glds16(const void* g, unsigned lds_base) {
    unsigned sv; asm volatile("s_mov_b32 %0, m0\n\ts_mov_b32 m0, %2\n\ts_nop 0\n\tglobal_load_lds_dwordx4 %1, off\n\ts_mov_b32 m0, %0" : "=&s"(sv) : "v"(g), "s"(lds_base) : "memory"); }
__device__ __forceinline__ void glds16_coh(const void* g, unsigned lds_base) {
    unsigned sv; asm volatile("s_mov_b32 %0, m0\n\ts_mov_b32 m0, %2\n\ts_nop 0\n\tglobal_load_lds_dwordx4 %1, off sc1\n\ts_mov_b32 m0, %0" : "=&s"(sv) : "v"(g), "s"(lds_base) : "memory"); }
__device__ __forceinline__ s16x4 vtr(lds_cptr p) { return __builtin_bit_cast(s16x4, __builtin_amdgcn_ds_read_tr16_b64_v4i16((FA_LAS v4i16_t*)p)); }
__device__ __forceinline__ unsigned lds_addr(lds_cptr p) { return (unsigned)(uintptr_t)p; }
#define FA_MX3(a, b, c) __builtin_fmaxf(__builtin_fmaxf((a), (b)), (c))
__device__ __forceinline__ float swap_max(float m) { auto rr = __builtin_amdgcn_permlane32_swap(__float_as_uint(m), __float_as_uint(m), false, false); return __builtin_fmaxf(__uint_as_float(rr[0]), __uint_as_float(rr[1])); }
__device__ __forceinline__ float swap_sum(float m) { auto rr = __builtin_amdgcn_permlane32_swap(__float_as_uint(m), __float_as_uint(m), false, false); return __uint_as_float(rr[0]) + __uint_as_float(rr[1]); }
__device__ __forceinline__ float rowmax(const f32x16& p0, const f32x16& p1) {
    float a = FA_MX3(p0[0], p0[1], p1[0]), b = FA_MX3(p0[2], p0[3], p1[1]); a = FA_MX3(a, p1[2], p1[3]);
#pragma unroll
    for (int r = 4; r < 16; r += 4) { a = FA_MX3(a, p0[r], p0[r + 1]); b = FA_MX3(b, p0[r + 2], p0[r + 3]); a = FA_MX3(a, p1[r], p1[r + 1]); b = FA_MX3(b, p1[r + 2], p1[r + 3]); }
    return swap_max(__builtin_fmaxf(a, b)); }

template <int DK> __device__ __forceinline__ void dma_k(const bf16_t* ksrc, int kpitch, unsigned kslot, int wid, int lane) {
    glds16(ksrc + (size_t)lane * kpitch + wid * 8, (unsigned)__builtin_amdgcn_readfirstlane(kslot + wid * 1024));
    if (DK > 64) { const int c2 = (wid < DK / 8 - 8) ? wid + 8 : wid;
        glds16(ksrc + (size_t)lane * kpitch + c2 * 8, (unsigned)__builtin_amdgcn_readfirstlane(kslot + c2 * 1024)); }
}
__device__ __forceinline__ void dma_v(const bf16_t* vsrc, int vpitch, unsigned vslot, int wid, int lane) {
    glds16(vsrc + (size_t)(16 * (wid & 3) + (lane >> 2)) * vpitch + (wid >> 2) * 32 + (lane & 3) * 8, (unsigned)__builtin_amdgcn_readfirstlane(vslot + wid * 1024));
}
struct Run { float mref, l; f32x16 o0, o1, negm; bool started; };
__device__ __forceinline__ void run_init(Run& R) { R.mref = 0.f; R.l = 0.f; R.o0 = f32x16{}; R.o1 = f32x16{}; R.negm = f32x16{}; R.started = false; }
constexpr float FA_THR = 8.0f;
template <int DK> __device__ __forceinline__ void qkt(f32x16& p0, f32x16& p1, lds_cptr kslot, const bf16x8* qr, const f32x16& negm, int r32, int hi) {
    const lds_cptr kb = kslot + hi * 1024 + r32 * 16;
    bf16x8 kf[DK / 8];
#pragma unroll
    for (int d0 = 0; d0 < DK / 16; ++d0) { kf[2 * d0] = *(const FA_LAS bf16x8*)(kb + d0 * 2048); kf[2 * d0 + 1] = *(const FA_LAS bf16x8*)(kb + d0 * 2048 + 512); }
    __builtin_amdgcn_sched_barrier(0);
#pragma unroll
    for (int d0 = 0; d0 < DK / 16; ++d0) {
        if (d0 == 0) { p0 = FA_MFMA(kf[0], qr[0], negm); p1 = FA_MFMA(kf[1], qr[0], negm); } else { p0 = FA_MFMA(kf[2 * d0], qr[d0], p0); p1 = FA_MFMA(kf[2 * d0 + 1], qr[d0], p1); } }
}
__device__ __forceinline__ void mask_range(f32x16& p0, f32x16& p1, int kidx0, int klo, int khi, int hi) {
#pragma unroll
    for (int r = 0; r < 16; ++r) { const int k0 = kidx0 + (r & 3) + 8 * (r >> 2) + 4 * hi, k1 = k0 + 32;
        if (k0 < klo || k0 > khi) p0[r] = -INFINITY; if (k1 < klo || k1 > khi) p1[r] = -INFINITY; }
}
__device__ __forceinline__ void softmax_step(Run& R, f32x16& p0, f32x16& p1, FA_LAS float* wsf, int r32, int hi, bool rowok = true) {
    const bool first = !R.started; R.started = true;
    float rm = rowmax(p0, p1); rm = rowok ? rm : -INFINITY;
    if (first || __any(rm > FA_THR)) { const float dl = first ? __builtin_fmaxf(rm, -64.f) : __builtin_fmaxf(rm, 0.f); R.mref += dl;
#pragma unroll
        for (int r = 0; r < 16; ++r) { p0[r] -= dl; p1[r] -= dl; R.negm[r] = -R.mref; }
        if (!first) { const float f = __builtin_amdgcn_exp2f(-dl); R.l *= f; if (hi == 0) wsf[r32] = f;
            asm volatile("s_waitcnt lgkmcnt(0)" ::: "memory");
#pragma unroll
            for (int r = 0; r < 16; ++r) { const float fr_ = wsf[crow(r, hi)]; R.o0[r] *= fr_; R.o1[r] *= fr_; }
            asm volatile("s_waitcnt lgkmcnt(0)" ::: "memory"); } }
    float s0 = 0.f, s1 = 0.f, s2 = 0.f, s3 = 0.f;
#pragma unroll
    for (int r = 0; r < 16; r += 2) { p0[r] = __builtin_amdgcn_exp2f(p0[r]); p0[r + 1] = __builtin_amdgcn_exp2f(p0[r + 1]); p1[r] = __builtin_amdgcn_exp2f(p1[r]); p1[r + 1] = __builtin_amdgcn_exp2f(p1[r + 1]);
        s0 += p0[r]; s1 += p0[r + 1]; s2 += p1[r]; s3 += p1[r + 1]; }
    const float st = (s0 + s1) + (s2 + s3); R.l += rowok ? st : 0.f;
}
__device__ __forceinline__ void pack_p(u32x4 (&pw)[4], const f32x16& p0, const f32x16& p1) {
    pw[0] = (u32x4){cvtpk(p0[0], p0[1]), cvtpk(p0[2], p0[3]), cvtpk(p0[4], p0[5]), cvtpk(p0[6], p0[7])};
    pw[1] = (u32x4){cvtpk(p0[8], p0[9]), cvtpk(p0[10], p0[11]), cvtpk(p0[12], p0[13]), cvtpk(p0[14], p0[15])};
    pw[2] = (u32x4){cvtpk(p1[0], p1[1]), cvtpk(p1[2], p1[3]), cvtpk(p1[4], p1[5]), cvtpk(p1[6], p1[7])};
    pw[3] = (u32x4){cvtpk(p1[8], p1[9]), cvtpk(p1[10], p1[11]), cvtpk(p1[12], p1[13]), cvtpk(p1[14], p1[15])};
}
__device__ __forceinline__ void pv_pw(f32x16& o0, f32x16& o1, const u32x4 (&pw)[4], lds_cptr vslot, int lane, int hi) {
    const lds_cptr vp = vslot + ((lane >> 4) & 1) * 32 + (lane & 3) * 8 + (4 * hi + ((lane & 15) >> 2)) * 64;
    s16x4 vl0[4], vh0[4], vl1[4], vh1[4];
#pragma unroll
    for (int ks = 0; ks < 4; ++ks) { vl0[ks] = vtr(vp + ks * 1024); vh0[ks] = vtr(vp + ks * 1024 + 512); vl1[ks] = vtr(vp + 4096 + ks * 1024); vh1[ks] = vtr(vp + 4096 + ks * 1024 + 512); }
    __builtin_amdgcn_sched_barrier(0);
#pragma unroll
    for (int ks = 0; ks < 4; ++ks) { const bf16x8 pa = __builtin_bit_cast(bf16x8, pw[ks]);
        o0 = FA_MFMA(pa, ((bf16x8){vl0[ks][0], vl0[ks][1], vl0[ks][2], vl0[ks][3], vh0[ks][0], vh0[ks][1], vh0[ks][2], vh0[ks][3]}), o0);
        o1 = FA_MFMA(pa, ((bf16x8){vl1[ks][0], vl1[ks][1], vl1[ks][2], vl1[ks][3], vh1[ks][0], vh1[ks][1], vh1[ks][2], vh1[ks][3]}), o1); }
}
struct VFrag { s16x4 l0[4], h0[4], l1[4], h1[4]; };
__device__ __forceinline__ void v_load(VFrag& v, lds_cptr vslot, int lane, int hi) {
    const lds_cptr vp = vslot + ((lane >> 4) & 1) * 32 + (lane & 3) * 8 + (4 * hi + ((lane & 15) >> 2)) * 64;
#pragma unroll
    for (int ks = 0; ks < 4; ++ks) { v.l0[ks] = vtr(vp + ks * 1024); v.h0[ks] = vtr(vp + ks * 1024 + 512); v.l1[ks] = vtr(vp + 4096 + ks * 1024); v.h1[ks] = vtr(vp + 4096 + ks * 1024 + 512); }
}
__device__ __forceinline__ void pv_frag(f32x16& o0, f32x16& o1, const u32x4 (&pw)[4], const VFrag& v) {
#pragma unroll
    for (int ks = 0; ks < 4; ++ks) { const bf16x8 pa = __builtin_bit_cast(bf16x8, pw[ks]);
        o0 = FA_MFMA(pa, ((bf16x8){v.l0[ks][0], v.l0[ks][1], v.l0[ks][2], v.l0[ks][3], v.h0[ks][0], v.h0[ks][1], v.h0[ks][2], v.h0[ks][3]}), o0);
        o1 = FA_MFMA(pa, ((bf16x8){v.l1[ks][0], v.l1[ks][1], v.l1[ks][2], v.l1[ks][3], v.h1[ks][0], v.h1[ks][1], v.h1[ks][2], v.h1[ks][3]}), o1); }
}
__device__ __forceinline__ void pv(f32x16& o0, f32x16& o1, const f32x16& p0, const f32x16& p1, lds_cptr vslot, int lane, int hi, bool rowok = true) {
    u32x4 pw[4]; pack_p(pw, p0, p1);
#pragma unroll
    for (int k = 0; k < 4; ++k) { pw[k].x = rowok ? pw[k].x : 0u; pw[k].y = rowok ? pw[k].y : 0u; pw[k].z = rowok ? pw[k].z : 0u; pw[k].w = rowok ? pw[k].w : 0u; }
    const lds_cptr vp = vslot + ((lane >> 4) & 1) * 32 + (lane & 3) * 8 + (4 * hi + ((lane & 15) >> 2)) * 64;
#pragma unroll
    for (int ks = 0; ks < 4; ++ks) {
        const s16x4 l0 = vtr(vp + ks * 1024), h0 = vtr(vp + ks * 1024 + 512), l1 = vtr(vp + 4096 + ks * 1024), h1 = vtr(vp + 4096 + ks * 1024 + 512);
        const bf16x8 pa = __builtin_bit_cast(bf16x8, pw[ks]);
        o0 = FA_MFMA(pa, ((bf16x8){l0[0], l0[1], l0[2], l0[3], h0[0], h0[1], h0[2], h0[3]}), o0);
        o1 = FA_MFMA(pa, ((bf16x8){l1[0], l1[1], l1[2], l1[3], h1[0], h1[1], h1[2], h1[3]}), o1); }
}
__device__ __forceinline__ void run_finish(Run& R, float (&rli)[16], FA_LAS float* wsf, int r32, int hi) {
    const float lt = swap_sum(R.l);
    asm volatile("s_waitcnt lgkmcnt(0)" ::: "memory");
    if (hi == 0) wsf[32 + r32] = lt;
    asm volatile("s_waitcnt lgkmcnt(0)" ::: "memory");
#pragma unroll
    for (int r = 0; r < 16; ++r) rli[r] = 1.0f / __builtin_fmaxf(wsf[32 + crow(r, hi)], 1e-30f);
    asm volatile("s_waitcnt lgkmcnt(0)" ::: "memory");
}
}
constexpr int NWAVES = 8;
constexpr int BATCH = 8, SEQ = 4096, MROWS = BATCH * SEQ, DM = 1024, FF = 2816;
constexpr int HYN = 2048, NSAN = 2560;
constexpr float LOG2E = 1.4426950408889634f;
constexpr size_t MiB = 1u << 20;
constexpr size_t WS_CTL = 0, CTL_ZERO_BYTES = 64 * 1024;
constexpr size_t WS_WGU = 2 * MiB;
constexpr size_t WS_WD = 46 * MiB;
constexpr size_t WS_WIN0 = 68 * MiB;
constexpr size_t WS_WUQ = 72 * MiB;
constexpr size_t WS_WUKV = 72 * MiB + 512 * 1024;
constexpr size_t WS_WOUT0 = 73 * MiB;
constexpr size_t WS_WIN1 = 75 * MiB;
constexpr size_t WS_WOUT1 = 81 * MiB;
constexpr size_t WS_CW1 = 83 * MiB;
constexpr size_t WS_WGT = 80 * MiB + 512 * 1024;
constexpr size_t WS_CW2 = 80 * MiB + 768 * 1024;
constexpr size_t WS_ROPE0 = 84 * MiB;
constexpr size_t WS_ROPE1 = 88 * MiB;
constexpr size_t WS_SSQ = 96 * MiB;
constexpr size_t WS_SSQQ = 98 * MiB;
constexpr size_t WS_SSQKV = 98 * MiB + 512 * 1024;
constexpr size_t WS_KR = 99 * MiB;
constexpr size_t WS_GA = 103 * MiB;
constexpr size_t WS_BIAS1 = 105 * MiB;
constexpr size_t WS_GT = 106 * MiB;
constexpr size_t WS_DEC = 112 * MiB;
constexpr size_t WS_KCMP = 113 * MiB, WS_VCMP = 114 * MiB;
constexpr size_t WS_HB = 116 * MiB;
constexpr size_t WS_BIG = 180 * MiB;
constexpr size_t WS_HID = WS_BIG;
constexpr size_t WS_U0 = WS_BIG;
constexpr size_t WS_QM = 308 * MiB;
constexpr size_t WS_KF = 356 * MiB;
constexpr size_t WS_VM = 404 * MiB;
constexpr size_t WS_O0 = 436 * MiB;
constexpr size_t WS_QN = WS_BIG;
constexpr size_t WS_KV6 = 244 * MiB;
constexpr size_t WS_O1 = 340 * MiB;
constexpr size_t WS_END = 500 * MiB;
constexpr int CW_TMO = 0;
constexpr int CW_BAR = 4096;
constexpr int CW_Q0 = 8192, CW_Q1 = 8192 + 4096;
constexpr int RING_OFF = 0, RING_BYTES = 151552;
constexpr int LDSCTL_OFF = RING_BYTES, MISC_OFF = LDSCTL_OFF + 320;
constexpr int LDS_BYTES = 155648;
static_assert(MISC_OFF + 128 <= LDS_BYTES, "LDS map");

#define GAS __attribute__((address_space(1)))
#define LAS __attribute__((address_space(3)))
typedef unsigned short bf16;
typedef unsigned v4u __attribute__((ext_vector_type(4)));
typedef float f32x4 __attribute__((ext_vector_type(4)));
typedef float f32x2 __attribute__((ext_vector_type(2)));
typedef float f32x16 __attribute__((ext_vector_type(16)));
typedef short bf16x8 __attribute__((ext_vector_type(8)));
typedef GAS unsigned gu32;
#define RLX_AGENT __ATOMIC_RELAXED, __HIP_MEMORY_SCOPE_AGENT
#define LDS_WAIT() asm volatile("s_waitcnt lgkmcnt(0)" ::: "memory")
#define VM_WAIT() asm volatile("s_waitcnt vmcnt(0)" ::: "memory")
__device__ __forceinline__ unsigned f2bf(float f) { unsigned u = __builtin_bit_cast(unsigned, f); return (u + 0x7fffu + ((u >> 16) & 1u)) >> 16; }
__device__ __forceinline__ unsigned pk2(float lo, float hi) { return f2bf(lo) | (f2bf(hi) << 16); }
__device__ __forceinline__ float bf2f(unsigned short b) { return __builtin_bit_cast(float, (unsigned)b << 16); }

#define XB_TMO      128
#define XB_XCNT(j)  (256  + 64 * (j))
#define XB_XSUB(j)  (1280 + 64 * (j))
#define XB_XGEN(j)  (2304 + 64 * (j))
#define XB_TOP      3328
#define XB_TOPGEN   3392
#define XCD_BAR_WORDS 3456
#define XB_SPIN_CAP (1u << 18)
__device__ __forceinline__ unsigned xb_ld(unsigned* p)              { return __hip_atomic_load(p, __ATOMIC_RELAXED, __HIP_MEMORY_SCOPE_AGENT); }
__device__ __forceinline__ unsigned xb_add(unsigned* p, unsigned v) { return __hip_atomic_fetch_add(p, v, __ATOMIC_RELAXED, __HIP_MEMORY_SCOPE_AGENT); }
__device__ __forceinline__ unsigned xb_xcc_id() { return (unsigned)__builtin_amdgcn_s_getreg((3 << 11) | 20) & 0xFu; }
#define XB_SPIN(cond, bar) do { unsigned _sp = 0; while (cond) { __builtin_amdgcn_s_sleep(1); \
    if ((++_sp & 255u) == 0u) { if (xb_ld(&(bar)[XB_TMO])) break; if (_sp > XB_SPIN_CAP) { atomicAdd(&(bar)[XB_TMO], 1u); break; } } } } while (0)
struct XcdBarrier { unsigned* bar; unsigned x; volatile LAS unsigned* st; };
__device__ __forceinline__ XcdBarrier xcd_barrier_post(unsigned* bar, volatile LAS unsigned* st) {
    XcdBarrier b; b.bar = bar; b.x = xb_xcc_id(); b.st = st;
    if (threadIdx.x == 0) (void)xb_add(&bar[XB_XCNT(b.x)], 1u);
    return b;
}
__device__ __forceinline__ void xcd_barrier_complete(unsigned* bar, unsigned x, unsigned& nloc, unsigned& nx) {
    const unsigned G = gridDim.x * gridDim.y * gridDim.z;
    unsigned sum, cnt, mine, sp = 0u;
    for (;;) {
        sum = 0u; cnt = 0u; mine = 0u;
#pragma unroll
        for (unsigned j = 0; j < 16; ++j) { const unsigned c = xb_ld(&bar[XB_XCNT(j)]); sum += c; cnt += (c > 0u) ? 1u : 0u; mine = (j == x) ? c : mine; }
        if (sum == G) break;
        __builtin_amdgcn_s_sleep(1);
        if ((++sp & 255u) == 0u) { if (xb_ld(&bar[XB_TMO])) break; if (sp > XB_SPIN_CAP) { atomicAdd(&bar[XB_TMO], 1u); break; } }
    }
    nloc = mine > 0u ? mine : 1u; nx = cnt > 0u ? cnt : 1u;
}
__device__ __forceinline__ void xcd_barrier(const XcdBarrier& b) {
    asm volatile("s_waitcnt vmcnt(0)" ::: "memory");
    __syncthreads();
    if (threadIdx.x == 0) {
        unsigned* bar = b.bar;
        __builtin_amdgcn_s_waitcnt(0);
        unsigned nloc = b.st[0], nx = b.st[1];
        if (nloc == 0u) { xcd_barrier_complete(bar, b.x, nloc, nx); b.st[0] = nloc; b.st[1] = nx; }
        const unsigned old = xb_add(&bar[XB_XSUB(b.x)], 1u);
        const unsigned gen = old / nloc;
        if (old + 1u == (gen + 1u) * nloc) {
            __builtin_amdgcn_fence(__ATOMIC_RELEASE, "agent");
            asm volatile("s_waitcnt vmcnt(0)" ::: "memory");
            const unsigned og = xb_add(&bar[XB_TOP], 1u);
            const unsigned tg = og / nx;
            if (og + 1u == (tg + 1u) * nx) xb_add(&bar[XB_TOPGEN], 1u);
            else XB_SPIN(xb_ld(&bar[XB_TOPGEN]) == tg, bar);
            __builtin_amdgcn_fence(__ATOMIC_ACQUIRE, "agent");
            xb_add(&bar[XB_XGEN(b.x)], 1u);
            asm volatile("s_waitcnt vmcnt(0)" ::: "memory");
        } else {
            XB_SPIN(xb_ld(&bar[XB_XGEN(b.x)]) == gen, bar);
            __builtin_amdgcn_fence(__ATOMIC_ACQUIRE, "agent");
            asm volatile("s_waitcnt vmcnt(0)" ::: "memory");
        }
    }
    __syncthreads();
}

struct Frame {
    LAS unsigned char* lds;
    volatile LAS unsigned* MISC;
    gu32* ctl;
    int vcu, G;
    unsigned char* ws;
    unsigned long long tpacc, tpacc2, tpacc3;
};
__device__ __forceinline__ int opaque_tid() { int t = threadIdx.x; asm volatile("" : "+v"(t)); return t; }
__device__ __forceinline__ float wave_sum(float v) {
#pragma unroll
    for (int o = 1; o < 64; o <<= 1) v += __shfl_xor(v, o);
    return v;
}
__device__ __forceinline__ unsigned wq_issue(Frame& F, int word) {
    unsigned v = 0u; if (threadIdx.x == 0) v = __hip_atomic_fetch_add((unsigned*)(F.ctl + word), 1u, __ATOMIC_RELAXED, __HIP_MEMORY_SCOPE_AGENT); return v; }
__device__ __forceinline__ int wq_collect(Frame& F, unsigned ticket) {
    if (threadIdx.x == 0) F.MISC[0] = ticket;
    __syncthreads(); const int v = (int)F.MISC[0]; __syncthreads(); return v; }
__device__ __forceinline__ int wq_next(Frame& F, int word) {
    if (threadIdx.x == 0) F.MISC[0] = __hip_atomic_fetch_add((unsigned*)(F.ctl + word), 1u, __ATOMIC_RELAXED, __HIP_MEMORY_SCOPE_AGENT);
    __syncthreads(); const int v = (int)F.MISC[0]; __syncthreads(); return v;
}
struct Inputs {
    const float* x; const int* pos; const float* ffn_norm; const float* w_gate; const float* w_up; const float* w_down; const float* mix_norm;
    const float* hy_w_in; const float* q_norm; const float* w_uq; const float* kv_norm; const float* w_ukv; const float* w_a2; const float* b_a; const float* gla_norm; const float* hy_w_out;
    const float* nsa_w_in; const float* pos_k; const float* pos_v; const float* ck_w1; const float* ck_w2; const float* cv_w1; const float* cv_w2; const float* nsa_w_out; const float* final_norm;
};
struct ColSrc { const float* p; int ldn; };
__device__ __forceinline__ ColSrc map_gateup(const float* wg, const float* wu, int n) { const int T = n >> 8, j = n & 255; ColSrc c; c.ldn = FF; c.p = (j < 128) ? wg + T * 128 + j : wu + T * 128 + (j - 128); return c; }
__device__ __forceinline__ ColSrc map_ident(const float* w, int ldn, int n) { ColSrc c; c.ldn = ldn; c.p = w + n; return c; }
__device__ __forceinline__ ColSrc map_hyin(const float* w, int n) {
    ColSrc c; c.ldn = 1968; int s;
    if (n < 256) s = n; else if (n < 384) s = n; else if (n < 416) s = 384 + (n - 384); else if (n < 432) s = 1440 + (n - 416); else if (n < 512) s = -1;
    else if (n < 1024) s = 416 + (n - 512); else if (n < 1536) s = 928 + (n - 1024); else s = 1456 + (n - 1536);
    c.p = (s < 0) ? nullptr : w + s; return c; }
__device__ __forceinline__ ColSrc map_wuq(const float* w, int n) {
    ColSrc c; c.ldn = 768; int s;
    if (n < 512) s = (n >> 6) * 96 + (n & 63); else if (n < 640) { const int j = n - 512; s = (j >> 4) * 96 + 64 + (j & 15); } else { const int j = n - 640; s = (j >> 4) * 96 + 80 + (j & 15); }
    c.p = w + s; return c; }
__device__ __forceinline__ ColSrc map_nsain(const float* w, int n) {
    ColSrc c; c.ldn = 2608; const int T = n >> 8, j = n & 255; int s;
    if (T < 4) { const int hh = (j & 127) >> 5, i = j & 31; s = (4 * T + hh) * 64 + (j >> 7) * 32 + i; }
    else if (T == 6 || T == 8) { const int g = (j & 127) >> 5, i = j & 31; s = 1024 + (T - 4) * 256 + g * 64 + (j >> 7) * 32 + i; }
    else s = 1024 + (T - 4) * 256 + j;
    c.p = (s < 0) ? nullptr : w + s; return c; }
__device__ __forceinline__ ColSrc map_gates(const float* w, int n) { ColSrc c; c.ldn = 2608; c.p = (n < 48) ? w + 2560 + n : nullptr; return c; }
template <class Map> __device__ __forceinline__ void p0_item(const Map& mp, int K, bf16* WT, const float* gain, LAS float* scr, int kb, int nb, int lane) {
    const int k0 = 64 * kb, n0 = 64 * nb; const ColSrc cs = mp(n0 + lane);
    float v[64];
#pragma unroll
    for (int i = 0; i < 64; ++i) v[i] = cs.p ? cs.p[(size_t)(k0 + i) * cs.ldn] : 0.f;
#pragma unroll
    for (int i = 0; i < 64; ++i) scr[i * 65 + lane] = gain ? v[i] * gain[k0 + i] : v[i];
    LDS_WAIT(); asm volatile("" ::: "memory");
    const int c = lane & 7;
#pragma unroll
    for (int j = 0; j < 8; ++j) { const int n = (lane >> 3) + 8 * j; const LAS float* s = scr + (8 * c) * 65 + n;
        v4u o; o.x = pk2(s[0 * 65], s[1 * 65]); o.y = pk2(s[2 * 65], s[3 * 65]); o.z = pk2(s[4 * 65], s[5 * 65]); o.w = pk2(s[6 * 65], s[7 * 65]);
        *(GAS v4u*)(WT + (size_t)(n0 + n) * K + k0 + 8 * c) = o; }
    LDS_WAIT(); asm volatile("" ::: "memory");
}
__device__ __forceinline__ void sincos_d(double x, float& sn, float& cs) {
    const double k = rint(x * 0.63661977236758134308); double r = fma(-k, 1.57079632679489655800, x); r = fma(-k, 6.12323399573676603587e-17, r);
    const double r2 = r * r;
    double s = -7.6471637318198164759e-13; s = s * r2 + 1.6059043836821614599e-10; s = s * r2 - 2.5052108385441718775e-08; s = s * r2 + 2.7557319223985890653e-06; s = s * r2 - 1.9841269841269841270e-04; s = s * r2 + 8.3333333333333333333e-03; s = s * r2 - 1.6666666666666666667e-01; s = r + r * r2 * s;
    double c = 4.7794773323873852974e-14; c = c * r2 - 1.1470745597729724714e-11; c = c * r2 + 2.0876756987868098979e-09; c = c * r2 - 2.7557319223985890653e-07; c = c * r2 + 2.4801587301587301587e-05; c = c * r2 - 1.3888888888888888889e-03; c = c * r2 + 4.1666666666666666667e-02; c = c * r2 - 0.5; c = 1.0 + r2 * c;
    const int q = ((int)k) & 3; const double ss = (q == 0) ? s : (q == 1) ? c : (q == 2) ? -s : -c, cc = (q == 0) ? c : (q == 1) ? -s : (q == 2) ? -c : s;
    sn = (float)ss; cs = (float)cc;
}
struct RopeFreq { double f16[16]; double f32[32]; };
__device__ __forceinline__ void p0_prologue(Frame& F, const Inputs& I, const RopeFreq& RF) {
    const int tid = opaque_tid(), lane = tid & 63, wave = __builtin_amdgcn_readfirstlane(tid >> 6);
    LAS float* scr = (LAS float*)(F.lds + RING_OFF + wave * 16896);
    const int gw = F.vcu * NWAVES + wave, NGW = F.G * NWAVES;
    unsigned char* ws = F.ws;
    constexpr int I_GU = 16 * 88, I_DN = 44 * 16, I_IN0 = 16 * 32, I_UQ = 16 * 24, I_UKV = 8 * 32, I_OUT = 16 * 16, I_IN1 = 16 * 40, I_CW = 32 * 4, I_GT = 64, I_CW2 = 32;
    constexpr int NITEMS = 4 * I_GU + 4 * I_DN + I_IN0 + I_UQ + I_UKV + I_OUT + I_IN1 + I_OUT + 2 * I_CW + I_GT + I_CW2;
    for (int it = gw; it < NITEMS; it += NGW) {
        int r = it;
        if (r < 4 * I_GU) { const int f = r / I_GU; r -= f * I_GU; const float* wg = I.w_gate + (size_t)f * DM * FF; const float* wu = I.w_up + (size_t)f * DM * FF;
            auto mp = [&](int n) { return map_gateup(wg, wu, n); }; p0_item(mp, DM, (bf16*)(ws + WS_WGU) + (size_t)f * 5632 * DM, I.ffn_norm + f * DM, scr, r / 88, r % 88, lane); continue; } r -= 4 * I_GU;
        if (r < 4 * I_DN) { const int f = r / I_DN; r -= f * I_DN; const float* w = I.w_down + (size_t)f * FF * DM;
            auto mp = [&](int n) { return map_ident(w, DM, n); }; p0_item(mp, FF, (bf16*)(ws + WS_WD) + (size_t)f * DM * FF, nullptr, scr, r / 16, r % 16, lane); continue; } r -= 4 * I_DN;
        if (r < I_IN0) { auto mp = [&](int n) { return map_hyin(I.hy_w_in, n); }; p0_item(mp, DM, (bf16*)(ws + WS_WIN0), I.mix_norm, scr, r / 32, r % 32, lane); continue; } r -= I_IN0;
        if (r < I_UQ) { const int ks = r / 24, nblk = r % 24, r32 = lane & 31, hi = lane >> 5;
            const int col = (nblk < 16) ? ((32 * nblk + r32) >> 6) * 96 + ((32 * nblk + r32) & 63) : (2 * ((nblk - 16) & 3) + (r32 >> 4)) * 96 + (nblk < 20 ? 64 : 80) + (r32 & 15);
            float v[8];
#pragma unroll
            for (int j = 0; j < 8; ++j) { const int k = 16 * ks + 8 * hi + j; v[j] = I.w_uq[(size_t)k * 768 + col] * I.q_norm[k]; }
            v4u o; o.x = pk2(v[0], v[1]); o.y = pk2(v[2], v[3]); o.z = pk2(v[4], v[5]); o.w = pk2(v[6], v[7]); *(v4u*)((bf16*)(ws + WS_WUQ) + (size_t)r * 512 + lane * 8) = o; continue; } r -= I_UQ;
        if (r < I_UKV) { const int ks = r / 32, nblk = r % 32, r32 = lane & 31, hi = lane >> 5;
            float v[8];
#pragma unroll
            for (int j = 0; j < 8; ++j) { const int k = 16 * ks + 8 * hi + j; v[j] = I.w_ukv[(size_t)k * 1024 + 32 * nblk + r32] * I.kv_norm[k]; }
            v4u o; o.x = pk2(v[0], v[1]); o.y = pk2(v[2], v[3]); o.z = pk2(v[4], v[5]); o.w = pk2(v[6], v[7]); *(v4u*)((bf16*)(ws + WS_WUKV) + (size_t)r * 512 + lane * 8) = o; continue; } r -= I_UKV;
        if (r < I_OUT) { auto mp = [&](int n) { return map_ident(I.hy_w_out, DM, n); }; p0_item(mp, DM, (bf16*)(ws + WS_WOUT0), nullptr, scr, r / 16, r % 16, lane); continue; } r -= I_OUT;
        if (r < I_IN1) { auto mp = [&](int n) { return map_nsain(I.nsa_w_in, n); }; p0_item(mp, DM, (bf16*)(ws + WS_WIN1), I.mix_norm + DM, scr, r / 40, r % 40, lane); continue; } r -= I_IN1;
        if (r < I_OUT) { auto mp = [&](int n) { return map_ident(I.nsa_w_out, DM, n); }; p0_item(mp, DM, (bf16*)(ws + WS_WOUT1), nullptr, scr, r / 16, r % 16, lane); continue; } r -= I_OUT;
        if (r < 2 * I_CW) { const int kv = r / I_CW; r -= kv * I_CW; const float* w = kv ? I.cv_w1 : I.ck_w1;
            const int r32 = lane & 31, hi = lane >> 5; const float* wp = w + (size_t)(r * 16 + 8 * hi) * 128 + r32; bf16* dst = (bf16*)(ws + WS_CW1) + (size_t)kv * 262144 + (size_t)r * 2048 + lane * 8;
            float v[4][8];
#pragma unroll
            for (int q = 0; q < 4; ++q)
#pragma unroll
                for (int j = 0; j < 8; ++j) v[q][j] = wp[(size_t)j * 128 + 32 * q];
#pragma unroll
            for (int q = 0; q < 4; ++q) { v4u o; o.x = pk2(v[q][0], v[q][1]); o.y = pk2(v[q][2], v[q][3]); o.z = pk2(v[q][4], v[q][5]); o.w = pk2(v[q][6], v[q][7]); *(v4u*)(dst + q * 512) = o; }
            continue; } r -= 2 * I_CW;
        if (r >= I_GT) { r -= I_GT; const int kv = r >> 4, ks = (r >> 1) & 7, nblk = r & 1, r32 = lane & 31, hi = lane >> 5; const float* w2 = kv ? I.cv_w2 : I.ck_w2;
            float v[8];
#pragma unroll
            for (int j = 0; j < 8; ++j) v[j] = w2[(size_t)(16 * ks + 8 * hi + j) * 64 + 32 * nblk + r32];
            v4u o; o.x = pk2(v[0], v[1]); o.y = pk2(v[2], v[3]); o.z = pk2(v[4], v[5]); o.w = pk2(v[6], v[7]); *(v4u*)((bf16*)(ws + WS_CW2) + (size_t)r * 512 + lane * 8) = o; continue; }
        { const int r32 = lane & 31, hi = lane >> 5; const float* gm = I.mix_norm + DM;
            bf16* dst = (bf16*)(ws + WS_WGT) + (size_t)r * 1024 + lane * 8;
#pragma unroll
            for (int q = 0; q < 2; ++q) { float v[8]; const int n = 32 * q + r32;
#pragma unroll
                for (int j = 0; j < 8; ++j) { const int k = 16 * r + 8 * hi + j; v[j] = (n < 48) ? I.nsa_w_in[(size_t)k * 2608 + 2560 + n] * gm[k] : 0.f; }
                v4u o; o.x = pk2(v[0], v[1]); o.y = pk2(v[2], v[3]); o.z = pk2(v[4], v[5]); o.w = pk2(v[6], v[7]); *(v4u*)(dst + q * 512) = o; } }
    }
    bf16* hb = (bf16*)(ws + WS_HB); float* ssq = (float*)(ws + WS_SSQ);
    for (int m0 = 4 * gw; m0 < MROWS; m0 += 4 * NGW) {
        f32x4 v[4][4];
#pragma unroll
        for (int q = 0; q < 4; ++q) { const GAS f32x4* xr = (const GAS f32x4*)(I.x + (size_t)(m0 + q) * DM) + lane;
#pragma unroll
            for (int j = 0; j < 4; ++j) v[q][j] = xr[64 * j]; }
#pragma unroll
        for (int q = 0; q < 4; ++q) { float s = 0.f;
#pragma unroll
            for (int j = 0; j < 4; ++j) s += (v[q][j][0] * v[q][j][0] + v[q][j][1] * v[q][j][1]) + (v[q][j][2] * v[q][j][2] + v[q][j][3] * v[q][j][3]);
            s = wave_sum(s);
            GAS unsigned long long* o8 = (GAS unsigned long long*)(hb + (size_t)(m0 + q) * DM) + lane;
#pragma unroll
            for (int j = 0; j < 4; ++j) o8[64 * j] = (unsigned long long)pk2(v[q][j][0], v[q][j][1]) | ((unsigned long long)pk2(v[q][j][2], v[q][j][3]) << 32);
            if (lane < 16) ssq[(size_t)(m0 + q) * 16 + lane] = (lane == 0) ? s : 0.f; }
    }
    { const int gt = (F.vcu * NWAVES + wave) * 64 + lane, NGT = NGW * 64;
      f32x2* r0 = (f32x2*)(ws + WS_ROPE0); f32x2* r1 = (f32x2*)(ws + WS_ROPE1);
      for (int e = gt; e < MROWS * 48; e += NGT) { const int row = e / 48, j = e % 48; const double p = (double)I.pos[row];
          float sn, cs; if (j < 16) { sincos_d(p * RF.f16[j], sn, cs); r0[(size_t)row * 16 + j] = (f32x2){cs, sn}; } else { sincos_d(p * RF.f32[j - 16], sn, cs); r1[(size_t)row * 32 + (j - 16)] = (f32x2){cs, sn}; } } }
    for (int o = gw; o < 256; o += NGW) { const int kv = o >> 7, j = o & 127; const float* w = kv ? I.cv_w1 : I.ck_w1; const float* pe = kv ? I.pos_v : I.pos_k; float s = 0.f;
#pragma unroll
        for (int t = 0; t < 32; ++t) s += pe[lane + 64 * t] * w[(size_t)(lane + 64 * t) * 128 + j];
        s = wave_sum(s); if (lane == 0) ((float*)(ws + WS_BIAS1))[o] = s; }
}
constexpr int ML_NS = 5, ML_K = 0, ML_KSLOT = 12288, ML_V = ML_NS * ML_KSLOT, ML_VSLOT = 8192, ML_WS = ML_V + ML_NS * ML_VSLOT, ML_OST = ML_WS + 8 * 512, ML_END = ML_OST + 8 * 4096;
constexpr int NS_K = 0, NS_KSLOT = 8192, NS_V = 3 * NS_KSLOT, NS_VSLOT = 8192, NS_WS = NS_V + 4 * NS_VSLOT, NS_IMP = NS_WS + 8 * 512, NS_CK = NS_IMP + 16384, NS_CV = NS_CK + 32768, NS_END = NS_CV + 32768;
constexpr int AT_END = NS_END > ML_END ? NS_END : ML_END;
static_assert(AT_END <= RING_BYTES, "attention LDS map");
template <class RowPtr> __device__ __forceinline__ void store_o_tile(const f32x16& o0, const f32x16& o1, LAS unsigned char* stage, int lane, const RowPtr& rowptr) {
    const int r32 = lane & 31, hi = lane >> 5; LAS unsigned short* stg = (LAS unsigned short*)stage;
#pragma unroll
    for (int r = 0; r < 16; ++r) { const int orow = fa::crow(r, hi); stg[orow * 64 + r32] = (unsigned short)f2bf(o0[r]); stg[orow * 64 + 32 + r32] = (unsigned short)f2bf(o1[r]); }
    LDS_WAIT();
#pragma unroll
    for (int i = 0; i < 4; ++i) { const int row = i * 8 + (lane >> 3), ch = lane & 7; const v4u v = *(const LAS v4u*)(stg + row * 64 + ch * 8); *(v4u*)(rowptr(row) + ch * 8) = v; }
    LDS_WAIT();
}
__device__ __forceinline__ void mla_attn_unit(Frame& F, int b, int h, int qb, const bf16* QM, const bf16* KF, const bf16* VM, bf16* O0) {
    const int tid = opaque_tid(), lane = tid & 63, r32 = lane & 31, hi = lane >> 5, wid = __builtin_amdgcn_readfirstlane(tid >> 6);
    const size_t rowbase = (size_t)b * SEQ; const int q0 = qb * 256, NT = (q0 + 256) / 64;
    const fa::lds_cptr L = (fa::lds_cptr)(F.lds + RING_OFF); const unsigned l0 = fa::lds_addr(L);
    LAS float* wsf = (LAS float*)(F.lds + RING_OFF + ML_WS) + wid * 128;
    const bf16* Qw = QM + (rowbase + q0 + wid * 32 + r32) * 768 + h * 96;
    fa::bf16x8 qr[6];
#pragma unroll
    for (int d0 = 0; d0 < 6; ++d0) qr[d0] = *(const fa::bf16x8*)(Qw + d0 * 16 + hi * 8);
    __builtin_amdgcn_s_waitcnt(0x0F70);
    const bf16* Kh = KF + (size_t)(b * 8 + h) * SEQ * 96; const bf16* Vh = VM + (size_t)(b * 8 + h) * SEQ * 64;
    const int qpos = q0 + wid * 32 + r32, wq_lo = q0 + wid * 32, my_last = (wq_lo + 31) >> 6;
    fa::Run R; fa::run_init(R);
    auto dma_tile = [&](int t, int slot) { fa::dma_k<96>(Kh + (size_t)t * 64 * 96, 96, l0 + ML_K + slot * ML_KSLOT, wid, lane); fa::dma_v(Vh + (size_t)t * 64 * 64, 64, l0 + ML_V + slot * ML_VSLOT, wid, lane); };
    dma_tile(0, 0); dma_tile(1, 1); dma_tile(2, 2);
    fa::u32x4 pw[4] = {}; fa::f32x16 p0 = fa::f32x16{}, p1 = fa::f32x16{};
    int sc = 0, sn = 3;
#define ML_STEP(ST, t) do { \
        if ((ST) || (t) + 2 < NT) FA_WAIT_BAR(6); else if ((t) + 1 < NT) FA_WAIT_BAR(3); else FA_WAIT_BAR(0);       \
        if ((ST) || (t) + 3 < NT) dma_tile((t) + 3, sn); \
        if ((ST) || (t) <= my_last) { \
            fa::qkt<96>(p0, p1, L + ML_K + sc * ML_KSLOT, qr, R.negm, r32, hi); \
            fa::VFrag vf_; fa::v_load(vf_, L + ML_V + sc * ML_VSLOT, lane, hi);        \
            __builtin_amdgcn_sched_barrier(0); \
            if (!(ST) && (t) * 64 + 63 > wq_lo) { asm volatile("; causal band (a real branch)"); fa::mask_range(p0, p1, (t) * 64, 0, qpos, hi); } \
            fa::softmax_step(R, p0, p1, wsf, r32, hi); \
            fa::pack_p(pw, p0, p1); \
            fa::pv_frag(R.o0, R.o1, pw, vf_); } \
        __builtin_amdgcn_sched_barrier(0); \
        sc = (sc == ML_NS - 1) ? 0 : sc + 1; sn = (sn == ML_NS - 1) ? 0 : sn + 1; } while (0)
    int t = 0;
    ML_STEP(0, t); t = 1;
    for (; t < NT - 4; ++t) ML_STEP(1, t);
    for (; t < NT; ++t) ML_STEP(0, t);
#undef ML_STEP
    asm volatile("s_waitcnt lgkmcnt(0)\n\ts_barrier" ::: "memory");
    float rli[16]; fa::run_finish(R, rli, wsf, r32, hi);
#pragma unroll
    for (int r = 0; r < 16; ++r) { R.o0[r] *= rli[r]; R.o1[r] *= rli[r]; }
    bf16* Ow = O0 + (rowbase + q0 + wid * 32) * 1024 + h * 64;
    store_o_tile(R.o0, R.o1, F.lds + RING_OFF + ML_OST + wid * 4096, lane, [&](int rr) { return Ow + (size_t)rr * 1024; });
    FA_WAIT_BAR(0);
}
constexpr int UP_AQ = 0, UP_AKV = 65536, UP_RS = UP_AKV + 32768, UP_STG = UP_RS + 1024, UP_END = UP_STG + 8 * 4096;
static_assert(UP_END <= RING_BYTES, "up-projection LDS map");
__device__ __forceinline__ void mla_up_unit(Frame& F, int hm, const bf16* U0, const bf16* WUQF, const bf16* WUKVF, const float* ssqq, const float* ssqkv, const float* rope, float c2, bf16* QM, bf16* KF, bf16* VM) {
    const int tid = opaque_tid(), lane = tid & 63, r32 = lane & 31, hi = lane >> 5, wid = __builtin_amdgcn_readfirstlane(tid >> 6);
    const int rb = wid & 3, hf = wid >> 2, row0 = hm * 128, rot = (int)(blockIdx.x >> 3);
    const fa::lds_cptr L = (fa::lds_cptr)(F.lds + RING_OFF); const unsigned l0 = fa::lds_addr(L);
    LAS float* rsl = (LAS float*)(F.lds + RING_OFF + UP_RS); LAS unsigned short* stg = (LAS unsigned short*)(F.lds + RING_OFF + UP_STG + wid * 4096);
    if (tid < 256) { const int row = tid & 127; const f32x4 p = *(const f32x4*)((tid < 128 ? ssqq : ssqkv) + (size_t)(row0 + row) * 4); const float sm = (p[0] + p[1]) + (p[2] + p[3]);
        rsl[tid] = (tid < 128) ? __builtin_amdgcn_rsqf(sm * (1.0f / 256.0f) + pg8::NORM_EPS) * c2 : __builtin_amdgcn_rsqf(sm * (1.0f / 128.0f) + pg8::NORM_EPS); }
    __builtin_amdgcn_s_waitcnt(0x0F70);
#pragma unroll
    for (int q = 0; q < 8; ++q) { const int i = 8 * wid + q, p = 64 * i + lane, row = p >> 5, slot = p & 31, ch = slot ^ (row & 7);
        fa::glds16(U0 + (size_t)(row0 + row) * 2048 + ch * 8, (unsigned)__builtin_amdgcn_readfirstlane(l0 + UP_AQ + i * 1024)); }
#pragma unroll
    for (int q = 0; q < 4; ++q) { const int i = 4 * wid + q, p = 64 * i + lane, row = p >> 4, slot = p & 15, ch = slot ^ (row & 7);
        fa::glds16(U0 + (size_t)(row0 + row) * 2048 + 256 + ch * 8, (unsigned)__builtin_amdgcn_readfirstlane(l0 + UP_AKV + i * 1024)); }
    FA_WAIT_BAR(0);
    const int arow = 32 * rb + r32;
    auto put32 = [&](const fa::f32x16& v, int ncols, int coff) {
#pragma unroll
        for (int r = 0; r < 16; ++r) stg[fa::crow(r, hi) * ncols + coff] = (unsigned short)f2bf(v[r]); };
    { fa::bf16x8 af[16];
#pragma unroll
      for (int ks = 0; ks < 16; ++ks) af[ks] = *(const FA_LAS fa::bf16x8*)(L + UP_AQ + arow * 512 + (((2 * ks + hi) ^ (arow & 7)) * 16));
      float rsq[16];
#pragma unroll
      for (int r = 0; r < 16; ++r) rsq[r] = rsl[32 * rb + fa::crow(r, hi)];
      const bf16* wf = WUQF + lane * 8;
      const int nplain = hf ? 4 : 12;
      for (int t = 0; t < nplain; ++t) { const int tr = (t + rot) % nplain, nblk = hf ? 12 + tr : tr; fa::f32x16 acc = fa::f32x16{};
#pragma unroll
          for (int ks = 0; ks < 16; ++ks) acc = FA_MFMA(af[ks], *(const fa::bf16x8*)(wf + (size_t)(ks * 24 + nblk) * 512), acc);
#pragma unroll
          for (int r = 0; r < 16; ++r) acc[r] *= rsq[r];
          put32(acc, 32, r32); LDS_WAIT();
          bf16* dstb = QM + (size_t)(row0 + 32 * rb) * 768 + (nblk >> 1) * 96 + 32 * (nblk & 1);
#pragma unroll
          for (int it = 0; it < 2; ++it) { const int idx = it * 64 + lane, row = idx >> 2, ch = idx & 3; *(v4u*)(dstb + (size_t)row * 768 + ch * 8) = *(const LAS v4u*)(stg + row * 32 + ch * 8); }
          LDS_WAIT(); }
      if (hf) for (int jj = 0; jj < 4; ++jj) { const int j = (jj + rot) & 3; fa::f32x16 a1 = fa::f32x16{}, a2 = fa::f32x16{};
#pragma unroll
          for (int ks = 0; ks < 16; ++ks) { a1 = FA_MFMA(af[ks], *(const fa::bf16x8*)(wf + (size_t)(ks * 24 + 16 + j) * 512), a1); a2 = FA_MFMA(af[ks], *(const fa::bf16x8*)(wf + (size_t)(ks * 24 + 20 + j) * 512), a2); }
          fa::f32x16 y1, y2;
#pragma unroll
          for (int r = 0; r < 16; ++r) { const f32x2 cs = *(const f32x2*)(rope + ((size_t)(row0 + 32 * rb + fa::crow(r, hi)) * 16 + (r32 & 15)) * 2); const float x1 = a1[r] * rsq[r], x2 = a2[r] * rsq[r];
              y1[r] = x1 * cs[0] - x2 * cs[1]; y2[r] = x2 * cs[0] + x1 * cs[1]; }
          const int co = (r32 >> 4) * 32 + (r32 & 15);
          put32(y1, 64, co); put32(y2, 64, co + 16); LDS_WAIT();
          bf16* dstb = QM + (size_t)(row0 + 32 * rb) * 768 + (2 * j) * 96 + 64;
#pragma unroll
          for (int it = 0; it < 4; ++it) { const int idx = it * 64 + lane, row = idx >> 3, ch = idx & 7; *(v4u*)(dstb + (size_t)row * 768 + (ch >> 2) * 96 + (ch & 3) * 8) = *(const LAS v4u*)(stg + row * 64 + ch * 8); }
          LDS_WAIT(); } }
    { fa::bf16x8 af[8];
#pragma unroll
      for (int ks = 0; ks < 8; ++ks) af[ks] = *(const FA_LAS fa::bf16x8*)(L + UP_AKV + arow * 256 + (((2 * ks + hi) ^ (arow & 7)) * 16));
      float rsk[16];
#pragma unroll
      for (int r = 0; r < 16; ++r) rsk[r] = rsl[128 + 32 * rb + fa::crow(r, hi)];
      const bf16* wf = WUKVF + lane * 8;
      for (int t = 0; t < 16; ++t) { const int nblk = 16 * hf + ((t + rot) & 15); fa::f32x16 acc = fa::f32x16{};
#pragma unroll
          for (int ks = 0; ks < 8; ++ks) acc = FA_MFMA(af[ks], *(const fa::bf16x8*)(wf + (size_t)(ks * 32 + nblk) * 512), acc);
#pragma unroll
          for (int r = 0; r < 16; ++r) acc[r] *= rsk[r];
          put32(acc, 32, r32); LDS_WAIT();
          const int head = nblk >> 2, part = nblk & 3;
          const int bb = row0 >> 12, s0 = (row0 & (SEQ - 1)) + 32 * rb;
          bf16* dstb = (part < 2) ? KF + ((size_t)(bb * 8 + head) * SEQ + s0) * 96 + 32 * part : VM + ((size_t)(bb * 8 + head) * SEQ + s0) * 64 + 32 * (part - 2);
          const int pitch = (part < 2) ? 96 : 64;
#pragma unroll
          for (int it = 0; it < 2; ++it) { const int idx = it * 64 + lane, row = idx >> 2, ch = idx & 3; *(v4u*)(dstb + (size_t)row * pitch + ch * 8) = *(const LAS v4u*)(stg + row * 32 + ch * 8); }
          LDS_WAIT(); } }
    asm volatile("s_waitcnt lgkmcnt(0)\n\ts_barrier" ::: "memory");
}
__device__ __forceinline__ void krot_pass(Frame& F, const float* KR, const float* rope, bf16* KF) {
    const int tid = opaque_tid(); const int gt = (F.vcu * NWAVES + __builtin_amdgcn_readfirstlane(tid >> 6)) * 64 + (tid & 63), NGT = F.G * NWAVES * 64;
    for (int e = gt; e < MROWS * 8; e += NGT) { const int row = e >> 3, h = e & 7; const f32x4* kr = (const f32x4*)(KR + (size_t)row * 32); const f32x4* cs = (const f32x4*)(rope + (size_t)row * 32);
        float x[32], c[16], s[16];
#pragma unroll
        for (int i = 0; i < 8; ++i) { const f32x4 v = kr[i]; x[4 * i] = v[0]; x[4 * i + 1] = v[1]; x[4 * i + 2] = v[2]; x[4 * i + 3] = v[3]; const f32x4 t = cs[i]; c[2 * i] = t[0]; s[2 * i] = t[1]; c[2 * i + 1] = t[2]; s[2 * i + 1] = t[3]; }
        v4u o[4];
#pragma unroll
        for (int i = 0; i < 16; i += 2) { const float y0 = x[i] * c[i] - x[16 + i] * s[i], y1 = x[i + 1] * c[i + 1] - x[17 + i] * s[i + 1]; o[i >> 3][(i >> 1) & 3] = pk2(y0, y1); }
#pragma unroll
        for (int i = 0; i < 16; i += 2) { const float y0 = x[16 + i] * c[i] + x[i] * s[i], y1 = x[17 + i] * c[i + 1] + x[i + 1] * s[i + 1]; o[2 + (i >> 3)][(i >> 1) & 3] = pk2(y0, y1); }
        v4u* dst = (v4u*)(KF + ((size_t)((row >> 12) * 8 + h) * SEQ + (row & (SEQ - 1))) * 96 + 64);
#pragma unroll
        for (int i = 0; i < 4; ++i) dst[i] = o[i]; }
}
__device__ __forceinline__ void gla_pre(Frame& F, const bf16* U0, const float* GA, const float* w_a2, const float* b_a, bf16* KD, bf16* QA, bf16* QI, float* DEC) {
    const int tid = opaque_tid(); const int gw = F.vcu * NWAVES + __builtin_amdgcn_readfirstlane(tid >> 6), NGW = F.G * NWAVES, lane = tid & 63;
    for (int u = gw; u < BATCH * 64 * 4; u += NGW) { const int h = u & 3, bn = u >> 2; const size_t t0 = (size_t)bn * 64;
        float wv[16];
#pragma unroll
        for (int j = 0; j < 16; ++j) wv[j] = w_a2[j * 256 + h * 64 + lane];
        const float bav = b_a[h * 64 + lane];
        float bc[64]; float run = 0.f;
#pragma unroll
        for (int i = 0; i < 64; ++i) { const f32x4* gp = (const f32x4*)(GA + (t0 + i) * 16); const f32x4 a0 = gp[0], a1 = gp[1], a2 = gp[2], a3 = gp[3];
            float g = bav;
            g += a0[0] * wv[0]; g += a0[1] * wv[1]; g += a0[2] * wv[2]; g += a0[3] * wv[3]; g += a1[0] * wv[4]; g += a1[1] * wv[5]; g += a1[2] * wv[6]; g += a1[3] * wv[7];
            g += a2[0] * wv[8]; g += a2[1] * wv[9]; g += a2[2] * wv[10]; g += a2[3] * wv[11]; g += a3[0] * wv[12]; g += a3[1] * wv[13]; g += a3[2] * wv[14]; g += a3[3] * wv[15];
            const float la = (__builtin_fminf(g, 0.f) - __logf(1.0f + __expf(-__builtin_fabsf(g)))) * (1.0f / 16.0f);
            run += la; bc[i] = run; }
        const float bl = run;
        DEC[(size_t)bn * 256 + h * 64 + lane] = __expf(bl);
        const bf16* qp = U0 + t0 * 2048 + 512 + h * 64 + lane; const bf16* kp = U0 + t0 * 2048 + 768 + h * 64 + lane;
        bf16* kd = KD + t0 * 256 + h * 64 + lane; bf16* qa = QA + t0 * 256 + h * 64 + lane;
#pragma unroll
        for (int i0 = 0; i0 < 64; i0 += 16) { unsigned short qv[16], kv[16];
#pragma unroll
            for (int i = 0; i < 16; ++i) { qv[i] = qp[(size_t)(i0 + i) * 2048]; kv[i] = kp[(size_t)(i0 + i) * 2048]; }
#pragma unroll
            for (int i = 0; i < 16; ++i) { const float b_ = bc[i0 + i]; const float q = bf2f(qv[i]) * 0.125f, k = bf2f(kv[i]);
                kd[(size_t)(i0 + i) * 256] = (bf16)f2bf(k * __expf(bl - b_)); qa[(size_t)(i0 + i) * 256] = (bf16)f2bf(q * __expf(b_ - bl)); } } }
}
constexpr int GL_SET = 49152, GL_KDK = 0, GL_KDV = 8192, GL_QA = 16384, GL_QI = 24576, GL_VV = 32768, GL_S = 2 * GL_SET, GL_OB = GL_S + 16384, GL_OBP = 136, GL_OBSZ = 64 * GL_OBP * 2, GL_END = GL_OB + 2 * GL_OBSZ;
static_assert(GL_END <= RING_BYTES, "GLA LDS map");
__device__ __forceinline__ void gla_unit(Frame& F, int b, int h, int nb, int ne, const bf16* U0, const bf16* KD, const bf16* QA, const bf16* QI, const float* DEC, const float* gnorm, bf16* O0) {
    const int tid = opaque_tid(), lane = tid & 63, r32 = lane & 31, hi = lane >> 5, wid = __builtin_amdgcn_readfirstlane(tid >> 6);
    const int ib = wid & 1, vb = wid >> 1;
    const fa::lds_cptr L = (fa::lds_cptr)(F.lds + RING_OFF); const unsigned l0 = fa::lds_addr(L);
    const size_t tokb = (size_t)b * SEQ;
    const int trn = ((lane >> 4) & 1) * 32 + (lane & 3) * 8 + (8 * hi + ((lane & 15) >> 2)) * 64;
    const int trp = ((lane >> 4) & 1) * 32 + (lane & 3) * 8 + (4 * hi + ((lane & 15) >> 2)) * 64;
    auto dma_chunk = [&](int n, int s) { const size_t t0 = tokb + (size_t)n * 64; const unsigned base = l0 + s * GL_SET;
        fa::glds16(KD + (t0 + lane) * 256 + h * 64 + wid * 8, (unsigned)__builtin_amdgcn_readfirstlane(base + GL_KDK + wid * 1024));
        fa::glds16(QA + (t0 + lane) * 256 + h * 64 + wid * 8, (unsigned)__builtin_amdgcn_readfirstlane(base + GL_QA + wid * 1024));
        fa::glds16(KD + (t0 + 16 * (wid & 3) + (lane >> 2)) * 256 + h * 64 + (wid >> 2) * 32 + (lane & 3) * 8, (unsigned)__builtin_amdgcn_readfirstlane(base + GL_KDV + wid * 1024));
#pragma unroll
        for (int k = 0; k < 2; ++k) { const int p = wid + 8 * k; fa::glds16(U0 + (t0 + 16 * (p & 3) + (lane >> 2)) * 2048 + 1024 + h * 128 + (p >> 2) * 32 + (lane & 3) * 8, (unsigned)__builtin_amdgcn_readfirstlane(base + GL_VV + p * 1024)); } };
    fa::f32x16 st = fa::f32x16{};
    const int fi = tid >> 3, fs = tid & 7; float gn[16];
#pragma unroll
    for (int e = 0; e < 16; ++e) gn[e] = gnorm[fs * 16 + e];
    float dec[16]; v4u rr0, rr1;
    auto load_side = [&](int n) { const float* dp = DEC + ((size_t)b * 64 + n) * 256 + h * 64 + 32 * ib;
#pragma unroll
        for (int r = 0; r < 16; ++r) dec[r] = dp[fa::crow(r, hi)];
        const v4u* rp = (const v4u*)(U0 + (tokb + (size_t)n * 64 + fi) * 2048 + 1536 + h * 128 + fs * 16); rr0 = rp[0]; rr1 = rp[1]; };
    auto finalize = [&](int m, const v4u& q0, const v4u& q1) {
        const LAS v4u* op = (const LAS v4u*)(F.lds + RING_OFF + GL_OB + (m & 1) * GL_OBSZ + (fi * GL_OBP + fs * 16) * 2); const v4u xa = op[0], xb = op[1]; float x[16]; float ss = 0.f;
#pragma unroll
        for (int e = 0; e < 16; ++e) { const unsigned w = (e < 8) ? xa[e >> 1] : xb[(e - 8) >> 1]; x[e] = bf2f((unsigned short)((e & 1) ? (w >> 16) : (w & 0xffffu))); ss += x[e] * x[e]; }
        ss += __shfl_xor(ss, 1); ss += __shfl_xor(ss, 2); ss += __shfl_xor(ss, 4);
        const float rstd = 1.0f / sqrtf(ss * (1.0f / 128.0f) + pg8::NORM_EPS); float y[16];
#pragma unroll
        for (int e = 0; e < 16; ++e) { const unsigned w = (e < 8) ? q0[e >> 1] : q1[(e - 8) >> 1]; const float rv = bf2f((unsigned short)((e & 1) ? (w >> 16) : (w & 0xffffu))); y[e] = x[e] * rstd * gn[e] * pg8::silu_f(rv); }
        v4u w0, w1; w0.x = pk2(y[0], y[1]); w0.y = pk2(y[2], y[3]); w0.z = pk2(y[4], y[5]); w0.w = pk2(y[6], y[7]); w1.x = pk2(y[8], y[9]); w1.y = pk2(y[10], y[11]); w1.z = pk2(y[12], y[13]); w1.w = pk2(y[14], y[15]);
        v4u* dst = (v4u*)(O0 + (tokb + (size_t)m * 64 + fi) * 1024 + 512 + h * 128 + fs * 16); dst[0] = w0; dst[1] = w1; };
    v4u rp0 = {0u, 0u, 0u, 0u}, rp1 = {0u, 0u, 0u, 0u};
    if (nb > 0) {
        constexpr int WSET = 24576, W_KDV = 0, W_VV = 8192;
        auto dma_w = [&](int n, int s) { const size_t t0 = tokb + (size_t)n * 64; const unsigned base = l0 + s * WSET;
            fa::glds16(KD + (t0 + 16 * (wid & 3) + (lane >> 2)) * 256 + h * 64 + (wid >> 2) * 32 + (lane & 3) * 8, (unsigned)__builtin_amdgcn_readfirstlane(base + W_KDV + wid * 1024));
#pragma unroll
            for (int k = 0; k < 2; ++k) { const int p = wid + 8 * k; fa::glds16(U0 + (t0 + 16 * (p & 3) + (lane >> 2)) * 2048 + 1024 + h * 128 + (p >> 2) * 32 + (lane & 3) * 8, (unsigned)__builtin_amdgcn_readfirstlane(base + W_VV + p * 1024)); } };
        float wd[16];
        auto load_wd = [&](int n) { const float* dp = DEC + ((size_t)b * 64 + n) * 256 + h * 64 + 32 * ib;
#pragma unroll
            for (int r = 0; r < 16; ++r) wd[r] = dp[fa::crow(r, hi)]; };
        load_wd(0);
        __builtin_amdgcn_s_waitcnt(0x0F70);
        dma_w(0, 0); if (nb > 1) dma_w(1, 1);
        for (int n = 0; n < nb; ++n) { const int s = n & 1; const fa::lds_cptr IM = L + s * WSET;
            if (n + 1 < nb) asm volatile("s_waitcnt vmcnt(3)" ::: "memory"); else asm volatile("s_waitcnt vmcnt(0)" ::: "memory");
            asm volatile("s_barrier" ::: "memory");
            float wdc[16];
#pragma unroll
            for (int r = 0; r < 16; ++r) wdc[r] = wd[r];
            asm volatile("" ::: "memory");
            if (n + 1 < nb) load_wd(n + 1);
            const fa::lds_cptr ap = IM + W_KDV + ib * 4096 + trn; const fa::lds_cptr bp = IM + W_VV + vb * 4096 + trn;
            fa::s16x4 al_[4], ah_[4], bl_[4], bh_[4];
#pragma unroll
            for (int ks = 0; ks < 4; ++ks) { al_[ks] = fa::vtr(ap + ks * 1024); ah_[ks] = fa::vtr(ap + ks * 1024 + 256); bl_[ks] = fa::vtr(bp + ks * 1024); bh_[ks] = fa::vtr(bp + ks * 1024 + 256); }
            __builtin_amdgcn_sched_barrier(0);
#pragma unroll
            for (int r = 0; r < 16; ++r) st[r] *= wdc[r];
#pragma unroll
            for (int ks = 0; ks < 4; ++ks) st = FA_MFMA(((fa::bf16x8){al_[ks][0], al_[ks][1], al_[ks][2], al_[ks][3], ah_[ks][0], ah_[ks][1], ah_[ks][2], ah_[ks][3]}), ((fa::bf16x8){bl_[ks][0], bl_[ks][1], bl_[ks][2], bl_[ks][3], bh_[ks][0], bh_[ks][1], bh_[ks][2], bh_[ks][3]}), st);
            asm volatile("s_waitcnt lgkmcnt(0)\n\ts_barrier" ::: "memory");
            if (n + 2 < nb) dma_w(n + 2, s);
        }
    }
    dma_chunk(nb, nb & 1); load_side(nb);
    for (int n = nb; n < ne; ++n) { const int s = n & 1; const fa::lds_cptr IM = L + s * GL_SET;
        v4u rc0 = rr0, rc1 = rr1;
#pragma unroll
        for (int r = 0; r < 16; ++r) st[r] *= dec[r];
        { LAS unsigned short* sp = (LAS unsigned short*)(F.lds + RING_OFF + GL_S) + vb * 2048 + r32;
#pragma unroll
          for (int r = 0; r < 16; ++r) sp[(32 * ib + fa::crow(r, hi)) * 32] = (unsigned short)f2bf(st[r]); }
        FA_WAIT_BAR(2);
        if (n + 1 < ne) { dma_chunk(n + 1, s ^ 1); load_side(n + 1); }
        const fa::lds_cptr kb = IM + GL_KDK + hi * 1024 + r32 * 16, qb_ = IM + GL_QA + hi * 1024 + (32 * ib + r32) * 16, vpp = IM + GL_VV + vb * 4096 + trp;
        const fa::lds_cptr qi = IM + GL_QA + hi * 1024 + (32 * ib + r32) * 16; const fa::lds_cptr sp = L + GL_S + vb * 4096 + trn;
        fa::f32x16 p0 = fa::f32x16{}, p1 = fa::f32x16{}, o2 = fa::f32x16{}, o = fa::f32x16{};
        { fa::bf16x8 ka0[4], ka1[4], qq[4];
#pragma unroll
          for (int d0 = 0; d0 < 4; ++d0) { ka0[d0] = *(const FA_LAS fa::bf16x8*)(kb + d0 * 2048); ka1[d0] = *(const FA_LAS fa::bf16x8*)(kb + d0 * 2048 + 512); qq[d0] = *(const FA_LAS fa::bf16x8*)(qb_ + d0 * 2048); }
          __builtin_amdgcn_sched_barrier(0);
#pragma unroll
          for (int d0 = 0; d0 < 4; ++d0) { p0 = FA_MFMA(ka0[d0], qq[d0], p0); p1 = FA_MFMA(ka1[d0], qq[d0], p1); } }
        __builtin_amdgcn_sched_barrier(0);
        if (n > nb) finalize(n - 1, rp0, rp1);
        rp0 = rc0; rp1 = rc1;
        __builtin_amdgcn_sched_barrier(0);
        fa::bf16x8 qa_[4]; fa::s16x4 sl_[4], sh_[4], pvl[4], pvh[4];
#pragma unroll
        for (int d0 = 0; d0 < 4; ++d0) { qa_[d0] = *(const FA_LAS fa::bf16x8*)(qi + d0 * 2048); sl_[d0] = fa::vtr(sp + d0 * 1024); sh_[d0] = fa::vtr(sp + d0 * 1024 + 256); }
#pragma unroll
        for (int ks = 0; ks < 4; ++ks) { pvl[ks] = fa::vtr(vpp + ks * 1024); pvh[ks] = fa::vtr(vpp + ks * 1024 + 512); }
        __builtin_amdgcn_sched_barrier(0);
        { const int i = 32 * ib + r32;
#pragma unroll
          for (int r = 0; r < 16; ++r) { const int j0 = fa::crow(r, hi); if (j0 > i) p0[r] = 0.f; if (j0 + 32 > i) p1[r] = 0.f; } }
        { fa::u32x4 pw[4]; fa::pack_p(pw, p0, p1);
#pragma unroll
          for (int ks = 0; ks < 4; ++ks) { o = FA_MFMA(__builtin_bit_cast(fa::bf16x8, pw[ks]), ((fa::bf16x8){pvl[ks][0], pvl[ks][1], pvl[ks][2], pvl[ks][3], pvh[ks][0], pvh[ks][1], pvh[ks][2], pvh[ks][3]}), o);
              o2 = FA_MFMA(qa_[ks], ((fa::bf16x8){sl_[ks][0], sl_[ks][1], sl_[ks][2], sl_[ks][3], sh_[ks][0], sh_[ks][1], sh_[ks][2], sh_[ks][3]}), o2); } }
        __builtin_amdgcn_sched_barrier(0);
        { const fa::lds_cptr ap = IM + GL_KDV + ib * 4096 + trn; const fa::lds_cptr bp = IM + GL_VV + vb * 4096 + trn;
          fa::s16x4 al_[4], ah_[4], bl_[4], bh_[4];
#pragma unroll
          for (int ks = 0; ks < 4; ++ks) { al_[ks] = fa::vtr(ap + ks * 1024); ah_[ks] = fa::vtr(ap + ks * 1024 + 256); bl_[ks] = fa::vtr(bp + ks * 1024); bh_[ks] = fa::vtr(bp + ks * 1024 + 256); }
          __builtin_amdgcn_sched_barrier(0);
#pragma unroll
          for (int ks = 0; ks < 4; ++ks) st = FA_MFMA(((fa::bf16x8){al_[ks][0], al_[ks][1], al_[ks][2], al_[ks][3], ah_[ks][0], ah_[ks][1], ah_[ks][2], ah_[ks][3]}), ((fa::bf16x8){bl_[ks][0], bl_[ks][1], bl_[ks][2], bl_[ks][3], bh_[ks][0], bh_[ks][1], bh_[ks][2], bh_[ks][3]}), st); }
        { LAS unsigned short* ob = (LAS unsigned short*)(F.lds + RING_OFF + GL_OB + (n & 1) * GL_OBSZ) + 32 * vb + r32;
#pragma unroll
          for (int r = 0; r < 16; ++r) ob[(32 * ib + fa::crow(r, hi)) * GL_OBP] = (unsigned short)f2bf(o[r] + o2[r]); }
        asm volatile("s_waitcnt lgkmcnt(0)\n\ts_barrier" ::: "memory");
    }
    finalize(ne - 1, rp0, rp1);
    FA_WAIT_BAR(0);
}
namespace np {
using fa::bf16x8; using fa::s16x4; using fa::f32x16; using fa::u32x4; using fa::lds_cptr; using fa::crow;
#define NP_SBAR() __builtin_amdgcn_sched_barrier(0)
#define NP_WAIT_BAR(N) asm volatile("s_waitcnt vmcnt(" #N ") lgkmcnt(0)\n\ts_barrier" ::: "memory")
#define NP_PIN(x) asm volatile("" : "+v"(x))
#define NP_MX3(a, b, c) __builtin_fmaxf(__builtin_fmaxf((a), (b)), (c))
#define NP_MFMA(a, b, c) __builtin_amdgcn_mfma_f32_32x32x16_bf16(a, b, c, 0, 0, 0)
__device__ __forceinline__ void kload8(bf16x8* kf, lds_cptr kp) {
    kf[0] = *(const FA_LAS bf16x8*)(kp);        kf[1] = *(const FA_LAS bf16x8*)(kp + 512);  kf[2] = *(const FA_LAS bf16x8*)(kp + 2048); kf[3] = *(const FA_LAS bf16x8*)(kp + 2560);
    kf[4] = *(const FA_LAS bf16x8*)(kp + 4096); kf[5] = *(const FA_LAS bf16x8*)(kp + 4608); kf[6] = *(const FA_LAS bf16x8*)(kp + 6144); kf[7] = *(const FA_LAS bf16x8*)(kp + 6656);
}
__device__ __forceinline__ void kload2(bf16x8* kf, lds_cptr kp, int j) { kf[2 * j] = *(const FA_LAS bf16x8*)(kp + j * 2048); kf[2 * j + 1] = *(const FA_LAS bf16x8*)(kp + j * 2048 + 512); }
}
struct NsaTiles {
    const bf16* kSp; const bf16* vSp; unsigned kdst, vdst; int NS, wlo, NTOT, NT, cur; size_t KVB;
    __device__ __forceinline__ void init(const bf16* KV6, int b, int g, int cur_, unsigned lds0, int lane, int wid) {
        cur = cur_; NS = cur + 1; wlo = cur >= 8 ? cur - 8 : 0; NTOT = NS + (cur - wlo + 1); NT = (NTOT + 1) & ~1; if (NT < 4) NT = 4; KVB = (size_t)MROWS * 256;
        kSp = KV6 + 2 * KVB + (size_t)b * SEQ * 256 + g * 64 + (size_t)lane * 256 + wid * 8;
        vSp = KV6 + 3 * KVB + (size_t)b * SEQ * 256 + g * 64 + (size_t)(16 * (wid & 3) + (lane >> 2)) * 256 + (wid >> 2) * 32 + (lane & 3) * 8;
        kdst = lds0 + NS_K + wid * 1024; vdst = lds0 + NS_V + wid * 1024; }
    __device__ __forceinline__ size_t toff(int t) const { return (size_t)((t < NS) ? t : ((t < NTOT) ? wlo + (t - NS) : cur)) * (64 * 256) + ((t < NS) ? (size_t)0 : 2 * KVB); }
    __device__ __forceinline__ void dma_k(int t, int slot) const { fa::glds16(kSp + toff(t), (unsigned)__builtin_amdgcn_readfirstlane(kdst + slot)); }
    __device__ __forceinline__ void dma_v(int t, int slot) const { fa::glds16(vSp + toff(t), (unsigned)__builtin_amdgcn_readfirstlane(vdst + slot)); }
    __device__ __forceinline__ void prologue() const { dma_k(0, 0); dma_v(0, 0); dma_k(1, 8192); dma_k(2, 16384); dma_v(1, 8192); }
};
__device__ __forceinline__ void nsa_stream_pipe(Frame& F, const fa::bf16x8 (&qr)[4], const NsaTiles& TL, int tq, unsigned long long selmask,
                                                fa::f32x16& oc0, fa::f32x16& oc1, bf16* Ow, int lane, int wid) {
    using namespace np;
    const int r32 = lane & 31, hi = lane >> 5;
    const fa::lds_cptr L = (fa::lds_cptr)(F.lds + RING_OFF); const unsigned lds0 = fa::lds_addr(L);
    LAS float* wsf = (LAS float*)(F.lds + RING_OFF + NS_WS) + wid * 128;
    LAS float* OF = (LAS float*)(F.lds + RING_OFF + NS_CK + wid * 8192) + lane;
    constexpr int SLOTB = 8192;
    const int NS = TL.NS, wlo = TL.wlo, NTOT = TL.NTOT, NT = TL.NT, cur = TL.cur;
#define NP_DMA_K(t, slot) TL.dma_k((t), (slot))
#define NP_DMA_V(t, slot) TL.dma_v((t), (slot))
    const lds_cptr kp0 = L + NS_K + hi * 1024 + r32 * 16; const lds_cptr vp0 = L + NS_V + ((lane >> 4) & 1) * 32 + (lane & 3) * 8 + (4 * hi + ((lane & 15) >> 2)) * 64;
    bf16x8 kf[8];
    float mhat = 0.f, l_reg = 0.f; f32x16 o[2]; o[0] = f32x16{}; o[1] = f32x16{}; f32x16 negm = f32x16{}; NP_PIN(negm);
    bool resc = false;
#define NP_MASK(C0, C1, t) do { const int t_ = (t); const bool sel_ = t_ < NS; const int j_ = sel_ ? t_ : wlo + (t_ - NS); \
        if (t_ < NTOT && (j_ == cur || (!sel_ && cur >= 8 && j_ == wlo))) { asm volatile("; key mask (a real branch)"); fa::mask_range(C0, C1, j_ * 64, sel_ ? 0 : tq - 511, tq, hi); } } while (0)
#define NP_CIN(t) f32x16 cin_; do { const int t_ = (t); const bool sel_ = t_ < NS; const int j_ = sel_ ? t_ : wlo + (t_ - NS); const bool rowok_ = sel_ ? (((selmask >> j_) & 1ull) != 0ull) : (t_ < NTOT); \
        _Pragma("unroll") for (int r = 0; r < 16; ++r) cin_[r] = rowok_ ? negm[r] : -1e30f; NP_PIN(cin_); } while (0)
#define NP_RESC() do { if (resc) { asm volatile("s_waitcnt lgkmcnt(0)" ::: "memory"); \
        _Pragma("unroll") for (int d_ = 0; d_ < 2; ++d_) _Pragma("unroll") for (int r = 0; r < 16; ++r) o[d_][r] *= wsf[crow(r, hi)]; } } while (0)
#define NP_FOLD(gofs) do { const float lt_ = fa::swap_sum(l_reg); asm volatile("s_waitcnt lgkmcnt(0)" ::: "memory"); if (hi == 0) wsf[32 + r32] = lt_; asm volatile("s_waitcnt lgkmcnt(0)" ::: "memory"); \
        _Pragma("unroll") for (int r = 0; r < 16; ++r) { const float s_ = wsf[(gofs) + crow(r, hi)] / __builtin_fmaxf(wsf[32 + crow(r, hi)], 1e-30f); OF[64 * r] += s_ * o[0][r]; OF[64 * (16 + r)] += s_ * o[1][r]; } \
        asm volatile("s_waitcnt lgkmcnt(0)" ::: "memory"); o[0] = f32x16{}; o[1] = f32x16{}; l_reg = 0.f; } while (0)
    f32x16 pA0, pA1, pB0, pB1;
    int sl_cur = 0, sl_next = SLOTB;
    int vs_prev = 0, vs_cur = 0, vs_nn = 2 * SLOTB;
#define NP_ROT() do { sl_cur = sl_next; sl_next = (sl_next == 2 * SLOTB) ? 0 : sl_next + SLOTB; vs_prev = vs_cur; vs_cur = (vs_cur == 3 * SLOTB) ? 0 : vs_cur + SLOTB; vs_nn = (vs_nn == 3 * SLOTB) ? 0 : vs_nn + SLOTB; } while (0)
    NP_WAIT_BAR(4);
#pragma unroll
    for (int r = 0; r < 16; ++r) { OF[64 * r] = oc0[r]; OF[64 * (16 + r)] = oc1[r]; }
    { const lds_cptr kb = L + NS_K + hi * 1024 + r32 * 16;
#pragma unroll
      for (int d0 = 0; d0 < 4; ++d0) { const bf16x8 b0 = *(const FA_LAS bf16x8*)(kb + d0 * 2048), b1 = *(const FA_LAS bf16x8*)(kb + d0 * 2048 + 512);
          if (d0 == 0) { pA0 = NP_MFMA(b0, qr[0], negm); pA1 = NP_MFMA(b1, qr[0], negm); } else { pA0 = NP_MFMA(b0, qr[d0], pA0); pA1 = NP_MFMA(b1, qr[d0], pA1); } } }
    NP_MASK(pA0, pA1, 0);
    { const float rm = fa::rowmax(pA0, pA1); const float dl = __builtin_fmaxf(rm, -64.f); mhat += dl;
#pragma unroll
      for (int r = 0; r < 16; ++r) { pA0[r] -= dl; pA1[r] -= dl; negm[r] = -mhat; }
      NP_PIN(negm);
#pragma unroll
      for (int r = 0; r < 16; ++r) { pA0[r] = __builtin_amdgcn_exp2f(pA0[r]); pA1[r] = __builtin_amdgcn_exp2f(pA1[r]); } }
    NP_WAIT_BAR(0);
    NP_DMA_K(3, 0); NP_DMA_V(2, 2 * SLOTB);
    NP_ROT();
    kload8(kf, kp0 + sl_cur);
    NP_WAIT_BAR(2);
    s16x4 vlo[8], vhi[8]; u32x4 pw0, pw1, pw2, pw3;
#define NP_PKW(P, B) fa::cvtpk(P[B], P[B + 1])
#define NP_PAF(k) __builtin_bit_cast(bf16x8, pw##k)
#define NP_VFR(i) (bf16x8){vlo[i][0], vlo[i][1], vlo[i][2], vlo[i][3], vhi[i][0], vhi[i][1], vhi[i][2], vhi[i][3]}
#define NP_GAPA(MF, A0, A1, A2, A3, W0, W1, PW) do { MF; sacc += A0; sacc += A1; sacc += A2; sacc += A3; NP_PIN(sacc); W0; W1; NP_PIN(PW); NP_SBAR(); } while (0)
#define NP_EX(v) __builtin_amdgcn_exp2f(v)
#define NP_GAPB(MF, X, B) do { MF; X[B] = NP_EX(X[B]); X[B + 1] = NP_EX(X[B + 1]); X[B + 2] = NP_EX(X[B + 2]); X[B + 3] = NP_EX(X[B + 3]); NP_PIN(X); NP_SBAR(); } while (0)
#define NP_VRD(i) do { vlo[i] = fa::vtr(vp_ + (((i) >> 2) * 4096 + ((i) & 3) * 1024)); vhi[i] = fa::vtr(vp_ + (((i) >> 2) * 4096 + ((i) & 3) * 1024 + 512)); } while (0)
#define NP_KRD(G, j) do { if (G) { kload2(kf, kp0 + sl_next, j); NP_SBAR(); } } while (0)
#ifndef NSX
#define NSX 0
#endif
    f32x16 xd0 = f32x16{}, xd1 = f32x16{}; float xv = 1.0f;
#define NP_EXTRA() do { \
    if (NSX == 1) { _Pragma("unroll") for (int q_ = 0; q_ < 8; ++q_) { xd0 = NP_MFMA(kf[q_], qr[q_ & 3], xd0); xd1 = NP_MFMA(kf[q_], qr[(q_ + 1) & 3], xd1); } NP_PIN(xd0); NP_PIN(xd1); } \
    if (NSX == 2) { _Pragma("unroll") for (int q_ = 0; q_ < 64; ++q_) { xv = NP_EX(xv * 0.999f); NP_PIN(xv); } } \
    if (NSX == 3) { asm volatile("s_barrier" ::: "memory"); } \
    if (NSX == 4) { bf16x8 xk[8]; kload8(xk, kp0 + sl_cur); _Pragma("unroll") for (int q_ = 0; q_ < 8; ++q_) asm volatile("" :: "v"(xk[q_])); kload8(xk, kp0 + sl_next); _Pragma("unroll") for (int q_ = 0; q_ < 8; ++q_) asm volatile("" :: "v"(xk[q_])); kload8(xk, kp0); _Pragma("unroll") for (int q_ = 0; q_ < 8; ++q_) asm volatile("" :: "v"(xk[q_])); } \
    } while (0)
#define NP_STEP(C0, C1, P0, P1, t, GK, GV, GL) do { NP_SBAR(); NP_CIN(t); NP_SBAR(); \
    const lds_cptr vp_ = vp0 + vs_prev; \
    NP_VRD(0); NP_SBAR(); float sacc = (P0[0] + P0[1]); \
    NP_GAPA(C0 = NP_MFMA(kf[0], qr[0], cin_), P0[2], P0[3], P0[4], P0[5],     pw0[0] = NP_PKW(P0, 0), pw0[1] = NP_PKW(P0, 2), pw0); \
    NP_VRD(4); NP_SBAR(); NP_GAPA(C1 = NP_MFMA(kf[1], qr[0], cin_), P0[6], P0[7], P0[8], P0[9],     pw0[2] = NP_PKW(P0, 4), pw0[3] = NP_PKW(P0, 6), pw0); \
    NP_VRD(1); NP_SBAR(); NP_GAPA(C0 = NP_MFMA(kf[2], qr[1], C0),   P0[10], P0[11], P0[12], P0[13], pw1[0] = NP_PKW(P0, 8), pw1[1] = NP_PKW(P0, 10), pw1); \
    NP_VRD(5); NP_SBAR(); NP_GAPA(C1 = NP_MFMA(kf[3], qr[1], C1),   P0[14], P0[15], P1[0], P1[1],   pw1[2] = NP_PKW(P0, 12), pw1[3] = NP_PKW(P0, 14), pw1); \
    NP_VRD(2); NP_SBAR(); NP_GAPA(C0 = NP_MFMA(kf[4], qr[2], C0),   P1[2], P1[3], P1[4], P1[5],     pw2[0] = NP_PKW(P1, 0), pw2[1] = NP_PKW(P1, 2), pw2); \
    NP_VRD(6); NP_SBAR(); NP_GAPA(C1 = NP_MFMA(kf[5], qr[2], C1),   P1[6], P1[7], P1[8], P1[9],     pw2[2] = NP_PKW(P1, 4), pw2[3] = NP_PKW(P1, 6), pw2); \
    NP_VRD(3); NP_SBAR(); NP_GAPA(C0 = NP_MFMA(kf[6], qr[3], C0),   P1[10], P1[11], P1[12], P1[13], pw3[0] = NP_PKW(P1, 8), pw3[1] = NP_PKW(P1, 10), pw3); \
    NP_VRD(7); NP_SBAR(); NP_GAPA(C1 = NP_MFMA(kf[7], qr[3], C1),   P1[14], P1[15], 0.f, 0.f,       pw3[2] = NP_PKW(P1, 12), pw3[3] = NP_PKW(P1, 14), pw3); \
    l_reg += sacc; \
    if (GK) { NP_DMA_K((t) + 3, sl_cur); } if (GV) { NP_DMA_V((t) + 2, vs_nn); } \
    NP_MASK(C0, C1, t); \
    { float a = NP_MX3(C0[0], C0[1], C1[0]), b_ = NP_MX3(C0[2], C0[3], C1[1]); a = NP_MX3(a, C1[2], C1[3]); \
      _Pragma("unroll") for (int r = 4; r < 16; r += 4) { a = NP_MX3(a, C0[r], C0[r + 1]); b_ = NP_MX3(b_, C0[r + 2], C0[r + 3]); a = NP_MX3(a, C1[r], C1[r + 1]); b_ = NP_MX3(b_, C1[r + 2], C1[r + 3]); } \
      const float rm = fa::swap_max(__builtin_fmaxf(a, b_)); \
      resc = false; \
      if (__builtin_expect(__any(rm > fa::FA_THR), 0)) { const float dl = __builtin_fmaxf(rm, 0.f); mhat += dl; \
        _Pragma("unroll") for (int r = 0; r < 16; ++r) { C0[r] -= dl; C1[r] -= dl; } \
        _Pragma("unroll") for (int r = 0; r < 16; ++r) negm[r] = -mhat; NP_PIN(negm); \
        const float f = __builtin_amdgcn_exp2f(-dl); l_reg *= f; if (hi == 0) wsf[r32] = f; resc = true; } } \
    NP_SBAR(); \
    NP_GAPB(o[0] = NP_MFMA(NP_PAF(0), NP_VFR(0), o[0]), C0, 0); \
    NP_GAPB(o[1] = NP_MFMA(NP_PAF(0), NP_VFR(4), o[1]), C0, 4); \
    NP_KRD(GL, 0); NP_GAPB(o[0] = NP_MFMA(NP_PAF(1), NP_VFR(1), o[0]), C0, 8); \
    NP_KRD(GL, 1); NP_GAPB(o[1] = NP_MFMA(NP_PAF(1), NP_VFR(5), o[1]), C0, 12); \
    NP_KRD(GL, 2); NP_GAPB(o[0] = NP_MFMA(NP_PAF(2), NP_VFR(2), o[0]), C1, 0); \
    NP_KRD(GL, 3); NP_GAPB(o[1] = NP_MFMA(NP_PAF(2), NP_VFR(6), o[1]), C1, 4); \
    NP_GAPB(o[0] = NP_MFMA(NP_PAF(3), NP_VFR(3), o[0]), C1, 8); \
    NP_GAPB(o[1] = NP_MFMA(NP_PAF(3), NP_VFR(7), o[1]), C1, 12); \
    NP_EXTRA(); \
    } while (0)
#define NP_ENDW(tt) do { unsigned long long tw_ = 0ull; if (TPK == 120 || TPK == 121) tw_ = wall_clock64(); if (TPK == 121) { if ((tt) + 3 < NT) { asm volatile("s_waitcnt vmcnt(3) lgkmcnt(0)" ::: "memory"); } else if ((tt) + 2 < NT) { asm volatile("s_waitcnt vmcnt(2) lgkmcnt(0)" ::: "memory"); } else { asm volatile("s_waitcnt vmcnt(0) lgkmcnt(0)" ::: "memory"); } F.tpacc += wall_clock64() - tw_; } \
    if ((tt) + 3 < NT) { NP_WAIT_BAR(3); } else if ((tt) + 2 < NT) { NP_WAIT_BAR(2); } else { NP_WAIT_BAR(0); } if (TPK == 120) F.tpacc += wall_clock64() - tw_; } while (0)
#define NP_HOOK(t) do { if ((t) == NS) NP_FOLD(96); } while (0)
    int t = 1;
    for (; t + 4 < NT; t += 2) {
        NP_STEP(pB0, pB1, pA0, pA1, t, true, true, true);         NP_WAIT_BAR(3); NP_RESC(); NP_ROT(); NP_HOOK(t);
        NP_STEP(pA0, pA1, pB0, pB1, t + 1, true, true, true);     NP_WAIT_BAR(3); NP_RESC(); NP_ROT(); NP_HOOK(t + 1);
    }
    NP_STEP(pB0, pB1, pA0, pA1, t, false, true, true);            NP_WAIT_BAR(2); NP_RESC(); NP_ROT(); NP_HOOK(t);
    NP_STEP(pA0, pA1, pB0, pB1, t + 1, false, false, true);       NP_WAIT_BAR(0); NP_RESC(); NP_ROT(); NP_HOOK(t + 1);
    NP_STEP(pB0, pB1, pA0, pA1, NT - 1, false, false, false); NP_RESC(); NP_HOOK(NT - 1);
    { float sacc = pB0[0] + pB0[1];
#pragma unroll
      for (int r = 2; r < 16; ++r) sacc += pB0[r];
#pragma unroll
      for (int r = 0; r < 16; ++r) sacc += pB1[r];
      l_reg += sacc; NP_SBAR();
      fa::pv(o[0], o[1], pB0, pB1, L + NS_V + vs_cur, lane, hi); }
    { const float lt_ = fa::swap_sum(l_reg); asm volatile("s_waitcnt lgkmcnt(0)" ::: "memory"); if (hi == 0) wsf[32 + r32] = lt_; asm volatile("s_waitcnt lgkmcnt(0)" ::: "memory");
#pragma unroll
      for (int r = 0; r < 16; ++r) { const float s_ = wsf[64 + crow(r, hi)] / __builtin_fmaxf(wsf[32 + crow(r, hi)], 1e-30f); o[0][r] = OF[64 * r] + s_ * o[0][r]; o[1][r] = OF[64 * (16 + r)] + s_ * o[1][r]; }
      asm volatile("s_waitcnt lgkmcnt(0)" ::: "memory"); }
    store_o_tile(o[0], o[1], F.lds + RING_OFF + NS_CK + wid * 8192, lane, [&](int rr) { return Ow + (size_t)(rr >> 2) * 1024 + (rr & 3) * 64; });
    asm volatile("s_waitcnt lgkmcnt(0)\n\ts_barrier" ::: "memory");
#undef NP_DMA_K
#undef NP_DMA_V
#undef NP_MASK
#undef NP_CIN
#undef NP_RESC
#undef NP_FOLD
#undef NP_ROT
#undef NP_PKW
#undef NP_PAF
#undef NP_VFR
#undef NP_GAPA
#undef NP_EX
#undef NP_GAPB
#undef NP_VRD
#undef NP_KRD
#undef NP_STEP
#undef NP_ENDW
#undef NP_EXTRA
#undef NP_HOOK
}
constexpr int GA_A = 0, GA_ASZ = 32768, GA_B = 2 * GA_ASZ, GA_BSZ = 16384, GA_WS = GA_B + 2 * GA_BSZ;
__device__ __forceinline__ void nsa_gates_unit(Frame& F, int hm, const bf16* HBp, const bf16* WGT, const float* ssq, float* GT) {
    const int tid = opaque_tid(), lane = tid & 63, r32 = lane & 31, hi = lane >> 5, wid = __builtin_amdgcn_readfirstlane(tid >> 6);
    const int rb = wid & 3, nb = wid >> 2, row0 = hm * 128; const fa::lds_cptr L = (fa::lds_cptr)(F.lds + RING_OFF); const unsigned l0 = fa::lds_addr(L);
    LAS float* wsf = (LAS float*)(F.lds + RING_OFF + GA_WS) + rb * 32;
    float rsown;
    { const f32x4* sp = (const f32x4*)(ssq + (size_t)(row0 + rb * 32 + r32) * 16); const f32x4 a = sp[0], b = sp[1], c = sp[2], d = sp[3];
      const float s = ((a[0] + a[1]) + (a[2] + a[3])) + ((b[0] + b[1]) + (b[2] + b[3])) + ((c[0] + c[1]) + (c[2] + c[3])) + ((d[0] + d[1]) + (d[2] + d[3]));
      rsown = __builtin_amdgcn_rsqf(s * (1.0f / 1024.0f) + pg8::NORM_EPS); }
    __builtin_amdgcn_s_waitcnt(0x0F70);
    if (nb == 0 && hi == 0) wsf[r32] = rsown;
    auto dma_chunk = [&](int kc, int buf) {
#pragma unroll
        for (int q = 0; q < 4; ++q) { const int i = 4 * wid + q, p = 64 * i + lane, row = p >> 4, slot = p & 15, ch = slot ^ (row & 7);
            fa::glds16(HBp + (size_t)(row0 + row) * 1024 + kc * 128 + ch * 8, (unsigned)__builtin_amdgcn_readfirstlane(l0 + GA_A + buf * GA_ASZ + i * 1024)); }
#pragma unroll
        for (int q = 0; q < 2; ++q) { const int i = 2 * wid + q; fa::glds16(WGT + (size_t)kc * 8192 + i * 512 + lane * 8, (unsigned)__builtin_amdgcn_readfirstlane(l0 + GA_B + buf * GA_BSZ + i * 1024)); } };
    fa::f32x16 acc = fa::f32x16{};
    const int rot = (int)(blockIdx.x >> 3);
    dma_chunk(rot & 7, 0); dma_chunk((rot + 1) & 7, 1);
    const int arow = 32 * rb + r32;
    for (int kc = 0; kc < 8; ++kc) { const int buf = kc & 1;
        if (kc + 1 < 8) FA_WAIT_BAR(6); else FA_WAIT_BAR(0);
        const fa::lds_cptr ab = L + GA_A + buf * GA_ASZ + arow * 256, bb = L + GA_B + buf * GA_BSZ + nb * 1024 + lane * 16;
#pragma unroll
        for (int s = 0; s < 8; ++s) { const fa::bf16x8 a = *(const FA_LAS fa::bf16x8*)(ab + (((2 * s + hi) ^ (arow & 7)) * 16)), b = *(const FA_LAS fa::bf16x8*)(bb + s * 2048);
            acc = FA_MFMA(a, b, acc); }
        asm volatile("s_waitcnt lgkmcnt(0)\n\ts_barrier" ::: "memory");
        if (kc + 2 < 8) dma_chunk((kc + 2 + rot) & 7, buf);
    }
#pragma unroll
    for (int r = 0; r < 16; ++r) { const int rr = fa::crow(r, hi); const float rs = wsf[rr]; const int col = 32 * nb + r32;
        if (col < 48) GT[(size_t)(row0 + 32 * rb + rr) * 48 + col] = pg8::sigmoid_f(acc[r] * rs); }
    asm volatile("s_waitcnt lgkmcnt(0)\n\ts_barrier" ::: "memory");
}
constexpr int CP_A = 0, CP_RED = 67584, CP_H1 = CP_RED + 65536, CP_END = CP_H1 + 16384;
static_assert(CP_END <= RING_BYTES, "compress LDS map");
__device__ __forceinline__ void compress_unit(Frame& F, int u, const bf16* KV6, const bf16* CW1, const bf16* CW2, const float* BIAS1, const float* rope, bf16* KCMP, bf16* VCMP) {
    const int tid = opaque_tid(), lane = tid & 63, r32 = lane & 31, hi = lane >> 5, wid = __builtin_amdgcn_readfirstlane(tid >> 6);
    const int nb = u & 7, g = (u >> 3) & 3, b = (u >> 5) & 7, kv = u >> 8;
    const fa::lds_cptr L = (fa::lds_cptr)(F.lds + RING_OFF); const unsigned l0 = fa::lds_addr(L);
    const bf16* src = KV6 + (size_t)kv * ((size_t)MROWS * 256) + (size_t)b * SEQ * 256 + g * 64;
    const bf16* w1f = CW1 + (size_t)kv * 262144 + lane * 8;
    const int tok0 = 512 * nb;
    for (int i = wid; i < 66; i += 8) { const int p = 64 * i + lane, row = p >> 3, slot = p & 7, ch = slot ^ ((row >> 4) & 7); int trow = tok0 + row; if (trow > SEQ - 1) trow = SEQ - 1;
        fa::glds16(src + (size_t)trow * 256 + ch * 8, (unsigned)__builtin_amdgcn_readfirstlane(l0 + CP_A + i * 1024)); }
    FA_WAIT_BAR(0);
    const int wk = wid & 3, nh = wid >> 2, crot = (int)(blockIdx.x >> 3) & 7;
    fa::f32x16 acc0 = fa::f32x16{}, acc1 = fa::f32x16{};
#pragma unroll 8
    for (int kk = 0; kk < 32; ++kk) { const int l = 8 * wk + (((kk >> 2) + crot) & 7), d0 = kk & 3, row = 16 * r32 + l, slot = (2 * d0 + hi) ^ ((row >> 4) & 7);
        const fa::bf16x8 a = *(const FA_LAS fa::bf16x8*)(L + CP_A + row * 128 + slot * 16);
        const fa::bf16x8 b0 = *(const fa::bf16x8*)(w1f + (size_t)((l * 4 + d0) * 4 + 2 * nh) * 512), b1 = *(const fa::bf16x8*)(w1f + (size_t)((l * 4 + d0) * 4 + 2 * nh + 1) * 512);
        acc0 = FA_MFMA(a, b0, acc0); acc1 = FA_MFMA(a, b1, acc1); }
    { LAS float* red = (LAS float*)(F.lds + RING_OFF + CP_RED) + wid * 2048 + r32;
#pragma unroll
      for (int r = 0; r < 16; ++r) { red[fa::crow(r, hi) * 64] = acc0[r]; red[fa::crow(r, hi) * 64 + 32] = acc1[r]; } }
    __syncthreads();
    { const int row = tid >> 4, c0 = (tid & 15) * 8, nhh = c0 >> 6; const LAS float* red = (const LAS float*)(F.lds + RING_OFF + CP_RED) + (nhh * 4 * 32 + row) * 64 + (c0 & 63);
      float s[8];
#pragma unroll
      for (int e = 0; e < 8; ++e) s[e] = BIAS1[kv * 128 + c0 + e];
#pragma unroll
      for (int w = 0; w < 4; ++w) { const f32x4 x0 = *(const LAS f32x4*)(red + w * 2048), x1 = *(const LAS f32x4*)(red + w * 2048 + 4); s[0] += x0[0]; s[1] += x0[1]; s[2] += x0[2]; s[3] += x0[3]; s[4] += x1[0]; s[5] += x1[1]; s[6] += x1[2]; s[7] += x1[3]; }
      { const int ch = (tid & 15) ^ (row & 15);
        v4u o; o.x = pk2(pg8::silu_f(s[0]), pg8::silu_f(s[1])); o.y = pk2(pg8::silu_f(s[2]), pg8::silu_f(s[3])); o.z = pk2(pg8::silu_f(s[4]), pg8::silu_f(s[5])); o.w = pk2(pg8::silu_f(s[6]), pg8::silu_f(s[7]));
        *(LAS v4u*)(F.lds + RING_OFF + CP_H1 + row * 256 + ch * 16) = o; } }
    __syncthreads();
    if (wid == 0) {
        const bf16* w2f = CW2 + (size_t)kv * 8192 + lane * 8; fa::f32x16 o1 = fa::f32x16{}, o2 = fa::f32x16{};
#pragma unroll
        for (int ks = 0; ks < 8; ++ks) { const fa::bf16x8 a = *(const FA_LAS fa::bf16x8*)(L + CP_H1 + r32 * 256 + (((2 * ks + hi) ^ (r32 & 15)) * 16));
            o1 = FA_MFMA(a, *(const fa::bf16x8*)(w2f + (size_t)(ks * 2) * 512), o1); o2 = FA_MFMA(a, *(const fa::bf16x8*)(w2f + (size_t)(ks * 2 + 1) * 512), o2); }
#pragma unroll
        for (int r = 0; r < 16; ++r) { const int nn = nb * 32 + fa::crow(r, hi); float x1 = o1[r], x2 = o2[r];
            if (kv == 0 && nn < 255) { const size_t prow = (size_t)b * SEQ + 16 * nn + 31; const f32x2 cs = *(const f32x2*)(rope + (prow * 32 + r32) * 2);
                const float y1 = x1 * cs[0] - x2 * cs[1], y2 = x2 * cs[0] + x1 * cs[1]; x1 = y1; x2 = y2; }
            if (nn >= 255) { x1 = 0.f; x2 = 0.f; }
            bf16* dst = (kv ? VCMP : KCMP) + (((size_t)b * 256 + nn) * 4 + g) * 64 + r32;
            dst[0] = (bf16)f2bf(x1); dst[32] = (bf16)f2bf(x2); } }
    __syncthreads();
}
template <int MODE> __device__ __forceinline__ void nsa_unit(Frame& F, int b, int g, int qb, const bf16* QN, const bf16* KV6, const bf16* KCMP, const bf16* VCMP, const float* GT, bf16* O1) {
    const unsigned long long tp0_ = (TPK >= 101 && TPK <= 119) ? wall_clock64() : 0ull;
    const int tid = opaque_tid(), lane = tid & 63, r32 = lane & 31, hi = lane >> 5, wid = __builtin_amdgcn_readfirstlane(tid >> 6);
    const fa::lds_cptr L = (fa::lds_cptr)(F.lds + RING_OFF); const unsigned l0 = fa::lds_addr(L);
    LAS float* wsf = (LAS float*)(F.lds + RING_OFF + NS_WS) + wid * 128;
    const int tl = 8 * wid + (r32 >> 2), hh = r32 & 3, head = 4 * g + hh, t = 64 * qb + tl, cur = qb;
    const size_t tok = (size_t)b * SEQ + t;
    fa::bf16x8 qr[4];
#pragma unroll
    for (int d0 = 0; d0 < 4; ++d0) qr[d0] = *(const fa::bf16x8*)(QN + tok * 1024 + head * 64 + d0 * 16 + hi * 8);
    const float g0own = GT[tok * 48 + head * 3], g1own = GT[tok * 48 + head * 3 + 1], g2own = GT[tok * 48 + head * 3 + 2];
    __builtin_amdgcn_s_waitcnt(0x0F70);
    if (TPK == 111) { asm volatile("s_barrier" ::: "memory"); F.tpacc += wall_clock64() - tp0_; }
    unsigned long long tpc_ = 0ull; if (TPK >= 106 && TPK <= 119) { tpc_ = wall_clock64(); if (TPK == 106) F.tpacc += tpc_ - tp0_; }
    if (hi == 0) { wsf[64 + r32] = g0own; wsf[96 + r32] = g1own; }
    const int NTC = ((4 * qb + 2) >> 6) + 1;
    const bf16* kc = KCMP + (size_t)b * 256 * 256 + g * 64; const bf16* vc = VCMP + (size_t)b * 256 * 256 + g * 64;
    for (int T = 0; T < NTC; ++T) { fa::dma_k<64>(kc + (size_t)T * 64 * 256, 256, l0 + NS_CK + T * 8192, wid, lane); fa::dma_v(vc + (size_t)T * 64 * 256, 256, l0 + NS_CV + T * 8192, wid, lane); }
    NsaTiles TL; TL.init(KV6, b, g, cur, l0, lane, wid); TL.prologue();
    const int khc = (t >= 31) ? ((t - 31) >> 4) : -1;
    if (TPK == 112) { asm volatile("s_barrier" ::: "memory"); F.tpacc += wall_clock64() - tpc_; }
    unsigned long long tpd_ = 0ull; if (TPK == 108 || TPK == 109 || TPK == 114) { tpd_ = wall_clock64(); if (TPK == 108) F.tpacc += tpd_ - tpc_; }
    if (TPK == 109) { asm volatile("s_waitcnt vmcnt(5)" ::: "memory"); F.tpacc += wall_clock64() - tpd_; }
    if (TPK == 113) { const unsigned long long ta_ = wall_clock64(); asm volatile("s_waitcnt vmcnt(5)" ::: "memory"); const unsigned w_ = (unsigned)(wall_clock64() - ta_); atomicMax((unsigned*)&F.MISC[4], w_); }
    FA_WAIT_BAR(5);
    if (TPK >= 115 && TPK <= 117) { const unsigned long long te_ = wall_clock64(); F.tpacc += tpc_ - tp0_; F.tpacc2 += te_ - tpc_; F.tpacc3 += te_ - tp0_; }
    if (TPK == 114) F.tpacc += wall_clock64() - tpd_;
    if (TPK == 113) { F.tpacc += F.MISC[4]; __syncthreads(); if (threadIdx.x == 0) F.MISC[4] = 0u; __syncthreads(); }
    if (TPK == 107) F.tpacc += wall_clock64() - tpc_;
    unsigned long long tpa_ = 0ull; if (TPK == 103 || TPK == 104) { tpa_ = wall_clock64(); if (TPK == 103) F.tpacc += tpa_ - tp0_; }
    const fa::f32x16 zero16 = fa::f32x16{};
    const int twlo = 64 * qb + 8 * wid, khc_lo = (twlo >= 31) ? ((twlo - 31) >> 4) : -1, khc_hi = (twlo + 7 >= 31) ? ((twlo + 7 - 31) >> 4) : -1;
    const int NTW = (khc_hi >> 6) + 1;
    float mc = -1e30f;
    for (int T = 0; T < NTW; ++T) { fa::f32x16 p0, p1; fa::qkt<64>(p0, p1, L + NS_CK + T * 8192, qr, zero16, r32, hi); if (T * 64 + 63 > khc_lo) { asm volatile("; cmp mask (a real branch)"); fa::mask_range(p0, p1, T * 64, 0, khc, hi); }
        mc = __builtin_fmaxf(mc, fa::rowmax(p0, p1)); }
    float lc = 0.f; fa::f32x16 oc0 = fa::f32x16{}, oc1 = fa::f32x16{}; fa::f32x16 negmc;
#pragma unroll
    for (int r = 0; r < 16; ++r) negmc[r] = -mc;
    float ia[32], ic[32];
#pragma unroll
    for (int i = 0; i < 32; ++i) { ia[i] = 0.f; ic[i] = 0.f; }
#pragma unroll
    for (int T = 0; T < 4; ++T) if (T < NTW) { fa::f32x16 p0, p1; fa::qkt<64>(p0, p1, L + NS_CK + T * 8192, qr, negmc, r32, hi); if (T * 64 + 63 > khc_lo) { asm volatile("; cmp mask (a real branch)"); fa::mask_range(p0, p1, T * 64, 0, khc, hi); }
        float s0 = 0.f, s1 = 0.f;
#pragma unroll
        for (int r = 0; r < 16; ++r) { p0[r] = __builtin_amdgcn_exp2f(p0[r]); p1[r] = __builtin_amdgcn_exp2f(p1[r]); s0 += p0[r]; s1 += p1[r]; }
        lc += s0 + s1;
#pragma unroll
        for (int jj = 0; jj < 4; ++jj) { ia[T * 8 + jj] = (p0[4 * jj] + p0[4 * jj + 1]) + (p0[4 * jj + 2] + 0.5f * p0[4 * jj + 3]); ic[T * 8 + jj] = 0.5f * p0[4 * jj + 3];
            ia[T * 8 + 4 + jj] = (p1[4 * jj] + p1[4 * jj + 1]) + (p1[4 * jj + 2] + 0.5f * p1[4 * jj + 3]); ic[T * 8 + 4 + jj] = 0.5f * p1[4 * jj + 3]; }
        fa::pv(oc0, oc1, p0, p1, L + NS_CV + T * 8192, lane, hi); }
    lc = fa::swap_sum(lc);
    const float ilc = 1.0f / __builtin_fmaxf(lc, 1e-30f);
    LDS_WAIT(); if (hi == 0) wsf[32 + r32] = ilc; LDS_WAIT();
#pragma unroll
    for (int r = 0; r < 16; ++r) { const float f = wsf[32 + fa::crow(r, hi)]; oc0[r] *= f; oc1[r] *= f; }
    unsigned long long tpb_ = 0ull; if (TPK == 104 || TPK == 105) { tpb_ = wall_clock64(); if (TPK == 104) F.tpacc += tpb_ - tpa_; }
    unsigned long long selmask;
    if (cur < 16) selmask = (2ull << cur) - 1ull;
    else {
        LAS int* impb = (LAS int*)(F.lds + RING_OFF + NS_IMP + wid * 2048) + (r32 >> 2) * 64;
#pragma unroll
        for (int i = 0; i < 32; ++i) { ia[i] *= ilc; ic[i] *= ilc;
            ia[i] += __builtin_bit_cast(float, __builtin_amdgcn_update_dpp(0, __builtin_bit_cast(int, ia[i]), 0xB1, 0xf, 0xf, true)); ia[i] += __builtin_bit_cast(float, __builtin_amdgcn_update_dpp(0, __builtin_bit_cast(int, ia[i]), 0x4E, 0xf, 0xf, true));
            ic[i] += __builtin_bit_cast(float, __builtin_amdgcn_update_dpp(0, __builtin_bit_cast(int, ic[i]), 0xB1, 0xf, 0xf, true)); ic[i] += __builtin_bit_cast(float, __builtin_amdgcn_update_dpp(0, __builtin_bit_cast(int, ic[i]), 0x4E, 0xf, 0xf, true)); }
#pragma unroll
        for (int i = 0; i < 32; ++i) { auto rr = __builtin_amdgcn_permlane32_swap(__float_as_uint(ic[i]), __float_as_uint(ic[i]), false, false); ic[i] = __uint_as_float(hi ? rr[0] : rr[1]); }
#pragma unroll
        for (int i = 0; i < 32; ++i) { const float add = hi ? ic[i] : (i > 0 ? ic[i > 0 ? i - 1 : 0] : 0.f); const int mb = 2 * i + hi; const float v = ia[i] + add;
            int key = (int)((__float_as_uint(v) & ~63u) | (unsigned)(63 - mb)); if (mb < 1 || mb > cur - 2) key = (int)0x80000000;
            if (hh == 0) impb[(mb + (r32 >> 2)) & 63] = key; }
        LDS_WAIT();
        const int sub = hh * 2 + hi; int mine[8];
#pragma unroll
        for (int e = 0; e < 8; ++e) mine[e] = impb[(8 * sub + e + (r32 >> 2)) & 63];
        unsigned selb = 0u;
#pragma unroll 1
        for (int it = 0; it < 13; ++it) {
            int m = mine[0];
#pragma unroll
            for (int e = 1; e < 8; ++e) m = (mine[e] > m) ? mine[e] : m;
            { const int o1 = __builtin_amdgcn_update_dpp(0, m, 0xB1, 0xf, 0xf, true); m = (o1 > m) ? o1 : m; const int o2 = __builtin_amdgcn_update_dpp(0, m, 0x4E, 0xf, 0xf, true); m = (o2 > m) ? o2 : m;
              auto rr = __builtin_amdgcn_permlane32_swap((unsigned)m, (unsigned)m, false, false); const int o3 = (int)(hi ? rr[0] : rr[1]); m = (o3 > m) ? o3 : m; }
#pragma unroll
            for (int e = 0; e < 8; ++e) { const bool eq = (mine[e] == m); selb |= eq ? (1u << e) : 0u; mine[e] = eq ? (int)0x80000000 : mine[e]; } }
        unsigned bits = 0u;
#pragma unroll
        for (int e = 0; e < 8; ++e) { const int mb = 8 * sub + e; const bool cand = (mb >= 1 && mb <= cur - 2); const bool forced = (mb == 0 || mb == cur || mb == cur - 1); if (forced || (cand && ((selb >> e) & 1u))) bits |= 1u << e; }
        unsigned lo = (sub < 4) ? bits << (8 * sub) : 0u, hi32 = (sub >= 4) ? bits << (8 * (sub - 4)) : 0u;
        lo |= __shfl_xor(lo, 1); lo |= __shfl_xor(lo, 2); lo |= __shfl_xor(lo, 32); hi32 |= __shfl_xor(hi32, 1); hi32 |= __shfl_xor(hi32, 2); hi32 |= __shfl_xor(hi32, 32);
        selmask = ((unsigned long long)hi32 << 32) | lo;
        LDS_WAIT();
    }
    if (TPK == 105) F.tpacc += wall_clock64() - tpb_;
#pragma unroll
    for (int r = 0; r < 16; ++r) { const float gc = wsf[64 + fa::crow(r, hi)]; oc0[r] *= gc; oc1[r] *= gc; }
    LDS_WAIT(); if (hi == 0) wsf[64 + r32] = g2own; LDS_WAIT();
    if (MODE == 1) { asm volatile("" :: "v"(oc0), "v"(oc1), "v"(selmask)); FA_WAIT_BAR(0); return; }
    bf16* Ow = O1 + ((size_t)b * SEQ + 64 * qb + 8 * wid) * 1024 + 4 * g * 64;
    unsigned long long tp1_ = 0ull; if (TPK == 101 || TPK == 102) { tp1_ = wall_clock64(); if (TPK == 101) F.tpacc += tp1_ - tp0_; }
    nsa_stream_pipe(F, qr, TL, t, selmask, oc0, oc1, Ow, lane, wid);
    if (TPK == 102) F.tpacc += wall_clock64() - tp1_;
}
__device__ __forceinline__ void final_norm(Frame& F, const bf16* src, float* out, const float* ssq, const float* gain) {
    const int tid = opaque_tid(), lane = tid & 63; const int gw = F.vcu * NWAVES + __builtin_amdgcn_readfirstlane(tid >> 6), NGW = F.G * NWAVES;
    f32x4 gv[4];
#pragma unroll
    for (int j = 0; j < 4; ++j) gv[j] = *((const f32x4*)gain + 2 * lane + 128 * (j >> 1) + (j & 1));
    for (int m = gw; m < MROWS; m += NGW) { float s = (lane < 16) ? ssq[(size_t)m * 16 + lane] : 0.f; s = wave_sum(s); const float rstd = 1.0f / sqrtf(s * (1.0f / 1024.0f) + pg8::NORM_EPS);
        const v4u* xs = (const v4u*)(src + (size_t)m * DM) + lane; f32x4* xr = (f32x4*)(out + (size_t)m * DM) + 2 * lane;
#pragma unroll
        for (int hh = 0; hh < 2; ++hh) { const v4u w = xs[64 * hh];
            const f32x4 a = {__builtin_bit_cast(float, w.x << 16), __builtin_bit_cast(float, w.x & 0xffff0000u), __builtin_bit_cast(float, w.y << 16), __builtin_bit_cast(float, w.y & 0xffff0000u)};
            const f32x4 c = {__builtin_bit_cast(float, w.z << 16), __builtin_bit_cast(float, w.z & 0xffff0000u), __builtin_bit_cast(float, w.w << 16), __builtin_bit_cast(float, w.w & 0xffff0000u)};
            xr[128 * hh] = a * rstd * gv[2 * hh]; xr[128 * hh + 1] = c * rstd * gv[2 * hh + 1]; } }
}
#ifndef PH_END
#define PH_END 99
#endif
struct Args { Inputs in; float* out; unsigned char* ws; RopeFreq rf; };
__global__ void __launch_bounds__(NWAVES * 64, 2) trunk_fwd(Args args) {
    extern __shared__ __attribute__((aligned(16))) unsigned char lds[];
    Frame F;
    F.lds = (LAS unsigned char*)lds;
    F.MISC = (volatile LAS unsigned*)(F.lds + MISC_OFF);
    F.G = gridDim.x; { const int bx = blockIdx.x; F.vcu = (F.G % 8 == 0) ? (bx % 8) * (F.G / 8) + bx / 8 : bx; }
    F.ws = args.ws; F.ctl = (gu32*)(args.ws + WS_CTL); F.tpacc = 0ull; F.tpacc2 = 0ull; F.tpacc3 = 0ull;
    const Inputs& I = args.in; unsigned char* ws = args.ws; float* out = args.out;
    for (int u = threadIdx.x; u < (LDS_BYTES - LDSCTL_OFF) / 4; u += NWAVES * 64) ((LAS unsigned*)(F.lds + LDSCTL_OFF))[u] = 0u;
    __syncthreads();
    XcdBarrier bar = xcd_barrier_post((unsigned*)(F.ctl + CW_BAR), F.MISC + 8);
#ifndef TPBI
#define TPBI -1
#endif
#define GRID_BAR() do { if (TPK == 300) { const unsigned long long tb_ = wall_clock64(); xcd_barrier(bar); if (TPBI < 0 || (int)F.tpacc2 == TPBI) F.tpacc += wall_clock64() - tb_; F.tpacc2 += 1; } else xcd_barrier(bar); } while (0)
#define ON(k) ((k) < PH_END)
#ifndef DUP
#define DUP -1
#endif
#define NREP(k) (((k) == DUP) ? 2 : 1)
#ifndef WGM_OTHER
#define WGM_OTHER 4
#endif
#ifndef TPROBE
#define TPROBE -1
#endif
#ifndef TPK
#define TPK -1
#endif
#ifndef TPMUL
#define TPMUL 4
#endif
    unsigned long long tpb = 0ull;
#define TPB(k) do { if (TPK == (k)) tpb = wall_clock64(); } while (0)
#define TPEA(k) do { if (TPK == (k)) { __syncthreads(); const unsigned long long t1_ = wall_clock64(); const unsigned long long d_ = (unsigned long long)TPMUL * F.tpacc; while (wall_clock64() - t1_ < d_) __builtin_amdgcn_s_sleep(8); } } while (0)
#define TPE(k) do { if (TPK == (k)) { __syncthreads(); const unsigned long long t1_ = wall_clock64(); const unsigned long long d_ = (unsigned long long)TPMUL * (t1_ - tpb); while (wall_clock64() - t1_ < d_) __builtin_amdgcn_s_sleep(8); } } while (0)
    bf16* HB = (bf16*)(ws + WS_HB); float* SSQ = (float*)(ws + WS_SSQ); bf16* HID = (bf16*)(ws + WS_HID);
    TPB(0); if (ON(0)) for (int rep = 0; rep < NREP(0); ++rep) p0_prologue(F, I, args.rf); TPE(0);
    GRID_BAR();
#define FFN_PHASES(f, XB, k0) do { \
    if (ON(k0) && DUP == 300 + (f)) { pg8::Gemm g{HB, (const bf16*)(ws + WS_WGU) + (size_t)(f) * 5632 * DM, MROWS, 5632, DM, DM}; pg8::StaticOrder S; S.init(MROWS, 5632, F.G, (int)blockIdx.x); pg8::EpiNull E{}; pg8::gemm_phase<pg8::EpiNull, pg8::StaticOrder, true, true>(F.lds + RING_OFF, g, S, E); } \
    if (ON(k0) && DUP == 400 + (f)) { pg8::Gemm g{HID, (const bf16*)(ws + WS_WD) + (size_t)(f) * DM * FF, MROWS, DM, FF, FF}; pg8::StaticOrder S; S.init(MROWS, DM, F.G, (int)blockIdx.x, WGM_OTHER); pg8::EpiNull E{}; pg8::gemm_phase<pg8::EpiNull, pg8::StaticOrder, true, true>(F.lds + RING_OFF, g, S, E); } \
    TPB(100 + (f)); if (ON(k0)) for (int rep = 0; rep < NREP(100 + (f)); ++rep) { pg8::Gemm g{HB, (const bf16*)(ws + WS_WGU) + (size_t)(f) * 5632 * DM, MROWS, 5632, DM, DM}; pg8::StaticOrder S; S.init(MROWS, 5632, F.G, (int)blockIdx.x); \
        pg8::EpiGateUp E{HID, SSQ, FF}; pg8::gemm_phase<pg8::EpiGateUp, pg8::StaticOrder, true, true>(F.lds + RING_OFF, g, S, E); } TPE(100 + (f)); \
    GRID_BAR(); \
    TPB(200 + (f)); if (ON(k0)) for (int rep = 0; rep < NREP(200 + (f)); ++rep) { pg8::Gemm g{HID, (const bf16*)(ws + WS_WD) + (size_t)(f) * DM * FF, MROWS, DM, FF, FF}; pg8::StaticOrder S; S.init(MROWS, DM, F.G, (int)blockIdx.x, WGM_OTHER); \
        pg8::EpiResidT<XB> E{I.x, HB, SSQ, 0.5f}; \
        if (DUP == 500 && (f) == 0) { pg8::EpiTwice<pg8::EpiResidT<XB>> E2{E}; pg8::gemm_phase<pg8::EpiTwice<pg8::EpiResidT<XB>>, pg8::StaticOrder, true, true>(F.lds + RING_OFF, g, S, E2); } \
        else pg8::gemm_phase<pg8::EpiResidT<XB>, pg8::StaticOrder, true, true>(F.lds + RING_OFF, g, S, E); } TPE(200 + (f)); \
    GRID_BAR(); } while (0)

    FFN_PHASES(0, true, 1);
    {
        bf16* U0 = (bf16*)(ws + WS_U0); bf16* QM = (bf16*)(ws + WS_QM); bf16* KF = (bf16*)(ws + WS_KF); bf16* VM = (bf16*)(ws + WS_VM); bf16* O0 = (bf16*)(ws + WS_O0);
        bf16* KD = (bf16*)out; bf16* QA = KD + (size_t)MROWS * 256; bf16* QI = QA + (size_t)MROWS * 256;
        float* SSQQ = (float*)(ws + WS_SSQQ); float* SSQKV = (float*)(ws + WS_SSQKV); float* KR = (float*)(ws + WS_KR); float* GA = (float*)(ws + WS_GA); float* DEC = (float*)(ws + WS_DEC);
        const float* ROPE0 = (const float*)(ws + WS_ROPE0);
        TPB(2); if (ON(2)) for (int rep = 0; rep < NREP(2); ++rep) { pg8::Gemm g{HB, (const bf16*)(ws + WS_WIN0), MROWS, HYN, DM, DM}; pg8::StaticOrder S; S.init(MROWS, HYN, F.G, (int)blockIdx.x, WGM_OTHER);
            pg8::EpiHyIn E{U0, SSQ, SSQQ, SSQKV, KR, GA}; pg8::gemm_phase<pg8::EpiHyIn, pg8::StaticOrder, true, true>(F.lds + RING_OFF, g, S, E); } TPE(2);
        GRID_BAR();
        if (ON(3)) for (int rep = 0; rep < NREP(3); ++rep) {
            TPB(3); TPB(31); for (int r2 = 0; r2 < NREP(31); ++r2) for (int hm = (int)blockIdx.x; hm < MROWS / 128; hm += F.G) mla_up_unit(F, hm, U0, (const bf16*)(ws + WS_WUQ), (const bf16*)(ws + WS_WUKV), SSQQ, SSQKV, ROPE0, 0.10206207261596577f * LOG2E, QM, KF, VM);
            TPE(31); TPB(33); for (int r2 = 0; r2 < NREP(33); ++r2) krot_pass(F, KR, ROPE0, KF); TPE(33);
            TPB(34); for (int r2 = 0; r2 < NREP(34); ++r2) gla_pre(F, U0, GA, I.w_a2, I.b_a, KD, QA, QI, DEC); TPE(34); TPE(3);
        }
        GRID_BAR();
        if (ON(4)) for (int rep = 0; rep < NREP(4); ++rep) {
            TPB(4); TPB(41); TPB(42); if (blockIdx.x < 64) for (int r2 = 0; r2 < NREP(41); ++r2) { const int pr_ = (int)blockIdx.x >> 1, hf_ = (int)blockIdx.x & 1; gla_unit(F, pr_ >> 2, pr_ & 3, hf_ * 32, hf_ * 32 + 32, U0, KD, QA, QI, DEC, I.gla_norm, O0); } TPE(41);
            { const int xg = (int)blockIdx.x & 7;
              for (int r2 = 0; r2 < NREP(42); ++r2) { const int qw = CW_Q0 + 64 * xg + 1024 * rep + 2048 * r2; unsigned tk = wq_issue(F, qw);
                  for (;;) { const int i = wq_collect(F, tk); if (i >= 128) break; tk = wq_issue(F, qw); const int pr = 8 * xg + (i & 7); mla_attn_unit(F, pr >> 3, pr & 7, 15 - (i >> 3), QM, KF, VM, O0); } } } TPE(4); if (blockIdx.x >= 64) TPE(42); TPEA(44); TPEA(45);
        }
        GRID_BAR();
        TPB(5); if (ON(5)) { pg8::Gemm g{O0, (const bf16*)(ws + WS_WOUT0), MROWS, DM, DM, DM}; pg8::StaticOrder S; S.init(MROWS, DM, F.G, (int)blockIdx.x, WGM_OTHER);
            pg8::EpiResidT<false> E{I.x, HB, SSQ, 1.0f}; pg8::gemm_phase<pg8::EpiResidT<false>, pg8::StaticOrder, true, true>(F.lds + RING_OFF, g, S, E); } TPE(5);
        GRID_BAR();
    }
    FFN_PHASES(1, false, 6);
    FFN_PHASES(2, false, 7);
    {
        bf16* QN = (bf16*)(ws + WS_QN); bf16* KV6 = (bf16*)(ws + WS_KV6); bf16* O1 = (bf16*)(ws + WS_O1); float* GT = (float*)(ws + WS_GT);
        bf16* KCMP = (bf16*)(ws + WS_KCMP); bf16* VCMP = (bf16*)(ws + WS_VCMP); const float* ROPE1 = (const float*)(ws + WS_ROPE1);
        TPB(8); if (ON(8)) for (int rep = 0; rep < NREP(8); ++rep) { pg8::Gemm g{HB, (const bf16*)(ws + WS_WIN1), MROWS, NSAN, DM, DM}; pg8::StaticOrder S; S.init(MROWS, NSAN, F.G, (int)blockIdx.x, WGM_OTHER);
            pg8::EpiNsaIn E{QN, KV6, SSQ, ROPE1, 0.125f * LOG2E}; pg8::gemm_phase<pg8::EpiNsaIn, pg8::StaticOrder, true, true>(F.lds + RING_OFF, g, S, E); TPB(81);
            for (int r2 = 0; r2 < NREP(81); ++r2) for (int hm = (int)blockIdx.x; hm < MROWS / 128; hm += F.G) nsa_gates_unit(F, hm, HB, (const bf16*)(ws + WS_WGT), SSQ, GT); } TPE(81); TPE(8);
        GRID_BAR();
        TPB(9); if (ON(9)) for (int rep = 0; rep < NREP(9); ++rep) { for (int u = (int)blockIdx.x; u < 512; u += F.G) compress_unit(F, u, KV6, (const bf16*)(ws + WS_CW1), (const bf16*)(ws + WS_CW2), (const float*)(ws + WS_BIAS1), ROPE1, KCMP, VCMP); } TPE(9);
        GRID_BAR();
        TPB(10); if (ON(10)) for (int rep = 0; rep < NREP(10); ++rep) {
            const int xg = (int)blockIdx.x & 7;
            const int qw = CW_Q1 + 64 * xg + 1024 * rep; unsigned tk = wq_issue(F, qw);
            for (;;) { const int i = wq_collect(F, tk); if (i >= 256) break; tk = wq_issue(F, qw); const int pr = 4 * xg + (i & 3), qb = 63 - (i >> 2);
                if (DUP == 110) nsa_unit<1>(F, pr >> 2, pr & 3, qb, QN, KV6, KCMP, VCMP, GT, O1);
                nsa_unit<0>(F, pr >> 2, pr & 3, qb, QN, KV6, KCMP, VCMP, GT, O1); } } TPE(10); TPEA(101); TPEA(103); TPEA(104); TPEA(105); TPEA(106); TPEA(107); TPEA(108); TPEA(109); TPEA(111); TPEA(112); TPEA(113); TPEA(114); TPEA(120); TPEA(121); TPEA(102); TPEA(115); if (TPK == 116) { F.tpacc = F.tpacc2; TPEA(116); } if (TPK == 117) { F.tpacc = F.tpacc3; TPEA(117); }
        GRID_BAR();
        TPB(11); if (ON(11)) { pg8::Gemm g{O1, (const bf16*)(ws + WS_WOUT1), MROWS, DM, DM, DM}; pg8::StaticOrder S; S.init(MROWS, DM, F.G, (int)blockIdx.x, WGM_OTHER);
            pg8::EpiResidT<false> E{I.x, HB, SSQ, 1.0f}; pg8::gemm_phase<pg8::EpiResidT<false>, pg8::StaticOrder, true, true>(F.lds + RING_OFF, g, S, E); } TPE(11);
        GRID_BAR();
    }
    FFN_PHASES(3, false, 12);
    TPB(13); final_norm(F, HB, out, SSQ, I.final_norm); TPE(13); TPEA(300);
    if (blockIdx.x == 0 && threadIdx.x == 0) { if (__hip_atomic_load((unsigned*)(F.ctl + CW_BAR) + XB_TMO, RLX_AGENT) != 0u) { VM_WAIT(); out[0] = __builtin_nanf(""); } }
#undef ON
#undef GRID_BAR
}

extern "C" void kernel_launch(void* const* d_in, const int* in_sizes, int n_in, void* d_out, int out_size, void* d_ws, size_t ws_size, hipStream_t stream) {
    static int grid = 0;
    if (grid == 0) {
        if (n_in != 25 || in_sizes[0] != MROWS * DM || out_size != MROWS * DM || ws_size < WS_END) { fprintf(stderr, "kernel_launch: unexpected shapes (n_in %d, in0 %d, out %d, ws %zu); nothing launched\n", n_in, n_in > 0 ? in_sizes[0] : -1, out_size, ws_size); grid = -1; return; }
        int dev = 0, cus = 0, per_cu = 0;
        if (hipGetDevice(&dev) != hipSuccess || hipDeviceGetAttribute(&cus, hipDeviceAttributeMultiprocessorCount, dev) != hipSuccess) { grid = -1; return; }
        if (hipFuncSetAttribute((const void*)trunk_fwd, hipFuncAttributeMaxDynamicSharedMemorySize, LDS_BYTES) != hipSuccess) { fprintf(stderr, "kernel_launch: hipFuncSetAttribute failed\n"); grid = -1; return; }
        if (hipOccupancyMaxActiveBlocksPerMultiprocessor(&per_cu, (const void*)trunk_fwd, NWAVES * 64, LDS_BYTES) != hipSuccess || per_cu < 1) { fprintf(stderr, "kernel_launch: occupancy query reports %d workgroups per CU\n", per_cu); }
        (void)hipGetLastError();
        grid = cus;
    }
    if (grid < 0) return;
    if (hipMemsetAsync((char*)d_ws + WS_CTL, 0, CTL_ZERO_BYTES, stream) != hipSuccess) return;
    Args a{};
    const void** ip = (const void**)&a.in;
    for (int i = 0; i < 25; ++i) ip[i] = d_in[i];
    a.out = (float*)d_out; a.ws = (unsigned char*)d_ws;
    for (int j = 0; j < 16; ++j) a.rf.f16[j] = (double)powf(10000.0f, -(float)j * (2.0f / 32.0f));
    for (int j = 0; j < 32; ++j) a.rf.f32[j] = (double)powf(10000.0f, -(float)j * (2.0f / 64.0f));
    hipLaunchKernelGGL(trunk_fwd, dim3(grid), dim3(NWAVES * 64), LDS_BYTES, stream, a);
}
```
